# Optimizing an MI355X kernel written in HIP

```python
import math
import jax, jax.numpy as jnp
from jax import lax
import numpy as np

D_MODEL = 2048
BATCH = 8
SEQ = 2048
DEPTH = 1

MLA_HEADS = D_MODEL // 256
MLA_Q_RANK = D_MODEL // 4
MLA_KV_RANK = D_MODEL // 8
MLA_NOPE_DIM = 128
MLA_ROPE_DIM = 64
MLA_V_DIM = 128
MLA_SCALE = (MLA_NOPE_DIM + MLA_ROPE_DIM) ** -0.5
DIFF_HEADS = D_MODEL // 256
DIFF_QK_DIM = 64
DIFF_V_DIM = 2 * DIFF_QK_DIM
DIFF_SCALE = DIFF_QK_DIM ** -0.5
MIX_WIDTH = MLA_HEADS * MLA_V_DIM + DIFF_HEADS * DIFF_V_DIM
IN_Q_LAT = MLA_Q_RANK
IN_KV_LAT = MLA_KV_RANK
IN_K_ROPE = MLA_ROPE_DIM
IN_DIFF_Q = DIFF_HEADS * 2 * DIFF_QK_DIM
IN_DIFF_K = DIFF_HEADS * 2 * DIFF_QK_DIM
IN_DIFF_V = DIFF_HEADS * DIFF_V_DIM
IN_WIDTH = IN_Q_LAT + IN_KV_LAT + IN_K_ROPE + IN_DIFF_Q + IN_DIFF_K + IN_DIFF_V
SPLIT_POINTS = (IN_Q_LAT,
                IN_Q_LAT + IN_KV_LAT,
                IN_Q_LAT + IN_KV_LAT + IN_K_ROPE,
                IN_Q_LAT + IN_KV_LAT + IN_K_ROPE + IN_DIFF_Q,
                IN_Q_LAT + IN_KV_LAT + IN_K_ROPE + IN_DIFF_Q + IN_DIFF_K)
D_FF = 5632
CONV_WIDTH = 3
REL_BUCKETS = 32
REL_MAX_DIST = 128
ROPE_THETA = 10000.0
Q_BLOCK = 128
NORM_EPS = 1e-6
N_MOD = 6

kernel_name = "hybrid_mla_diffattn_convffn_encoder"


def rms_norm(x, w):
    xf = x.astype(jnp.float32)
    y = xf * lax.rsqrt(jnp.mean(xf * xf, axis=-1, keepdims=True) + NORM_EPS)
    return (y * w.astype(jnp.float32)).astype(x.dtype)


def modulate(h, shift, scale):
    return h * (1 + scale[:, None, :]) + shift[:, None, :]


def rope_tables(positions):
    inv = 1.0 / (ROPE_THETA ** (jnp.arange(0, MLA_ROPE_DIM, 2, dtype=jnp.float32) / MLA_ROPE_DIM))
    ang = positions.astype(jnp.float32)[..., None] * inv
    return jnp.cos(ang), jnp.sin(ang)


def apply_rope(t, cos, sin):
    half = t.shape[-1] // 2
    t1, t2 = t[..., :half], t[..., half:]
    cos = cos.astype(t.dtype)
    sin = sin.astype(t.dtype)
    return jnp.concatenate([t1 * cos - t2 * sin, t1 * sin + t2 * cos], axis=-1)


def t5_bucket(rel):
    half = REL_BUCKETS // 2
    max_exact = half // 2
    ret = jnp.where(rel > 0, half, 0)
    n = jnp.abs(rel)
    nf = jnp.maximum(n, 1).astype(jnp.float32)
    large = max_exact + (jnp.log(nf / max_exact) / math.log(REL_MAX_DIST / max_exact)
                         * (half - max_exact)).astype(jnp.int32)
    large = jnp.minimum(large, half - 1)
    return ret + jnp.where(n < max_exact, n, large)


def to_blocks(t):
    b, s = t.shape[0], t.shape[1]
    return jnp.moveaxis(t.reshape(b, s // Q_BLOCK, Q_BLOCK, *t.shape[2:]), 1, 0)


def from_blocks(t):
    nb, b = t.shape[0], t.shape[1]
    t = jnp.moveaxis(t, 0, 1)
    return t.reshape(b, nb * Q_BLOCK, *t.shape[3:])


def hybrid_mixer(h, positions, cos, sin, rel_bias, w_in, q_norm, w_uq, kv_norm, w_ukv,
                 lq1, lk1, lq2, lk2, subln, w_o, lambda_init):
    B, S, _ = h.shape
    proj = h @ w_in
    q_lat, kv_lat, k_rope, dq, dk, dv = jnp.split(proj, SPLIT_POINTS, axis=-1)

    q = (rms_norm(q_lat, q_norm) @ w_uq).reshape(B, S, MLA_HEADS, MLA_NOPE_DIM + MLA_ROPE_DIM)
    q_nope = q[..., :MLA_NOPE_DIM]
    q_rope = apply_rope(q[..., MLA_NOPE_DIM:], cos[:, :, None, :], sin[:, :, None, :])
    kv = (rms_norm(kv_lat, kv_norm) @ w_ukv).reshape(B, S, MLA_HEADS, MLA_NOPE_DIM + MLA_V_DIM)
    k_nope = kv[..., :MLA_NOPE_DIM]
    v_mla = kv[..., MLA_NOPE_DIM:]
    k_rope = apply_rope(k_rope, cos, sin)

    dq = dq.reshape(B, S, DIFF_HEADS, 2, DIFF_QK_DIM)
    dk = dk.reshape(B, S, DIFF_HEADS, 2, DIFF_QK_DIM)
    dv = dv.reshape(B, S, DIFF_HEADS, DIFF_V_DIM)
    lam = (jnp.exp(jnp.sum(lq1.astype(jnp.float32) * lk1.astype(jnp.float32)))
           - jnp.exp(jnp.sum(lq2.astype(jnp.float32) * lk2.astype(jnp.float32)))
           + lambda_init)
    bias_tab = rel_bias.astype(jnp.float32)

    def block(args):
        qn, qr, dqb, pq = args
        s = (jnp.einsum('bqhd,bkhd->bhqk', qn, k_nope)
             + jnp.einsum('bqhr,bkr->bhqk', qr, k_rope)) * MLA_SCALE
        p = jax.nn.softmax(s.astype(jnp.float32), axis=-1).astype(v_mla.dtype)
        o_mla = jnp.einsum('bhqk,bkhd->bqhd', p, v_mla)

        rel = positions[:, None, :] - pq[:, :, None]
        bias = jnp.take(bias_tab, t5_bucket(rel), axis=0)
        bias = jnp.transpose(bias, (0, 3, 1, 2))
        s1 = jnp.einsum('bqhd,bkhd->bhqk', dqb[..., 0, :], dk[..., 0, :]).astype(jnp.float32) * DIFF_SCALE + bias
        s2 = jnp.einsum('bqhd,bkhd->bhqk', dqb[..., 1, :], dk[..., 1, :]).astype(jnp.float32) * DIFF_SCALE + bias
        a = jax.nn.softmax(s1, axis=-1) - lam * jax.nn.softmax(s2, axis=-1)
        o_diff = jnp.einsum('bhqk,bkhd->bqhd', a.astype(dv.dtype), dv)
        return o_mla, o_diff

    o_mla, o_diff = lax.map(block, (to_blocks(q_nope), to_blocks(q_rope),
                                    to_blocks(dq), to_blocks(positions)))
    o_mla = from_blocks(o_mla)
    o_diff = from_blocks(o_diff)
    o_diff = rms_norm(o_diff, subln) * (1.0 - lambda_init)
    out = jnp.concatenate([o_mla.reshape(B, S, MLA_HEADS * MLA_V_DIM),
                           o_diff.reshape(B, S, DIFF_HEADS * DIFF_V_DIM)], axis=-1)
    return out @ w_o


def conv_geglu_ffn(h, w_up, conv_w, conv_b, w_down):
    u = h @ w_up
    pad = CONV_WIDTH // 2
    up = jnp.pad(u, ((0, 0), (pad, pad), (0, 0)))
    S = u.shape[1]
    u = conv_b + sum(up[:, t:t + S] * conv_w[t] for t in range(CONV_WIDTH))
    gate, val = jnp.split(u, 2, axis=-1)
    return (jax.nn.gelu(gate, approximate=True) * val) @ w_down


def setup_inputs(seed: int = 0) -> dict:
    key = jax.random.key(seed)
    ks = jax.random.split(key, 32)
    f32 = jnp.float32
    nrm = lambda k, shape, s: jax.random.normal(k, shape, f32) * s
    L = DEPTH
    x = jax.random.normal(ks[0], (BATCH, SEQ, D_MODEL), f32)
    c = jax.random.normal(ks[1], (BATCH, D_MODEL), f32)
    positions = (jnp.arange(SEQ, dtype=jnp.int32)[None, :]
                 + jax.random.randint(ks[2], (BATCH, 1), 0, 1024, dtype=jnp.int32))
    return {
        "x": x,
        "c": c,
        "positions": positions,
        "rel_bias": nrm(ks[3], (REL_BUCKETS, DIFF_HEADS), 0.5),
        "ada_w": nrm(ks[4], (L, D_MODEL, N_MOD * D_MODEL), 0.5 * D_MODEL ** -0.5),
        "ada_b": nrm(ks[5], (L, N_MOD * D_MODEL), 0.02),
        "attn_pre_norm": 1.0 + nrm(ks[6], (L, D_MODEL), 0.05),
        "attn_post_norm": 1.0 + nrm(ks[7], (L, D_MODEL), 0.05),
        "w_in": nrm(ks[8], (L, D_MODEL, IN_WIDTH), D_MODEL ** -0.5),
        "q_norm": 1.0 + nrm(ks[9], (L, MLA_Q_RANK), 0.05),
        "w_uq": nrm(ks[10], (L, MLA_Q_RANK, MLA_HEADS * (MLA_NOPE_DIM + MLA_ROPE_DIM)), MLA_Q_RANK ** -0.5),
        "kv_norm": 1.0 + nrm(ks[11], (L, MLA_KV_RANK), 0.05),
        "w_ukv": nrm(ks[12], (L, MLA_KV_RANK, MLA_HEADS * (MLA_NOPE_DIM + MLA_V_DIM)), MLA_KV_RANK ** -0.5),
        "lambda_q1": nrm(ks[13], (L, DIFF_QK_DIM), 0.1),
        "lambda_k1": nrm(ks[14], (L, DIFF_QK_DIM), 0.1),
        "lambda_q2": nrm(ks[15], (L, DIFF_QK_DIM), 0.1),
        "lambda_k2": nrm(ks[16], (L, DIFF_QK_DIM), 0.1),
        "diff_subln": 1.0 + nrm(ks[17], (L, DIFF_V_DIM), 0.05),
        "w_o": nrm(ks[18], (L, MIX_WIDTH, D_MODEL), MIX_WIDTH ** -0.5),
        "ffn_pre_norm": 1.0 + nrm(ks[19], (L, D_MODEL), 0.05),
        "ffn_post_norm": 1.0 + nrm(ks[20], (L, D_MODEL), 0.05),
        "w_up": nrm(ks[21], (L, D_MODEL, 2 * D_FF), D_MODEL ** -0.5),
        "conv_w": nrm(ks[22], (L, CONV_WIDTH, 2 * D_FF), CONV_WIDTH ** -0.5),
        "conv_b": nrm(ks[23], (L, 2 * D_FF), 0.02),
        "w_down": nrm(ks[24], (L, D_FF, D_MODEL), D_FF ** -0.5),
    }


def reference(x, c, positions, rel_bias, ada_w, ada_b, attn_pre_norm, attn_post_norm,
              w_in, q_norm, w_uq, kv_norm, w_ukv, lambda_q1, lambda_k1, lambda_q2, lambda_k2,
              diff_subln, w_o, ffn_pre_norm, ffn_post_norm, w_up, conv_w, conv_b, w_down):
    cos, sin = rope_tables(positions)
    c_act = jax.nn.silu(c)
    for l in range(DEPTH):
        lambda_init = 0.8 - 0.6 * math.exp(-0.3 * l)
        mod = c_act @ ada_w[l] + ada_b[l]
        sh_a, sc_a, g_a, sh_f, sc_f, g_f = jnp.split(mod, N_MOD, axis=-1)
        h = modulate(rms_norm(x, attn_pre_norm[l]), sh_a, sc_a)
        y = hybrid_mixer(h, positions, cos, sin, rel_bias, w_in[l], q_norm[l], w_uq[l],
                         kv_norm[l], w_ukv[l], lambda_q1[l], lambda_k1[l], lambda_q2[l],
                         lambda_k2[l], diff_subln[l], w_o[l], lambda_init)
        x = x + g_a[:, None, :] * rms_norm(y, attn_post_norm[l])
        h = modulate(rms_norm(x, ffn_pre_norm[l]), sh_f, sc_f)
        y = conv_geglu_ffn(h, w_up[l], conv_w[l], conv_b[l], w_down[l])
        x = x + g_f[:, None, :] * rms_norm(y, ffn_post_norm[l])
    return x
```

```cpp
#include <hip/hip_runtime.h>
#include <cstdio>
#include <cstdint>
namespace pg8 {
#define PG8_LAS __attribute__((address_space(3)))
typedef unsigned short bf16_t;
typedef short bf16x8 __attribute__((ext_vector_type(8)));
typedef float f32x4 __attribute__((ext_vector_type(4)));
typedef unsigned u32x4 __attribute__((ext_vector_type(4)));
constexpr int BM = 256, BK = 64, HALF = 128, HTB = HALF * BK * 2  , STAGE_BYTES = 8 * HTB, NXCD = 8, WGM = 8;

__host__ __device__ __forceinline__ int lds_byte(int r, int c) { const int st = (r >> 4) * 2 + (c >> 5), rr = r & 15, cc = c & 31, ob = rr * 64 + cc * 2; return st * 1024 + (ob ^ (((ob >> 9) & 1) << 5)); }
__host__ __device__ __forceinline__ void stage_rc(int b, int& R, int& C) { const int st = b / 1024, sb = b % 1024, swz = sb ^ (((sb >> 9) & 1) << 5); R = (st >> 1) * 16 + swz / 64; C = (st & 1) * 32 + (swz % 64) / 2; }
__host__ __device__ __forceinline__ int perm32(int rho) { const int n = rho >> 4, i = rho & 15; return 8 * (i >> 2) + 4 * n + (i & 3); }

struct Unit { int pm, pn; };
struct Gemm { const bf16_t* A; const bf16_t* Bt; int M, N, K, lda, ldb; };

struct StaticOrder {
    int nM, nN, nwg, G, c;
    __host__ __device__ void init(int M, int N, int G_, int c_) { nM = M / BM; nN = N / BM; nwg = nM * nN; G = G_; c = c_; }
    __host__ __device__ bool next(int i, Unit& u) const {
        const long L = (long)i * G + c; if (L >= nwg) return false;
        int wgid = (int)L; { const int q = nwg / NXCD, r = nwg % NXCD, xcd = wgid % NXCD, off = wgid / NXCD; wgid = (xcd < r ? xcd * (q + 1) : r * (q + 1) + (xcd - r) * q) + off; }
        const int nig = WGM * nN, gid = wgid / nig, fm = gid * WGM, gsz = (nM - fm) < WGM ? (nM - fm) : WGM;
        u.pm = fm + ((wgid % nig) % gsz); u.pn = (wgid % nig) / gsz; return true;
    }
    __device__ __forceinline__ void a_ready(const Unit&) const {}
    __device__ __forceinline__ void done(const Unit&) const {}
};


__device__ __forceinline__ unsigned cvt_pk_bf16(float lo, float hi) { unsigned r; asm volatile("v_cvt_pk_bf16_f32 %0, %1, %2" : "=v"(r) : "v"(lo), "v"(hi)); return r; }

struct EpiF32 {
    static constexpr bool PERM = false, AFTER_DRAIN = false;
    float* C; int ldc;
    __device__ __forceinline__ void operator()(const f32x4 (&acc)[2][2][4][2], const Unit& u, int wr, int wc, int fr, int fq) const {
        const int row0 = u.pm * BM + wr * 64 + fr, col0 = u.pn * BM + wc * 32 + 4 * fq;
#pragma unroll
        for (int ai = 0; ai < 2; ++ai)
#pragma unroll
            for (int m = 0; m < 4; ++m) { float* rowp = C + (size_t)(row0 + ai * HALF + m * 16) * ldc + col0;
#pragma unroll
                for (int bj = 0; bj < 2; ++bj)
#pragma unroll
                    for (int n = 0; n < 2; ++n) *(f32x4*)(rowp + bj * HALF + n * 16) = acc[ai][bj][m][n]; }
    }
};
struct EpiBf16 {
    static constexpr bool PERM = true, AFTER_DRAIN = false;
    bf16_t* O; int ldc;
    __device__ __forceinline__ void operator()(const f32x4 (&acc)[2][2][4][2], const Unit& u, int wr, int wc, int fr, int fq) const {
        const int row0 = u.pm * BM + wr * 64 + fr; const int col0 = u.pn * BM + wc * 32 + 8 * fq;
#pragma unroll
        for (int ai = 0; ai < 2; ++ai)
#pragma unroll
            for (int m = 0; m < 4; ++m) { bf16_t* rowp = O + (size_t)(row0 + ai * HALF + m * 16) * ldc + col0;
#pragma unroll
                for (int bj = 0; bj < 2; ++bj) { const f32x4 v0 = acc[ai][bj][m][0], v1 = acc[ai][bj][m][1];
                    u32x4 w; w.x = cvt_pk_bf16(v0[0], v0[1]); w.y = cvt_pk_bf16(v0[2], v0[3]); w.z = cvt_pk_bf16(v1[0], v1[1]); w.w = cvt_pk_bf16(v1[2], v1[3]);
                    *(u32x4*)(rowp + bj * HALF) = w; } }
    }
};
template <class Epi, class Sched, bool ALIGN_EPI = false, bool SP2 = false>
__device__ __forceinline__ void gemm_phase(PG8_LAS unsigned char* lds, const Gemm g, const Sched& S, const Epi& E) {
    const int tid = threadIdx.x, wid = __builtin_amdgcn_readfirstlane(tid >> 6), lane = tid & 63, wr = wid >> 2, wc = wid & 3, fr = lane & 15, fq = lane >> 4;
    const int K = g.K, nt = K / BK;
    unsigned voffA[2], voffB[2];
#pragma unroll
    for (int i = 0; i < 2; ++i) { int R, C; stage_rc(tid * 16 + i * 8192, R, C); const int Rb = Epi::PERM ? ((R & ~31) + perm32(R & 31)) : R;
        voffA[i] = (unsigned)(R * g.lda + C) * 2u; voffB[i] = (unsigned)(Rb * g.ldb + C) * 2u; }
    const size_t kstep = (size_t)(BK * 2);
    const size_t hsA = (size_t)HALF * g.lda * 2, hsB = (size_t)HALF * g.ldb * 2;
    const size_t tsA = 2 * hsA, tsB = 2 * hsB;
    const unsigned ldsw = (unsigned)wid * 1024u;
    const int aoff = lds_byte(wr * 64 + fr, fq * 8), boff = lds_byte(wc * 32 + fr, fq * 8);
#define PG8_SA(b, h) (((b) * 2 + (h)) * HTB)
#define PG8_SB(b, h) ((4 + (b) * 2 + (h)) * HTB)
#define PG8_STAGE(bufoff, gbase, voff) do { _Pragma("unroll") for (int _i = 0; _i < 2; ++_i) \
        __builtin_amdgcn_global_load_lds((const unsigned*)((const char*)(gbase) + (voff)[_i]), (PG8_LAS unsigned*)(lds + (bufoff) + ldsw + _i * 8192), 16, 0, 0); } while (0)
#define PG8_LDA(dst, b, h) do { _Pragma("unroll") for (int m = 0; m < 4; ++m) _Pragma("unroll") for (int k = 0; k < 2; ++k) dst[m][k] = *(const PG8_LAS bf16x8*)(lds + PG8_SA(b, h) + aoff + m * 2048 + k * 1024); } while (0)
#define PG8_LDB(dst, b, h) do { _Pragma("unroll") for (int n = 0; n < 2; ++n) _Pragma("unroll") for (int k = 0; k < 2; ++k) dst[n][k] = *(const PG8_LAS bf16x8*)(lds + PG8_SB(b, h) + boff + n * 2048 + k * 1024); } while (0)
#define PG8_MMA(ai, bj, At, Bt) do { __builtin_amdgcn_s_setprio(1); _Pragma("unroll") for (int m = 0; m < 4; ++m) _Pragma("unroll") for (int n = 0; n < 2; ++n) _Pragma("unroll") for (int k = 0; k < 2; ++k) \
        acc[ai][bj][m][n] = __builtin_amdgcn_mfma_f32_16x16x32_bf16(Bt[n][k], At[m][k], acc[ai][bj][m][n], 0, 0, 0); __builtin_amdgcn_s_setprio(0); } while (0)
#define PG8_WAIT_V(n) asm volatile("s_waitcnt vmcnt(" #n ")" ::: "memory")
#define PG8_WAIT_L(n) asm volatile("s_waitcnt lgkmcnt(" #n ")" ::: "memory")
#define PG8_BAR __builtin_amdgcn_s_barrier()
#define PG8_SCHED __builtin_amdgcn_sched_barrier(0)
    Unit cur, nxt; int ui = 0;
    if (!S.next(0, cur)) return;
    f32x4 acc[2][2][4][2];
#pragma unroll
    for (int a = 0; a < 2; ++a)
#pragma unroll
        for (int b = 0; b < 2; ++b)
#pragma unroll
            for (int m = 0; m < 4; ++m)
#pragma unroll
                for (int n = 0; n < 2; ++n) acc[a][b][m][n] = (f32x4){0.f, 0.f, 0.f, 0.f};
    bf16x8 At[4][2], B0[2][2], B1[2][2];
    const char* cA = (const char*)g.A + (size_t)cur.pm * tsA; const char* cB = (const char*)g.Bt + (size_t)cur.pn * tsB;
    S.a_ready(cur);
    if constexpr (SP2) {
        PG8_STAGE(PG8_SB(0, 0), cB, voffB); PG8_STAGE(PG8_SB(0, 1), cB + hsB, voffB); PG8_STAGE(PG8_SA(0, 0), cA, voffA); PG8_STAGE(PG8_SA(0, 1), cA + hsA, voffA);
        if (wr == 1) PG8_BAR;
        PG8_WAIT_V(2); PG8_BAR;
        PG8_STAGE(PG8_SB(1, 0), cB + kstep, voffB); PG8_STAGE(PG8_SA(1, 0), cA + kstep, voffA); PG8_STAGE(PG8_SB(1, 1), cB + hsB + kstep, voffB);
        PG8_WAIT_V(6); PG8_BAR;
    } else {
        PG8_STAGE(PG8_SB(0, 0), cB, voffB); PG8_STAGE(PG8_SA(0, 0), cA, voffA); PG8_STAGE(PG8_SB(0, 1), cB + hsB, voffB); PG8_STAGE(PG8_SA(0, 1), cA + hsA, voffA);
        if (wr == 1) PG8_BAR;
        PG8_WAIT_V(4); PG8_BAR;
        PG8_STAGE(PG8_SB(1, 0), cB + kstep, voffB); PG8_STAGE(PG8_SA(1, 0), cA + kstep, voffA); PG8_STAGE(PG8_SB(1, 1), cB + hsB + kstep, voffB);
        PG8_WAIT_V(6); PG8_BAR;
    }
    for (;;) {
        const bool has_next = S.next(ui + 1, nxt);
        const char* nA = has_next ? (const char*)g.A + (size_t)nxt.pm * tsA : cA; const char* nB = has_next ? (const char*)g.Bt + (size_t)nxt.pn * tsB : cB;
        for (int t = 0; t < nt; t += 2) {
            const bool last = (t == nt - 2);
            const char* a1 = cA + (size_t)(t + 1) * kstep;
            const char* a2 = last ? nA : cA + (size_t)(t + 2) * kstep; const char* b2 = last ? nB : cB + (size_t)(t + 2) * kstep;
            const char* a3 = a2 + kstep; const char* b3 = b2 + kstep;
            if (last && has_next) S.a_ready(nxt);
            if constexpr (SP2) {
            PG8_LDB(B0, 0, 0); PG8_LDB(B1, 0, 1); PG8_SCHED; PG8_LDA(At, 0, 0); PG8_STAGE(PG8_SA(1, 1), a1 + hsA, voffA);
            PG8_WAIT_V(8); PG8_WAIT_L(0); PG8_BAR; PG8_MMA(0, 0, At, B0); PG8_MMA(0, 1, At, B1); PG8_BAR; PG8_SCHED;
            PG8_LDA(At, 0, 1); PG8_STAGE(PG8_SB(0, 0), b2, voffB); PG8_STAGE(PG8_SB(0, 1), b2 + hsB, voffB); PG8_STAGE(PG8_SA(0, 0), a2, voffA);
            PG8_WAIT_V(8); PG8_WAIT_L(0); PG8_BAR; PG8_MMA(1, 0, At, B0); PG8_MMA(1, 1, At, B1); PG8_BAR; PG8_SCHED;
            PG8_LDB(B0, 1, 0); PG8_LDB(B1, 1, 1); PG8_SCHED; PG8_LDA(At, 1, 0); PG8_STAGE(PG8_SA(0, 1), a2 + hsA, voffA);
            PG8_WAIT_V(8); PG8_WAIT_L(0); PG8_BAR; PG8_MMA(0, 0, At, B0); PG8_MMA(0, 1, At, B1); PG8_BAR; PG8_SCHED;
            PG8_LDA(At, 1, 1); PG8_STAGE(PG8_SB(1, 0), b3, voffB); PG8_STAGE(PG8_SB(1, 1), b3 + hsB, voffB); PG8_STAGE(PG8_SA(1, 0), a3, voffA);
            PG8_WAIT_V(8); PG8_WAIT_L(0); PG8_BAR; PG8_MMA(1, 0, At, B0); PG8_MMA(1, 1, At, B1); PG8_BAR; PG8_SCHED;
            } else {
            PG8_LDB(B0, 0, 0); PG8_SCHED; PG8_LDA(At, 0, 0); PG8_STAGE(PG8_SA(1, 1), a1 + hsA, voffA);
            PG8_WAIT_L(8); PG8_BAR; PG8_WAIT_L(0); PG8_MMA(0, 0, At, B0); PG8_BAR; PG8_SCHED;
            PG8_LDB(B1, 0, 1); PG8_STAGE(PG8_SB(0, 0), b2, voffB);
            PG8_BAR; PG8_WAIT_L(0); PG8_MMA(0, 1, At, B1); PG8_BAR;
            PG8_LDA(At, 0, 1); PG8_STAGE(PG8_SA(0, 0), a2, voffA);
            PG8_BAR; PG8_WAIT_L(0); PG8_MMA(1, 0, At, B0); PG8_BAR; PG8_SCHED;
            PG8_STAGE(PG8_SB(0, 1), b2 + hsB, voffB);
            PG8_WAIT_V(6); PG8_BAR; PG8_MMA(1, 1, At, B1); PG8_BAR;
            PG8_LDB(B0, 1, 0); PG8_SCHED; PG8_LDA(At, 1, 0); PG8_STAGE(PG8_SA(0, 1), a2 + hsA, voffA);
            PG8_WAIT_L(8); PG8_BAR; PG8_WAIT_L(0); PG8_MMA(0, 0, At, B0); PG8_BAR; PG8_SCHED;
            PG8_LDB(B1, 1, 1); PG8_STAGE(PG8_SB(1, 0), b3, voffB);
            PG8_BAR; PG8_WAIT_L(0); PG8_MMA(0, 1, At, B1); PG8_BAR;
            PG8_LDA(At, 1, 1); PG8_STAGE(PG8_SA(1, 0), a3, voffA);
            PG8_BAR; PG8_WAIT_L(0); PG8_MMA(1, 0, At, B0); PG8_BAR; PG8_SCHED;
            PG8_STAGE(PG8_SB(1, 1), b3 + hsB, voffB);
            PG8_WAIT_V(6); PG8_BAR; PG8_MMA(1, 1, At, B1); PG8_BAR;
            }
        }
        if constexpr (ALIGN_EPI) { if (wr == 0) PG8_BAR; }
        if constexpr (!Epi::AFTER_DRAIN) { E(acc, cur, wr, wc, fr, fq); S.done(cur); }
        if (!has_next) break;
#pragma unroll
        for (int a = 0; a < 2; ++a)
#pragma unroll
            for (int b = 0; b < 2; ++b)
#pragma unroll
                for (int m = 0; m < 4; ++m)
#pragma unroll
                    for (int n = 0; n < 2; ++n) acc[a][b][m][n] = (f32x4){0.f, 0.f, 0.f, 0.f};
        cur = nxt; cA = nA; cB = nB; ++ui;
        if constexpr (ALIGN_EPI) { if (wr == 1) PG8_BAR; }
    }
    PG8_WAIT_V(0);
    if constexpr (!ALIGN_EPI) { if (wr == 0) PG8_BAR; }
    PG8_BAR;
    if constexpr (Epi::AFTER_DRAIN) { E.fused(acc, cur, wr, wc, fr, fq, lds, wid, lane); S.done(cur); }
#undef PG8_SA
#undef PG8_SB
#undef PG8_STAGE
#undef PG8_LDA
#undef PG8_LDB
#undef PG8_MMA
#undef PG8_WAIT_V
#undef PG8_WAIT_L
#undef PG8_BAR
#undef PG8_SCHED
}
}
#define GAS __attribute__((address_space(1)))
#define LAS __attribute__((address_space(3)))
typedef unsigned short bf16;
typedef unsigned v4u __attribute__((ext_vector_type(4)));
typedef float f32x4 __attribute__((ext_vector_type(4)));
typedef short bf16x8 __attribute__((ext_vector_type(8)));
typedef GAS unsigned gu32;
typedef GAS unsigned long long gu64;
#define RLX_AGENT __ATOMIC_RELAXED, __HIP_MEMORY_SCOPE_AGENT
#define LDS_WAIT() asm volatile("s_waitcnt lgkmcnt(0)" ::: "memory")
#define VM_WAIT() asm volatile("s_waitcnt vmcnt(0)" ::: "memory")
__device__ __forceinline__ unsigned long long rt() { return __builtin_amdgcn_s_memrealtime(); }
__device__ __forceinline__ unsigned f2bf(float f) { unsigned u = __builtin_bit_cast(unsigned, f); return (u + 0x7fffu + ((u >> 16) & 1u)) >> 16; }
__device__ __forceinline__ unsigned pk2(float lo, float hi) { return f2bf(lo) | (f2bf(hi) << 16); }

#define XB_TMO      128
#define XB_XCNT(j)  (256  + 64 * (j))
#define XB_XSUB(j)  (1280 + 64 * (j))
#define XB_XGEN(j)  (2304 + 64 * (j))
#define XB_TOP      3328
#define XB_TOPGEN   3392
#define XCD_BAR_WORDS 3456
#define XB_SPIN_CAP (1u << 18)

__device__ __forceinline__ unsigned xb_ld(unsigned* p)              { return __hip_atomic_load(p, __ATOMIC_RELAXED, __HIP_MEMORY_SCOPE_AGENT); }
__device__ __forceinline__ unsigned xb_add(unsigned* p, unsigned v) { return __hip_atomic_fetch_add(p, v, __ATOMIC_RELAXED, __HIP_MEMORY_SCOPE_AGENT); }
__device__ __forceinline__ unsigned xb_xcc_id() { return (unsigned)__builtin_amdgcn_s_getreg((3 << 11) | 20) & 0xFu; }
#define XB_SPIN(cond, bar) do { unsigned _sp = 0; while (cond) { __builtin_amdgcn_s_sleep(1); \
    if ((++_sp & 255u) == 0u) { if (xb_ld(&(bar)[XB_TMO])) break; if (_sp > XB_SPIN_CAP) { atomicAdd(&(bar)[XB_TMO], 1u); break; } } } } while (0)

struct XcdBarrier {
    unsigned* bar; unsigned x;
    volatile LAS unsigned* st;
};

__device__ __forceinline__ XcdBarrier xcd_barrier_post(unsigned* bar, volatile LAS unsigned* st) {
    XcdBarrier b; b.bar = bar; b.x = xb_xcc_id(); b.st = st;
    if (threadIdx.x == 0) (void)xb_add(&bar[XB_XCNT(b.x)], 1u);
    return b;
}
__device__ __forceinline__ void xcd_barrier_complete(unsigned* bar, unsigned x, unsigned& nloc, unsigned& nx) {
    const unsigned G = gridDim.x * gridDim.y * gridDim.z;
    unsigned sum, cnt, mine, sp = 0u;
    for (;;) {
        sum = 0u; cnt = 0u; mine = 0u;
#pragma unroll
        for (unsigned j = 0; j < 16; ++j) { const unsigned c = xb_ld(&bar[XB_XCNT(j)]); sum += c; cnt += (c > 0u) ? 1u : 0u; mine = (j == x) ? c : mine; }
        if (sum == G) break;
        __builtin_amdgcn_s_sleep(1);
        if ((++sp & 255u) == 0u) { if (xb_ld(&bar[XB_TMO])) break; if (sp > XB_SPIN_CAP) { atomicAdd(&bar[XB_TMO], 1u); break; } }
    }
    nloc = mine > 0u ? mine : 1u; nx = cnt > 0u ? cnt : 1u;
}

__device__ __forceinline__ void xcd_barrier(const XcdBarrier& b) {
    asm volatile("s_waitcnt vmcnt(0)" ::: "memory");
    __syncthreads();
    if (threadIdx.x == 0) {
        unsigned* bar = b.bar;
        __builtin_amdgcn_s_waitcnt(0);
        unsigned nloc = b.st[0], nx = b.st[1];
        if (nloc == 0u) { xcd_barrier_complete(bar, b.x, nloc, nx); b.st[0] = nloc; b.st[1] = nx; }
        const unsigned old = xb_add(&bar[XB_XSUB(b.x)], 1u);
        const unsigned gen = old / nloc;
        if (old + 1u == (gen + 1u) * nloc) {
            __builtin_amdgcn_fence(__ATOMIC_RELEASE, "agent");
            asm volatile("s_waitcnt vmcnt(0)" ::: "memory");
            const unsigned og = xb_add(&bar[XB_TOP], 1u);
            const unsigned tg = og / nx;
            if (og + 1u == (tg + 1u) * nx) xb_add(&bar[XB_TOPGEN], 1u);
            else XB_SPIN(xb_ld(&bar[XB_TOPGEN]) == tg, bar);
            __builtin_amdgcn_fence(__ATOMIC_ACQUIRE, "agent");
            xb_add(&bar[XB_XGEN(b.x)], 1u);
            asm volatile("s_waitcnt vmcnt(0)" ::: "memory");
        } else {
            XB_SPIN(xb_ld(&bar[XB_XGEN(b.x)]) == gen, bar);
            __builtin_amdgcn_fence(__ATOMIC_ACQUIRE, "agent");
            asm volatile("s_waitcnt vmcnt(0)" ::: "memory");
        }
    }
    __syncthreads();
}

constexpr int NWAVES = 8, NTHREADS = 512;
constexpr int BATCH = 8, SEQ = 2048, DM = 2048, M = BATCH * SEQ;
constexpr int INW = 3904, INWP = 4096;
constexpr int QW = 1536, KVW = 2048, FF = 5632, FF2 = 11264, NMOD = 12288;
constexpr int C_QLAT = 0, C_KVLAT = 512, C_KROPE = 768, C_DQ = 832, C_DK = 1856, C_DV = 2880;
constexpr int MOD_SHA = 0, MOD_SCA = 2048, MOD_GA = 4096, MOD_SHF = 6144, MOD_SCF = 8192, MOD_GF = 10240;
constexpr float EPS = 1e-6f, MLA_SCALE = 0.07216878364870322f, DIFF_SCALE = 0.125f, LAMBDA_INIT = 0.2f;
constexpr int UCH = 4096, NUCH = M / UCH;

constexpr size_t MiB = 1u << 20;
constexpr size_t WS_CTL = 0, CTL_ZERO_BYTES = 1 * MiB, WS_MOD = 512 * 1024;
constexpr size_t WS_COS = 2 * MiB, WS_SIN = 4 * MiB;
constexpr size_t WS_WIN = 8 * MiB, WS_WUQ = 24 * MiB, WS_WUKV = 26 * MiB, WS_WO = 28 * MiB, WS_WUP = 36 * MiB, WS_WDN = 80 * MiB;
constexpr size_t WS_H = 104 * MiB;
constexpr size_t WS_PROJ = 168 * MiB, WS_Q = 296 * MiB, WS_KV = 344 * MiB, WS_AO = 408 * MiB;
constexpr size_t WS_Y = 168 * MiB;
constexpr size_t WS_G = 168 * MiB;
constexpr size_t WS_U = 344 * MiB;
constexpr size_t WS_Y2 = 344 * MiB;
constexpr size_t WS_END = 512 * MiB;
constexpr int CW_TMO = 0, CW_CODE = 1, CW_BAR = 4096;

constexpr int LDS_BYTES = 147456;
constexpr int LDSCTL_OFF = LDS_BYTES - 512, MISC_OFF = LDSCTL_OFF;

__device__ __forceinline__ float bf2f(unsigned short u) { return __uint_as_float((unsigned)u << 16); }
__device__ __forceinline__ float bflo(unsigned w) { return __uint_as_float(w << 16); }
__device__ __forceinline__ float bfhi(unsigned w) { return __uint_as_float(w & 0xffff0000u); }
__device__ __forceinline__ float wave_sum(float v) {
#pragma unroll
    for (int o = 1; o < 64; o <<= 1) v += __shfl_xor(v, o);
    return v;
}
__device__ __forceinline__ float wave_max(float v) {
#pragma unroll
    for (int o = 1; o < 64; o <<= 1) v = fmaxf(v, __shfl_xor(v, o));
    return v;
}
__device__ __forceinline__ int t5_bucket(int rel) {
    const int ret = rel > 0 ? 16 : 0; const int n = rel < 0 ? -rel : rel; const float nf = (float)(n > 1 ? n : 1);
    int large = 8 + (int)(logf(nf / 8.0f) / 2.772588722239781f * 8.0f);
    large = large < 15 ? large : 15;
    return ret + (n < 8 ? n : large);
}
__device__ __forceinline__ float gelu_tanh(float x) {
    const float z2 = 1.5957691216057308f * (x + 0.044715f * x * x * x);
    return x / (1.0f + __expf(-z2));
}


constexpr int PTR_OFF = LDSCTL_OFF + 128;
enum { P_X = 0, P_C, P_POS, P_RELB, P_ADAW, P_ADAB, P_APRE, P_APOST, P_WIN, P_QN, P_WUQ, P_KVN, P_WUKV, P_LQ1, P_LK1, P_LQ2, P_LK2, P_SUBLN, P_WO, P_FPRE, P_FPOST, P_WUP, P_CW, P_CB, P_WDN, P_OUT, P_WS };
__device__ __forceinline__ const void* ldptr(LAS unsigned char* lds, int i) {
    const unsigned long long v = *(volatile LAS unsigned long long*)(lds + PTR_OFF + 8 * i);
    const unsigned lo = __builtin_amdgcn_readfirstlane((unsigned)v), hi = __builtin_amdgcn_readfirstlane((unsigned)(v >> 32));
    return (const void*)(GAS const void*)(((unsigned long long)hi << 32) | lo);
}
#define LPF(i) ((const float*)ldptr(lds, (i)))
#define LPWS() ((unsigned char*)ldptr(lds, P_WS))

__device__ __forceinline__ void p0_transpose_item(const float* W, const float* sv, int K, int N, bf16* WT, LAS float* scr, int item, int lane) {
    const int nblk = N / 32, kb = item / nblk, nb = item % nblk, k0 = 64 * kb, n0 = 32 * nb;
#pragma unroll 8
    for (int i = 0; i < 32; ++i) { const int kk = 2 * i + (lane >> 5); float w = W[(size_t)(k0 + kk) * N + n0 + (lane & 31)]; if (sv) w *= sv[k0 + kk]; scr[kk * 33 + (lane & 31)] = w; }
    LDS_WAIT(); asm volatile("" ::: "memory");
    const int c = lane & 7;
#pragma unroll
    for (int j = 0; j < 4; ++j) { const int n = (lane >> 3) + 8 * j; const LAS float* s = scr + (8 * c) * 33 + n;
        v4u o; o.x = pk2(s[0 * 33], s[1 * 33]); o.y = pk2(s[2 * 33], s[3 * 33]); o.z = pk2(s[4 * 33], s[5 * 33]); o.w = pk2(s[6 * 33], s[7 * 33]);
        *(GAS v4u*)(WT + (size_t)(n0 + n) * K + k0 + 8 * c) = o; }
    LDS_WAIT(); asm volatile("" ::: "memory");
}
__device__ __forceinline__ void p0_prologue(LAS unsigned char* lds, int tid, int lane, int wave, int G, int bid) {
    { unsigned char* ws = LPWS(); float* mod = (float*)(ws + WS_MOD); const float* in_c = LPF(P_C); const float* in_adaw = LPF(P_ADAW); const float* in_adab = LPF(P_ADAB);
    for (int item = bid; item < 256; item += G) {
        const int kc = item >> 5, cc = item & 31;
        LAS float* scl = (LAS float*)lds;
        LAS float* red = (LAS float*)(lds + 8192);
        for (int e = tid; e < 2048; e += NTHREADS) { const int b = e >> 8, i = e & 255; const float cv = in_c[b * DM + 256 * kc + i]; scl[e] = cv / (1.0f + __expf(-cv)); }
        __syncthreads();
        const int kg = tid >> 7, ct = tid & 127;
        float acc[8][3];
#pragma unroll
        for (int b = 0; b < 8; ++b) { acc[b][0] = 0.f; acc[b][1] = 0.f; acc[b][2] = 0.f; }
        const float* wp = in_adaw + (size_t)(256 * kc + 64 * kg) * NMOD + 384 * cc + ct;
#pragma unroll 4
        for (int kk = 0; kk < 64; ++kk) {
            const float w0 = wp[(size_t)kk * NMOD], w1 = wp[(size_t)kk * NMOD + 128], w2 = wp[(size_t)kk * NMOD + 256];
#pragma unroll
            for (int b = 0; b < 8; ++b) { const float s = scl[b * 256 + 64 * kg + kk]; acc[b][0] += s * w0; acc[b][1] += s * w1; acc[b][2] += s * w2; }
        }
#pragma unroll
        for (int b = 0; b < 8; ++b)
#pragma unroll
            for (int i = 0; i < 3; ++i) red[(kg * 8 + b) * 384 + ct + 128 * i] = acc[b][i];
        __syncthreads();
        for (int o = tid; o < 3072; o += NTHREADS) { const int b = o / 384, col = o % 384;
            float v = (red[(0 * 8 + b) * 384 + col] + red[(1 * 8 + b) * 384 + col]) + (red[(2 * 8 + b) * 384 + col] + red[(3 * 8 + b) * 384 + col]);
            if (kc == 0) v += in_adab[384 * cc + col];
            atomicAdd(mod + b * NMOD + 384 * cc + col, v); }
        __syncthreads();
    } }
    unsigned char* ws = LPWS();
    LAS float* scr = (LAS float*)(lds + wave * 16384);
    const int gw = bid * NWAVES + wave, NGW = G * NWAVES;
    constexpr int I_IN = (DM / 64) * (INW / 32), I_UQ = (512 / 64) * (QW / 32), I_UKV = (256 / 64) * (KVW / 32), I_O = (DM / 64) * (DM / 32), I_UP = (DM / 64) * (FF2 / 32), I_DN = (FF / 64) * (DM / 32);
    constexpr int NITEMS = I_IN + I_UQ + I_UKV + I_O + I_UP + I_DN;
    for (int it = gw; it < NITEMS; it += NGW) {
        int r = it;
        if (r < I_IN) { p0_transpose_item(LPF(P_WIN), nullptr, DM, INW, (bf16*)(ws + WS_WIN), scr, r, lane); continue; } r -= I_IN;
        if (r < I_UQ) { p0_transpose_item(LPF(P_WUQ), LPF(P_QN), 512, QW, (bf16*)(ws + WS_WUQ), scr, r, lane); continue; } r -= I_UQ;
        if (r < I_UKV) { p0_transpose_item(LPF(P_WUKV), LPF(P_KVN), 256, KVW, (bf16*)(ws + WS_WUKV), scr, r, lane); continue; } r -= I_UKV;
        if (r < I_O) { p0_transpose_item(LPF(P_WO), nullptr, DM, DM, (bf16*)(ws + WS_WO), scr, r, lane); continue; } r -= I_O;
        if (r < I_UP) { p0_transpose_item(LPF(P_WUP), nullptr, DM, FF2, (bf16*)(ws + WS_WUP), scr, r, lane); continue; } r -= I_UP;
        p0_transpose_item(LPF(P_WDN), nullptr, FF, DM, (bf16*)(ws + WS_WDN), scr, r, lane);
    }
    { v4u* z = (v4u*)(ws + WS_WIN + (size_t)INW * DM * 2); const v4u zero = {0u, 0u, 0u, 0u};
      for (int i = bid * NTHREADS + tid; i < (INWP - INW) * DM * 2 / 16; i += G * NTHREADS) z[i] = zero; }
    { float* COS = (float*)(ws + WS_COS); float* SIN = (float*)(ws + WS_SIN); const int* in_pos = (const int*)ldptr(lds, P_POS);
      for (int idx = bid * NTHREADS + tid; idx < M * 32; idx += G * NTHREADS) {
          const int m = idx >> 5, i = idx & 31;
          const float inv = 1.0f / exp2f((float)i * (13.287712379549449f / 32.0f));
          const float ang = (float)in_pos[m] * inv;
          double t = (double)ang * 0.15915494309189535; t -= rint(t);
          const float tf = (float)t;
          COS[idx] = __builtin_amdgcn_cosf(tf); SIN[idx] = __builtin_amdgcn_sinf(tf); } }
}

__device__ __forceinline__ void prenorm_phase(const float* x, const float* wn, const float* mod, int off_sh, int off_sc, bf16* H, int lane, int wave, int G, int bid) {
    const int gw = bid * NWAVES + wave, NGW = G * NWAVES;
    for (int m = gw; m < M; m += NGW) {
        const f32x4* xr = (const f32x4*)(x + (size_t)m * DM) + lane;
        f32x4 v[8]; float ss = 0.f;
#pragma unroll
        for (int j = 0; j < 8; ++j) { v[j] = xr[64 * j]; ss += (v[j].x * v[j].x + v[j].y * v[j].y) + (v[j].z * v[j].z + v[j].w * v[j].w); }
        const float rstd = rsqrtf(wave_sum(ss) * (1.0f / DM) + EPS);
        const float* mb = mod + (size_t)(m >> 11) * NMOD;
#pragma unroll
        for (int j = 0; j < 8; ++j) { const int col = (lane + 64 * j) * 4;
            const f32x4 w = *(const f32x4*)(wn + col), sh = *(const f32x4*)(mb + off_sh + col), sc = *(const f32x4*)(mb + off_sc + col);
            const f32x4 o = v[j] * rstd * w * (sc + 1.0f) + sh;
            uint2 pk; pk.x = pk2(o.x, o.y); pk.y = pk2(o.z, o.w);
            *(uint2*)(H + (size_t)m * DM + col) = pk; }
    }
}
template <bool NEXT>
__device__ __forceinline__ void post_phase(const float* Y, const float* xin, float* xout, const float* wpost, const float* mod, int off_g,
                                           const float* wn2, int off_sh, int off_sc, bf16* Hn, int lane, int wave, int G, int bid) {
    const int gw = bid * NWAVES + wave, NGW = G * NWAVES;
    for (int m = gw; m < M; m += NGW) {
        const f32x4* yr = (const f32x4*)(Y + (size_t)m * DM) + lane;
        const f32x4* xr = (const f32x4*)(xin + (size_t)m * DM) + lane;
        f32x4 v[8]; float ss = 0.f;
#pragma unroll
        for (int j = 0; j < 8; ++j) { v[j] = yr[64 * j]; ss += (v[j].x * v[j].x + v[j].y * v[j].y) + (v[j].z * v[j].z + v[j].w * v[j].w); }
        const float rstd = rsqrtf(wave_sum(ss) * (1.0f / DM) + EPS);
        const float* mb = mod + (size_t)(m >> 11) * NMOD;
        float ss2 = 0.f;
#pragma unroll
        for (int j = 0; j < 8; ++j) { const int col = (lane + 64 * j) * 4;
            const f32x4 w = *(const f32x4*)(wpost + col), g = *(const f32x4*)(mb + off_g + col), xv = xr[64 * j];
            const f32x4 o = xv + g * (v[j] * rstd * w);
            v[j] = o; ss2 += (o.x * o.x + o.y * o.y) + (o.z * o.z + o.w * o.w);
            *(f32x4*)(xout + (size_t)m * DM + col) = o; }
        if (NEXT) {
            const float rstd2 = rsqrtf(wave_sum(ss2) * (1.0f / DM) + EPS);
#pragma unroll
            for (int j = 0; j < 8; ++j) { const int col = (lane + 64 * j) * 4;
                const f32x4 w = *(const f32x4*)(wn2 + col), sh = *(const f32x4*)(mb + off_sh + col), sc = *(const f32x4*)(mb + off_sc + col);
                const f32x4 o = v[j] * rstd2 * w * (sc + 1.0f) + sh;
                uint2 pk; pk.x = pk2(o.x, o.y); pk.y = pk2(o.z, o.w);
                *(uint2*)(Hn + (size_t)m * DM + col) = pk; }
        }
    }
}
__device__ __forceinline__ void krope_phase(bf16* PROJ, const float* COS, const float* SIN, int tid, int G, int bid) {
    for (int idx = bid * NTHREADS + tid; idx < M * 32; idx += G * NTHREADS) {
        const int m = idx >> 5, i = idx & 31;
        bf16* p = PROJ + (size_t)m * INWP + C_KROPE + i;
        const float a = bf2f(p[0]), b = bf2f(p[32]), c = COS[idx], s = SIN[idx];
        p[0] = (bf16)f2bf(a * c - b * s); p[32] = (bf16)f2bf(a * s + b * c);
    }
}
__device__ __forceinline__ void qkvpost_phase(const bf16* PROJ, bf16* Q, bf16* KV, const float* COS, const float* SIN, int lane, int wave, int G, int bid) {
    const int gw = bid * NWAVES + wave, NGW = G * NWAVES;
    for (int m = gw; m < M; m += NGW) {
        const bf16* pr = PROJ + (size_t)m * INWP;
        float sq = 0.f, sk = 0.f;
        { const v4u raw = *(const v4u*)(pr + C_QLAT + lane * 8);
          const float a0 = bflo(raw.x), a1 = bfhi(raw.x), a2 = bflo(raw.y), a3 = bfhi(raw.y), a4 = bflo(raw.z), a5 = bfhi(raw.z), a6 = bflo(raw.w), a7 = bfhi(raw.w);
          sq = (a0 * a0 + a1 * a1) + (a2 * a2 + a3 * a3) + (a4 * a4 + a5 * a5) + (a6 * a6 + a7 * a7); }
        { const uint2 raw = *(const uint2*)(pr + C_KVLAT + lane * 4);
          const float a0 = bflo(raw.x), a1 = bfhi(raw.x), a2 = bflo(raw.y), a3 = bfhi(raw.y);
          sk = (a0 * a0 + a1 * a1) + (a2 * a2 + a3 * a3); }
        const float rq = rsqrtf(wave_sum(sq) * (1.0f / 512.0f) + EPS), rk = rsqrtf(wave_sum(sk) * (1.0f / 256.0f) + EPS);
        bf16* qr = Q + (size_t)m * QW;
#pragma unroll 4
        for (int j = 0; j < 16; ++j) { const int e = lane + 64 * j, h = e >> 7, d = e & 127; bf16* p = qr + h * 192 + d; *p = (bf16)f2bf(bf2f(*p) * rq); }
#pragma unroll
        for (int j = 0; j < 4; ++j) { const int p_ = lane + 64 * j, h = p_ >> 5, i = p_ & 31; bf16* p = qr + h * 192 + 128 + i;
            const float a = bf2f(p[0]) * rq, b = bf2f(p[32]) * rq, c = COS[m * 32 + i], s = SIN[m * 32 + i];
            p[0] = (bf16)f2bf(a * c - b * s); p[32] = (bf16)f2bf(a * s + b * c); }
        bf16* kr = KV + (size_t)m * KVW;
#pragma unroll
        for (int j = 0; j < 4; ++j) { v4u raw = *(v4u*)(kr + (lane + 64 * j) * 8);
            raw.x = pk2(bflo(raw.x) * rk, bfhi(raw.x) * rk); raw.y = pk2(bflo(raw.y) * rk, bfhi(raw.y) * rk);
            raw.z = pk2(bflo(raw.z) * rk, bfhi(raw.z) * rk); raw.w = pk2(bflo(raw.w) * rk, bfhi(raw.w) * rk);
            *(v4u*)(kr + (lane + 64 * j) * 8) = raw; }
    }
}
__device__ __forceinline__ void conv_phase(const bf16* U, bf16* Gb, int R0, const float* cw, const float* cb, int tid, int G, int bid) {
    constexpr int NV = FF / 8;
    for (int idx = bid * NTHREADS + tid; idx < UCH * NV; idx += G * NTHREADS) {
        const int ml = idx / NV, f0 = (idx % NV) * 8, s = (R0 + ml) & (SEQ - 1);
        const bf16* up = U + (size_t)ml * FF2 + f0;
        const v4u zero = {0u, 0u, 0u, 0u};
        const v4u g1 = *(const v4u*)up, v1 = *(const v4u*)(up + FF);
        const v4u g0 = s > 0 ? *(const v4u*)(up - FF2) : zero, v0 = s > 0 ? *(const v4u*)(up - FF2 + FF) : zero;
        const v4u g2 = s < SEQ - 1 ? *(const v4u*)(up + FF2) : zero, v2 = s < SEQ - 1 ? *(const v4u*)(up + FF2 + FF) : zero;
        unsigned ow[4];
#pragma unroll
        for (int q = 0; q < 4; ++q) {
            float r[2];
#pragma unroll
            for (int hh = 0; hh < 2; ++hh) { const int f = f0 + 2 * q + hh;
                const float a0 = hh ? bfhi(g0[q]) : bflo(g0[q]), a1 = hh ? bfhi(g1[q]) : bflo(g1[q]), a2 = hh ? bfhi(g2[q]) : bflo(g2[q]);
                const float b0 = hh ? bfhi(v0[q]) : bflo(v0[q]), b1 = hh ? bfhi(v1[q]) : bflo(v1[q]), b2 = hh ? bfhi(v2[q]) : bflo(v2[q]);
                const float gate = cb[f] + cw[f] * a0 + cw[FF2 + f] * a1 + cw[2 * FF2 + f] * a2;
                const float val = cb[FF + f] + cw[FF + f] * b0 + cw[FF2 + FF + f] * b1 + cw[2 * FF2 + FF + f] * b2;
                r[hh] = gelu_tanh(gate) * val; }
            ow[q] = pk2(r[0], r[1]); }
        const v4u o = {ow[0], ow[1], ow[2], ow[3]};
        *(v4u*)(Gb + (size_t)(R0 + ml) * FF + f0) = o;
    }
}

__device__ __forceinline__ void dot8(float (&acc)[8], const LAS float* qp, float kf) {
    const f32x4 q0 = *(const LAS f32x4*)qp, q1 = *(const LAS f32x4*)(qp + 4);
    acc[0] += q0.x * kf; acc[1] += q0.y * kf; acc[2] += q0.z * kf; acc[3] += q0.w * kf;
    acc[4] += q1.x * kf; acc[5] += q1.y * kf; acc[6] += q1.z * kf; acc[7] += q1.w * kf;
}
__device__ __forceinline__ void dot8x8(float (&acc)[8], const LAS float* qp, v4u raw) {
    dot8(acc, qp + 0, bflo(raw.x)); dot8(acc, qp + 8, bfhi(raw.x)); dot8(acc, qp + 16, bflo(raw.y)); dot8(acc, qp + 24, bfhi(raw.y));
    dot8(acc, qp + 32, bflo(raw.z)); dot8(acc, qp + 40, bfhi(raw.z)); dot8(acc, qp + 48, bflo(raw.w)); dot8(acc, qp + 56, bfhi(raw.w));
}
__device__ __forceinline__ void mla_naive(const bf16* Q, const bf16* KV, const bf16* PROJ, bf16* AO, LAS unsigned char* lds, int tid, int G, int bid) {
    LAS float* qs = (LAS float*)lds;
    LAS float* sc = (LAS float*)(lds + 8192);
    LAS float* rinv = (LAS float*)(lds + 8192 + 65536);
    const int lane = tid & 63, wave = tid >> 6;
    for (int item = bid; item < BATCH * 8 * (SEQ / 8); item += G) {
        const int qb = item & 255, h = (item >> 8) & 7, b = item >> 11;
        const int m0 = b * SEQ + qb * 8;
        for (int e = tid; e < 1536; e += NTHREADS) { const int r = e / 192, d = e % 192; qs[d * 8 + r] = bf2f(Q[(size_t)(m0 + r) * QW + h * 192 + d]) * MLA_SCALE; }
        __syncthreads();
#pragma unroll 1
        for (int j = 0; j < 4; ++j) { const int k = tid + NTHREADS * j; const size_t mk = (size_t)b * SEQ + k;
            float acc[8] = {0.f, 0.f, 0.f, 0.f, 0.f, 0.f, 0.f, 0.f};
            const bf16* kn = KV + mk * KVW + h * 256;
#pragma unroll 2
            for (int c = 0; c < 16; ++c) dot8x8(acc, qs + c * 64, *(const v4u*)(kn + c * 8));
            const bf16* kr = PROJ + mk * INWP + C_KROPE;
#pragma unroll 2
            for (int c = 0; c < 8; ++c) dot8x8(acc, qs + (128 + c * 8) * 8, *(const v4u*)(kr + c * 8));
#pragma unroll
            for (int r = 0; r < 8; ++r) sc[r * SEQ + k] = acc[r]; }
        __syncthreads();
        { LAS float* row = sc + wave * SEQ; float mx = -3.0e38f;
          for (int i = 0; i < 32; ++i) mx = fmaxf(mx, row[lane + 64 * i]);
          mx = wave_max(mx); float s = 0.f;
          for (int i = 0; i < 32; ++i) { const float e = __expf(row[lane + 64 * i] - mx); row[lane + 64 * i] = e; s += e; }
          s = wave_sum(s); if (lane == 0) rinv[wave] = 1.0f / s; }
        __syncthreads();
        { const int d = tid & 127, rg = tid >> 7; const LAS float* p0 = sc + (2 * rg) * SEQ; const LAS float* p1 = p0 + SEQ; float a0 = 0.f, a1 = 0.f;
          const bf16* vp = KV + (size_t)b * SEQ * KVW + h * 256 + 128 + d;
#pragma unroll 8
          for (int k = 0; k < SEQ; ++k) { const float v = bf2f(vp[(size_t)k * KVW]); a0 += p0[k] * v; a1 += p1[k] * v; }
          AO[(size_t)(m0 + 2 * rg) * DM + h * 128 + d] = (bf16)f2bf(a0 * rinv[2 * rg]);
          AO[(size_t)(m0 + 2 * rg + 1) * DM + h * 128 + d] = (bf16)f2bf(a1 * rinv[2 * rg + 1]); }
        __syncthreads();
    }
}
__device__ __forceinline__ void diff_naive(const bf16* PROJ, const int* pos, const float* rel_bias, const float* subln, float lam, bf16* AO, LAS unsigned char* lds, int tid, int G, int bid) {
    LAS float* qs = (LAS float*)lds;
    LAS float* sc = (LAS float*)(lds + 4096);
    LAS float* misc = (LAS float*)(lds + 4096 + 131072);
    LAS int* qpos = (LAS int*)(misc + 24);
    LAS float* osm = misc + 32;
    const int lane = tid & 63, wave = tid >> 6;
    for (int item = bid; item < BATCH * 8 * (SEQ / 8); item += G) {
        const int qb = item & 255, h = (item >> 8) & 7, b = item >> 11;
        const int m0 = b * SEQ + qb * 8;
        for (int e = tid; e < 1024; e += NTHREADS) { const int c = e >> 9, r = (e >> 6) & 7, d = e & 63;
            qs[(c * 64 + d) * 8 + r] = bf2f(PROJ[(size_t)(m0 + r) * INWP + C_DQ + h * 128 + c * 64 + d]) * DIFF_SCALE; }
        if (tid < 8) qpos[tid] = pos[m0 + tid];
        __syncthreads();
#pragma unroll 1
        for (int j = 0; j < 4; ++j) { const int k = tid + NTHREADS * j; const size_t mk = (size_t)b * SEQ + k; const int kp = pos[mk];
            float bs[8];
#pragma unroll
            for (int r = 0; r < 8; ++r) bs[r] = rel_bias[t5_bucket(kp - qpos[r]) * 8 + h];
#pragma unroll 1
            for (int c = 0; c < 2; ++c) {
                float acc[8] = {0.f, 0.f, 0.f, 0.f, 0.f, 0.f, 0.f, 0.f};
                const bf16* kd = PROJ + mk * INWP + C_DK + h * 128 + c * 64;
#pragma unroll 2
                for (int ch = 0; ch < 8; ++ch) dot8x8(acc, qs + (c * 64 + ch * 8) * 8, *(const v4u*)(kd + ch * 8));
#pragma unroll
                for (int r = 0; r < 8; ++r) sc[(c * 8 + r) * SEQ + k] = acc[r] + bs[r]; } }
        __syncthreads();
        { LAS float* r0 = sc + wave * SEQ; LAS float* r1 = sc + (8 + wave) * SEQ; float mx0 = -3.0e38f, mx1 = -3.0e38f;
          for (int i = 0; i < 32; ++i) { mx0 = fmaxf(mx0, r0[lane + 64 * i]); mx1 = fmaxf(mx1, r1[lane + 64 * i]); }
          mx0 = wave_max(mx0); mx1 = wave_max(mx1); float s0 = 0.f, s1 = 0.f;
          for (int i = 0; i < 32; ++i) { const float e0 = __expf(r0[lane + 64 * i] - mx0), e1 = __expf(r1[lane + 64 * i] - mx1); r0[lane + 64 * i] = e0; r1[lane + 64 * i] = e1; s0 += e0; s1 += e1; }
          s0 = wave_sum(s0); s1 = wave_sum(s1); const float i0 = 1.0f / s0, i1 = lam / s1;
          for (int i = 0; i < 32; ++i) r0[lane + 64 * i] = r0[lane + 64 * i] * i0 - r1[lane + 64 * i] * i1; }
        __syncthreads();
        { const int d = tid & 127, rg = tid >> 7; const LAS float* p0 = sc + (2 * rg) * SEQ; const LAS float* p1 = p0 + SEQ; float a0 = 0.f, a1 = 0.f;
          const bf16* vp = PROJ + (size_t)b * SEQ * INWP + C_DV + h * 128 + d;
#pragma unroll 8
          for (int k = 0; k < SEQ; ++k) { const float v = bf2f(vp[(size_t)k * INWP]); a0 += p0[k] * v; a1 += p1[k] * v; }
          osm[(2 * rg) * 128 + d] = a0; osm[(2 * rg + 1) * 128 + d] = a1; }
        __syncthreads();
        { const float v0 = osm[wave * 128 + lane], v1 = osm[wave * 128 + 64 + lane];
          const float rstd = rsqrtf(wave_sum(v0 * v0 + v1 * v1) * (1.0f / 128.0f) + EPS);
          bf16* op = AO + (size_t)(m0 + wave) * DM + 1024 + h * 128;
          op[lane] = (bf16)f2bf(v0 * rstd * subln[lane] * (1.0f - LAMBDA_INIT)); op[lane + 64] = (bf16)f2bf(v1 * rstd * subln[lane + 64] * (1.0f - LAMBDA_INIT)); }
        __syncthreads();
    }
}

#ifndef SKIPM
#define SKIPM 0
#endif
constexpr int NPH = 19;
struct Args { const void* in[25]; float* out; unsigned char* ws; int ph_lo, ph_hi; };
__global__ void __launch_bounds__(NTHREADS, 2) fwd(Args args) {
    extern __shared__ __attribute__((aligned(16))) unsigned char lds_raw[];
    LAS unsigned char* lds = (LAS unsigned char*)lds_raw;
    const int tid0 = threadIdx.x, G0 = gridDim.x;
    for (int u = tid0; u < (LDS_BYTES - LDSCTL_OFF) / 4; u += NTHREADS) ((LAS unsigned*)(lds + LDSCTL_OFF))[u] = 0u;
    __syncthreads();
    if (tid0 == 0) {
        LAS unsigned long long* pt = (LAS unsigned long long*)(lds + PTR_OFF);
#pragma unroll
        for (int i = 0; i < 25; ++i) pt[i] = (unsigned long long)args.in[i];
        pt[P_OUT] = (unsigned long long)args.out; pt[P_WS] = (unsigned long long)args.ws;
    }
    __syncthreads();
    volatile LAS unsigned* MISC = (volatile LAS unsigned*)(lds + MISC_OFF);
    const int ph_lo = args.ph_lo, ph_hi = args.ph_hi;
    XcdBarrier bar; bar.bar = nullptr; bar.x = 0; bar.st = nullptr;
    if (ph_hi - ph_lo > 1) bar = xcd_barrier_post((unsigned*)(LPWS() + WS_CTL) + CW_BAR, MISC + 8);

    for (int ph = ph_lo; ph < ph_hi; ++ph) {
        int tid = tid0, G = G0, bid = (int)blockIdx.x;
        asm volatile("" : "+v"(tid)); asm volatile("" : "+s"(G)); asm volatile("" : "+s"(bid));
        const int lane = tid & 63, wave = __builtin_amdgcn_readfirstlane(tid >> 6);
        switch (ph) {
        case 0: if (!(SKIPM & 1)) p0_prologue(lds, tid, lane, wave, G, bid); break;
        case 1: if (!(SKIPM & 2)) { unsigned char* ws = LPWS(); prenorm_phase(LPF(P_X), LPF(P_APRE), (const float*)(ws + WS_MOD), MOD_SHA, MOD_SCA, (bf16*)(ws + WS_H), lane, wave, G, bid); } break;
        case 2: case 4: case 9: case 11: case 13: case 15: {
            const int nsub = (ph == 4) ? 2 : 1;
            for (int sub = 0; sub < nsub; ++sub) {
                unsigned char* ws = LPWS();
                bf16* H = (bf16*)(ws + WS_H); bf16* PROJ = (bf16*)(ws + WS_PROJ);
                pg8::Gemm g; pg8::EpiBf16 E;
                if (ph == 2) { g = pg8::Gemm{H, (const bf16*)(ws + WS_WIN), M, INWP, DM, DM, DM}; E = pg8::EpiBf16{PROJ, INWP}; }
                else if (ph == 4 && sub == 0) { g = pg8::Gemm{PROJ + C_QLAT, (const bf16*)(ws + WS_WUQ), M, QW, 512, INWP, 512}; E = pg8::EpiBf16{(bf16*)(ws + WS_Q), QW}; }
                else if (ph == 4) { g = pg8::Gemm{PROJ + C_KVLAT, (const bf16*)(ws + WS_WUKV), M, KVW, 256, INWP, 256}; E = pg8::EpiBf16{(bf16*)(ws + WS_KV), KVW}; }
                else { const int ch = (ph - 9) >> 1; g = pg8::Gemm{H + (size_t)ch * UCH * DM, (const bf16*)(ws + WS_WUP), UCH, FF2, DM, DM, DM}; E = pg8::EpiBf16{(bf16*)(ws + WS_U), FF2}; }
                pg8::StaticOrder S; S.init(g.M, g.N, G, (int)blockIdx.x);
                if (!(SKIPM & 4)) pg8::gemm_phase<pg8::EpiBf16, pg8::StaticOrder, true, true>(lds, g, S, E);
            }
        } break;
        case 3: if (!(SKIPM & 8)) { unsigned char* ws = LPWS(); krope_phase((bf16*)(ws + WS_PROJ), (const float*)(ws + WS_COS), (const float*)(ws + WS_SIN), tid, G, bid); } break;
        case 5: if (!(SKIPM & 16)) { unsigned char* ws = LPWS(); qkvpost_phase((const bf16*)(ws + WS_PROJ), (bf16*)(ws + WS_Q), (bf16*)(ws + WS_KV), (const float*)(ws + WS_COS), (const float*)(ws + WS_SIN), lane, wave, G, bid); } break;
        case 6: {
            if (!(SKIPM & 32)) { unsigned char* ws = LPWS(); mla_naive((const bf16*)(ws + WS_Q), (const bf16*)(ws + WS_KV), (const bf16*)(ws + WS_PROJ), (bf16*)(ws + WS_AO), lds, tid, G, bid); }
            if (!(SKIPM & 64)) { unsigned char* ws = LPWS();
                const float s1 = wave_sum(LPF(P_LQ1)[lane] * LPF(P_LK1)[lane]), s2 = wave_sum(LPF(P_LQ2)[lane] * LPF(P_LK2)[lane]);
                const float lam = expf(s1) - expf(s2) + LAMBDA_INIT;
                diff_naive((const bf16*)(ws + WS_PROJ), (const int*)ldptr(lds, P_POS), LPF(P_RELB), LPF(P_SUBLN), lam, (bf16*)(ws + WS_AO), lds, tid, G, bid); }
        } break;
        case 7: case 17: {
            unsigned char* ws = LPWS();
            pg8::Gemm g; pg8::EpiF32 E;
            if (ph == 7) { g = pg8::Gemm{(const bf16*)(ws + WS_AO), (const bf16*)(ws + WS_WO), M, DM, DM, DM, DM}; E = pg8::EpiF32{(float*)(ws + WS_Y), DM}; }
            else { g = pg8::Gemm{(const bf16*)(ws + WS_G), (const bf16*)(ws + WS_WDN), M, DM, FF, FF, FF}; E = pg8::EpiF32{(float*)(ws + WS_Y2), DM}; }
            pg8::StaticOrder S; S.init(g.M, g.N, G, (int)blockIdx.x);
            if (!(SKIPM & 128)) pg8::gemm_phase<pg8::EpiF32, pg8::StaticOrder, true, true>(lds, g, S, E);
        } break;
        case 8: if (!(SKIPM & 256)) { unsigned char* ws = LPWS(); const float* mod = (const float*)(ws + WS_MOD);
            post_phase<true>((const float*)(ws + WS_Y), LPF(P_X), (float*)ldptr(lds, P_OUT), LPF(P_APOST), mod, MOD_GA, LPF(P_FPRE), MOD_SHF, MOD_SCF, (bf16*)(ws + WS_H), lane, wave, G, bid); } break;
        case 10: case 12: case 14: case 16: if (!(SKIPM & 512)) { unsigned char* ws = LPWS(); const int ch = (ph - 10) >> 1; conv_phase((const bf16*)(ws + WS_U), (bf16*)(ws + WS_G), ch * UCH, LPF(P_CW), LPF(P_CB), tid, G, bid); } break;
        case 18: if (!(SKIPM & 1024)) { unsigned char* ws = LPWS(); const float* mod = (const float*)(ws + WS_MOD); float* outp = (float*)ldptr(lds, P_OUT);
            post_phase<false>((const float*)(ws + WS_Y2), outp, outp, LPF(P_FPOST), mod, MOD_GF, nullptr, 0, 0, nullptr, lane, wave, G, bid); } break;
        default: break;
        }
        if (ph + 1 < ph_hi) xcd_barrier(bar);
    }
}

#ifndef MK_ONE_LAUNCH
#define MK_ONE_LAUNCH 0
#endif
extern "C" void kernel_launch(void* const* d_in, const int* in_sizes, int n_in, void* d_out, int out_size, void* d_ws, size_t ws_size, hipStream_t stream) {
    static int grid = 0;
    if (grid == 0) {
        if (n_in != 25 || in_sizes[0] != M * DM || out_size != M * DM || ws_size < WS_END) {
            fprintf(stderr, "kernel_launch: shape mismatch: n_in %d in0 %d out %d ws %zu (need >= %zu)\n", n_in, n_in > 0 ? in_sizes[0] : -1, out_size, ws_size, (size_t)WS_END); grid = -1; return; }
        int dev = 0, cus = 0;
        if (hipGetDevice(&dev) != hipSuccess || hipDeviceGetAttribute(&cus, hipDeviceAttributeMultiprocessorCount, dev) != hipSuccess) { grid = -1; return; }
        if (hipFuncSetAttribute((const void*)fwd, hipFuncAttributeMaxDynamicSharedMemorySize, LDS_BYTES) != hipSuccess) { fprintf(stderr, "kernel_launch: hipFuncSetAttribute failed\n"); grid = -1; return; }
        (void)hipGetLastError();
        grid = cus;
    }
    if (grid < 0) return;
    if (hipMemsetAsync((char*)d_ws + WS_CTL, 0, CTL_ZERO_BYTES, stream) != hipSuccess) { fprintf(stderr, "kernel_launch: memset failed\n"); return; }
    Args a{};
    for (int i = 0; i < 25; ++i) a.in[i] = d_in[i];
    a.out = (float*)d_out; a.ws = (unsigned char*)d_ws;
#if MK_ONE_LAUNCH
    a.ph_lo = 0; a.ph_hi = NPH;
    hipLaunchKernelGGL(fwd, dim3(grid), dim3(NTHREADS), LDS_BYTES, stream, a);
#else
    for (int p = 0; p < NPH; ++p) { a.ph_lo = p; a.ph_hi = p + 1; hipLaunchKernelGGL(fwd, dim3(grid), dim3(NTHREADS), LDS_BYTES, stream, a); }
#endif
    const hipError_t le = hipPeekAtLastError();
    if (le != hipSuccess) fprintf(stderr, "kernel_launch: launch failed: %s\n", hipGetErrorName(le));
}
```

```cpp
#include <hip/hip_runtime.h>
#include <cstdio>
#include <cstdint>
namespace pg8 {
#define PG8_LAS __attribute__((address_space(3)))
typedef unsigned short bf16_t;
typedef short bf16x8 __attribute__((ext_vector_type(8)));
typedef float f32x4 __attribute__((ext_vector_type(4)));
typedef unsigned u32x2 __attribute__((ext_vector_type(2)));
typedef unsigned u32x4 __attribute__((ext_vector_type(4)));
constexpr int BM = 256, BK = 64, HALF = 128, HTB = HALF * BK * 2  , STAGE_BYTES = 8 * HTB, NXCD = 8, WGM = 8;

__host__ __device__ __forceinline__ int lds_byte(int r, int c) { const int st = (r >> 4) * 2 + (c >> 5), rr = r & 15, cc = c & 31, ob = rr * 64 + cc * 2; return st * 1024 + (ob ^ (((ob >> 9) & 1) << 5)); }
__host__ __device__ __forceinline__ void stage_rc(int b, int& R, int& C) { const int st = b / 1024, sb = b % 1024, swz = sb ^ (((sb >> 9) & 1) << 5); R = (st >> 1) * 16 + swz / 64; C = (st & 1) * 32 + (swz % 64) / 2; }
__host__ __device__ __forceinline__ int perm32(int rho) { const int n = rho >> 4, i = rho & 15; return 8 * (i >> 2) + 4 * n + (i & 3); }

struct Unit { int pm, pn; };
struct Gemm { const bf16_t* A; const bf16_t* Bt; int M, N, K, lda, ldb, hsb, tsb, aperm; };

struct StaticOrder {
    int nM, nN, nwg, G, c;
    __host__ __device__ void init(int M, int N, int G_, int c_) { nM = M / BM; nN = N / BM; nwg = nM * nN; G = G_; c = c_; }
    __host__ __device__ bool next(int i, Unit& u) const {
        const long L = (long)i * G + c; if (L >= nwg) return false;
        int wgid = (int)L; { const int q = nwg / NXCD, r = nwg % NXCD, xcd = wgid % NXCD, off = wgid / NXCD; wgid = (xcd < r ? xcd * (q + 1) : r * (q + 1) + (xcd - r) * q) + off; }
        const int nig = WGM * nN, gid = wgid / nig, fm = gid * WGM, gsz = (nM - fm) < WGM ? (nM - fm) : WGM;
        u.pm = fm + ((wgid % nig) % gsz); u.pn = (wgid % nig) / gsz; return true;
    }
    __device__ __forceinline__ void a_ready(const Unit&) const {}
    __device__ __forceinline__ void done(const Unit&) const {}
};


struct ListOrder {
    int base, cnt, nN;
    __host__ __device__ bool next(int i, Unit& u) const { if (i >= cnt) return false; const int id = base + i; u.pm = id / nN; u.pn = id % nN; return true; }
    __device__ __forceinline__ void a_ready(const Unit&) const {}
    __device__ __forceinline__ void done(const Unit&) const {}
};

__device__ __forceinline__ unsigned cvt_pk_bf16(float lo, float hi) { unsigned r; asm volatile("v_cvt_pk_bf16_f32 %0, %1, %2" : "=v"(r) : "v"(lo), "v"(hi)); return r; }

struct EpiF32 {
    static constexpr bool PERM = false, AFTER_DRAIN = false;
    float* C; int ldc;
    __device__ __forceinline__ void operator()(const f32x4 (&acc)[2][2][4][2], const Unit& u, int wr, int wc, int fr, int fq) const {
        const int row0 = u.pm * BM + wr * 64 + fr, col0 = u.pn * BM + wc * 32 + 4 * fq;
#pragma unroll
        for (int ai = 0; ai < 2; ++ai)
#pragma unroll
            for (int m = 0; m < 4; ++m) { float* rowp = C + (size_t)(row0 + ai * HALF + m * 16) * ldc + col0;
#pragma unroll
                for (int bj = 0; bj < 2; ++bj)
#pragma unroll
                    for (int n = 0; n < 2; ++n) *(f32x4*)(rowp + bj * HALF + n * 16) = acc[ai][bj][m][n]; }
    }
};
struct EpiBf16 {
    static constexpr bool PERM = true, AFTER_DRAIN = false;
    bf16_t* O; int ldc;
    __device__ __forceinline__ void operator()(const f32x4 (&acc)[2][2][4][2], const Unit& u, int wr, int wc, int fr, int fq) const {
        const int row0 = u.pm * BM + wr * 64 + fr; const int col0 = u.pn * BM + wc * 32 + 8 * fq;
#pragma unroll
        for (int ai = 0; ai < 2; ++ai)
#pragma unroll
            for (int m = 0; m < 4; ++m) { bf16_t* rowp = O + (size_t)(row0 + ai * HALF + m * 16) * ldc + col0;
#pragma unroll
                for (int bj = 0; bj < 2; ++bj) { const f32x4 v0 = acc[ai][bj][m][0], v1 = acc[ai][bj][m][1];
                    u32x4 w; w.x = cvt_pk_bf16(v0[0], v0[1]); w.y = cvt_pk_bf16(v0[2], v0[3]); w.z = cvt_pk_bf16(v1[0], v1[1]); w.w = cvt_pk_bf16(v1[2], v1[3]);
                    *(u32x4*)(rowp + bj * HALF) = w; } }
    }
};

struct EpiX {
    static constexpr bool PERM = true, AFTER_DRAIN = false;
    bf16_t* O; int ldc; int mode; float* ssq_q; float* ssq_kv; const float* COS; const float* SIN; float qscale;
    __device__ __forceinline__ void operator()(const f32x4 (&acc)[2][2][4][2], const Unit& u, int wr, int wc, int fr, int fq) const {
        const int row0 = u.pm * BM + wr * 64 + fr; const int col0 = u.pn * BM + wc * 32 + 8 * fq;
        const bool do_ssq = (mode == 0) && (u.pn <= 2);
#pragma unroll
        for (int ai = 0; ai < 2; ++ai)
#pragma unroll
            for (int m = 0; m < 4; ++m) { const int row = row0 + ai * HALF + m * 16; bf16_t* rowp = O + (size_t)row * ldc + col0;
                float sc = 1.0f;
                if (mode == 1) sc = rsqrtf(ssq_q[row] * (1.0f / 512.0f) + 1e-6f) * qscale; else if (mode == 2) sc = rsqrtf(ssq_kv[row] * (1.0f / 256.0f) + 1e-6f);
                float ss = 0.f;
#pragma unroll
                for (int bj = 0; bj < 2; ++bj) { f32x4 v0 = acc[ai][bj][m][0] * sc, v1 = acc[ai][bj][m][1] * sc;
                    const int span = u.pn * BM + bj * HALF + wc * 32;
                    int roff = -1;
                    if (mode == 0) { if (span == 768 || span == 800) roff = span - 768; }
                    else if (mode == 1) { const int d = span % 192; if (d >= 128) roff = d - 128; }
                    if (roff >= 0) { const int ib = (roff >> 1) + 4 * fq;
                        const f32x4 cs = *(const f32x4*)(COS + (size_t)row * 32 + ib), sn = *(const f32x4*)(SIN + (size_t)row * 32 + ib);
                        f32x4 w0, w1;
                        w0[0] = v0[0] * cs[0] - v0[1] * sn[0]; w0[1] = v0[0] * sn[0] + v0[1] * cs[0]; w0[2] = v0[2] * cs[1] - v0[3] * sn[1]; w0[3] = v0[2] * sn[1] + v0[3] * cs[1];
                        w1[0] = v1[0] * cs[2] - v1[1] * sn[2]; w1[1] = v1[0] * sn[2] + v1[1] * cs[2]; w1[2] = v1[2] * cs[3] - v1[3] * sn[3]; w1[3] = v1[2] * sn[3] + v1[3] * cs[3];
                        v0 = w0; v1 = w1; }
                    if (do_ssq) ss += ((v0[0] * v0[0] + v0[1] * v0[1]) + (v0[2] * v0[2] + v0[3] * v0[3])) + ((v1[0] * v1[0] + v1[1] * v1[1]) + (v1[2] * v1[2] + v1[3] * v1[3]));
                    u32x4 w; w.x = cvt_pk_bf16(v0[0], v0[1]); w.y = cvt_pk_bf16(v0[2], v0[3]); w.z = cvt_pk_bf16(v1[0], v1[1]); w.w = cvt_pk_bf16(v1[2], v1[3]);
                    *(u32x4*)(rowp + bj * HALF) = w; }
                if (do_ssq) { ss += __shfl_xor(ss, 16); ss += __shfl_xor(ss, 32);
                    if (fq == 0) atomicAdd((u.pn < 2 ? ssq_q : ssq_kv) + row, ss); }
            }
    }
};

struct EpiConv {
    static constexpr bool PERM = true, AFTER_DRAIN = false;
    bf16_t* G; bf16_t* E; const float* cw; const float* cb; int ff, ff2;
    template <int CTRL> static __device__ __forceinline__ float dpp(float x) { return __builtin_bit_cast(float, __builtin_amdgcn_update_dpp(0, __builtin_bit_cast(int, x), CTRL, 0xf, 0xf, true)); }
    static __device__ __forceinline__ float gelu(float x) { const float t = x * x, u = __builtin_fmaf(t, -0.10294324f, -2.3022082f); return x * __builtin_amdgcn_rcpf(1.0f + __builtin_amdgcn_exp2f(x * u)); }
    __device__ __forceinline__ void operator()(const f32x4 (&acc)[2][2][4][2], const Unit& u, int wr, int wc, int fr, int fq) const {
        const int fl = wc * 32 + 8 * fq, f0 = u.pn * HALF + fl;
        constexpr int SHR1 = 0x111, SHL1 = 0x101;
#pragma unroll
        for (int n = 0; n < 2; ++n) {
            const int f = f0 + 4 * n;
            const f32x4 g0 = *(const f32x4*)(cw + f), g1 = *(const f32x4*)(cw + ff2 + f), g2 = *(const f32x4*)(cw + 2 * ff2 + f), gb = *(const f32x4*)(cb + f);
            const f32x4 v0 = *(const f32x4*)(cw + ff + f), v1 = *(const f32x4*)(cw + ff2 + ff + f), v2 = *(const f32x4*)(cw + 2 * ff2 + ff + f), vb = *(const f32x4*)(cb + ff + f);
#pragma unroll
            for (int ai = 0; ai < 2; ++ai) {
                const int grp = u.pm * 4 + ai * 2 + wr;
#pragma unroll
                for (int m = 0; m < 4; ++m) { const int row = u.pm * BM + ai * HALF + wr * 64 + 4 * fr + m;
                    const f32x4 a = acc[ai][0][m][n], b = acc[ai][1][m][n];
                    const f32x4 ap = acc[ai][0][m > 0 ? m - 1 : 3][n], bp = acc[ai][1][m > 0 ? m - 1 : 3][n];
                    const f32x4 an = acc[ai][0][m < 3 ? m + 1 : 0][n], bn = acc[ai][1][m < 3 ? m + 1 : 0][n];
                    float og[4];
#pragma unroll
                    for (int c = 0; c < 4; ++c) {
                        float ga = __builtin_fmaf(g1[c], a[c], gb[c]), va = __builtin_fmaf(v1[c], b[c], vb[c]);
                        ga = __builtin_fmaf(g0[c], m > 0 ? ap[c] : dpp<SHR1>(ap[c]), ga); va = __builtin_fmaf(v0[c], m > 0 ? bp[c] : dpp<SHR1>(bp[c]), va);
                        ga = __builtin_fmaf(g2[c], m < 3 ? an[c] : dpp<SHL1>(an[c]), ga); va = __builtin_fmaf(v2[c], m < 3 ? bn[c] : dpp<SHL1>(bn[c]), va);
                        og[c] = gelu(ga) * va; }
                    uint2 o2; o2.x = cvt_pk_bf16(og[0], og[1]); o2.y = cvt_pk_bf16(og[2], og[3]);
                    *(uint2*)(G + (size_t)row * ff + f) = o2;
                    if ((m < 2 && fr == 0) || (m >= 2 && fr == 15)) {
                        bf16_t* ep = E + ((size_t)(u.pn * 256 + grp) * 4 + m) * 256 + fl + 4 * n;
                        uint2 eg; eg.x = cvt_pk_bf16(a[0], a[1]); eg.y = cvt_pk_bf16(a[2], a[3]); uint2 ev; ev.x = cvt_pk_bf16(b[0], b[1]); ev.y = cvt_pk_bf16(b[2], b[3]);
                        *(uint2*)ep = eg; *(uint2*)(ep + HALF) = ev; }
                }
            }
        }
    }
};
template <class Epi, class Sched, bool ALIGN_EPI = false, bool SP2 = false>
__device__ __forceinline__ void gemm_phase(PG8_LAS unsigned char* lds, const Gemm g, const Sched& S, const Epi& E, const int tid) {
    const int  wid = __builtin_amdgcn_readfirstlane(tid >> 6), lane = tid & 63, wr = wid >> 2, wc = wid & 3, fr = lane & 15, fq = lane >> 4;
    const int K = g.K, nt = K / BK;
    unsigned voffA[2], voffB[2];
#pragma unroll
    for (int i = 0; i < 2; ++i) { int R, C; stage_rc(tid * 16 + i * 8192, R, C); const int Rb = Epi::PERM ? ((R & ~31) + perm32(R & 31)) : R;
        const int Ra = g.aperm ? ((R & ~63) + 4 * (R & 15) + ((R >> 4) & 3)) : R;
        voffA[i] = (unsigned)(Ra * g.lda + C) * 2u; voffB[i] = (unsigned)(Rb * g.ldb + C) * 2u; }
    const __amdgpu_buffer_rsrc_t srdA = __builtin_amdgcn_make_buffer_rsrc((void*)g.A, 0, -1, 0x00020000), srdB = __builtin_amdgcn_make_buffer_rsrc((void*)g.Bt, 0, -1, 0x00020000);
    const unsigned kstep = (unsigned)(BK * 2);
    const unsigned hsA = (unsigned)HALF * g.lda * 2, hsB = (unsigned)g.hsb * g.ldb * 2;
    const unsigned tsA = 2 * hsA, tsB = (unsigned)g.tsb * g.ldb * 2;
    const unsigned ldsw = (unsigned)wid * 1024u;
    const int aoff = lds_byte(wr * 64 + fr, fq * 8), boff = lds_byte(wc * 32 + fr, fq * 8);
#define PG8_SA(b, h) (((b) * 2 + (h)) * HTB)
#define PG8_SB(b, h) ((4 + (b) * 2 + (h)) * HTB)
#define PG8_SRD_voffA srdA
#define PG8_SRD_voffB srdB
#define PG8_STAGE(bufoff, soff, voff) do { _Pragma("unroll") for (int _i = 0; _i < 2; ++_i) \
        __builtin_amdgcn_raw_ptr_buffer_load_lds(PG8_SRD_##voff, (PG8_LAS void*)(lds + (bufoff) + ldsw + _i * 8192), 16, (voff)[_i], (soff), 0, 0); } while (0)
#define PG8_LDA(dst, b, h) do { _Pragma("unroll") for (int m = 0; m < 4; ++m) _Pragma("unroll") for (int k = 0; k < 2; ++k) dst[m][k] = *(const PG8_LAS bf16x8*)(lds + PG8_SA(b, h) + aoff + m * 2048 + k * 1024); } while (0)
#define PG8_LDB(dst, b, h) do { _Pragma("unroll") for (int n = 0; n < 2; ++n) _Pragma("unroll") for (int k = 0; k < 2; ++k) dst[n][k] = *(const PG8_LAS bf16x8*)(lds + PG8_SB(b, h) + boff + n * 2048 + k * 1024); } while (0)
#define PG8_MMA(ai, bj, At, Bt) do { __builtin_amdgcn_s_setprio(1); _Pragma("unroll") for (int m = 0; m < 4; ++m) _Pragma("unroll") for (int n = 0; n < 2; ++n) _Pragma("unroll") for (int k = 0; k < 2; ++k) \
        acc[ai][bj][m][n] = __builtin_amdgcn_mfma_f32_16x16x32_bf16(Bt[n][k], At[m][k], acc[ai][bj][m][n], 0, 0, 0); __builtin_amdgcn_s_setprio(0); } while (0)
#define PG8_WAIT_V(n) asm volatile("s_waitcnt vmcnt(" #n ")" ::: "memory")
#define PG8_WAIT_L(n) asm volatile("s_waitcnt lgkmcnt(" #n ")" ::: "memory")
#define PG8_BAR __builtin_amdgcn_s_barrier()
#define PG8_SCHED __builtin_amdgcn_sched_barrier(0)
    Unit cur, nxt; int ui = 0;
    if (!S.next(0, cur)) return;
    f32x4 acc[2][2][4][2];
#pragma unroll
    for (int a = 0; a < 2; ++a)
#pragma unroll
        for (int b = 0; b < 2; ++b)
#pragma unroll
            for (int m = 0; m < 4; ++m)
#pragma unroll
                for (int n = 0; n < 2; ++n) acc[a][b][m][n] = (f32x4){0.f, 0.f, 0.f, 0.f};
    bf16x8 At[4][2], B0[2][2], B1[2][2];
    unsigned cA = (unsigned)cur.pm * tsA, cB = (unsigned)cur.pn * tsB;
    S.a_ready(cur);
    if constexpr (SP2) {
        PG8_STAGE(PG8_SB(0, 0), cB, voffB); PG8_STAGE(PG8_SB(0, 1), cB + hsB, voffB); PG8_STAGE(PG8_SA(0, 0), cA, voffA); PG8_STAGE(PG8_SA(0, 1), cA + hsA, voffA);
        if (wr == 1) PG8_BAR;
        PG8_WAIT_V(2); PG8_BAR;
        PG8_STAGE(PG8_SB(1, 0), cB + kstep, voffB); PG8_STAGE(PG8_SA(1, 0), cA + kstep, voffA); PG8_STAGE(PG8_SB(1, 1), cB + hsB + kstep, voffB);
        PG8_WAIT_V(6); PG8_BAR;
    } else {
        PG8_STAGE(PG8_SB(0, 0), cB, voffB); PG8_STAGE(PG8_SA(0, 0), cA, voffA); PG8_STAGE(PG8_SB(0, 1), cB + hsB, voffB); PG8_STAGE(PG8_SA(0, 1), cA + hsA, voffA);
        if (wr == 1) PG8_BAR;
        PG8_WAIT_V(4); PG8_BAR;
        PG8_STAGE(PG8_SB(1, 0), cB + kstep, voffB); PG8_STAGE(PG8_SA(1, 0), cA + kstep, voffA); PG8_STAGE(PG8_SB(1, 1), cB + hsB + kstep, voffB);
        PG8_WAIT_V(6); PG8_BAR;
    }
    for (;;) {
        const bool has_next = S.next(ui + 1, nxt);
        const unsigned nA = has_next ? (unsigned)nxt.pm * tsA : cA, nB = has_next ? (unsigned)nxt.pn * tsB : cB;
        for (int t = 0; t < nt; t += 2) {
            const bool last = (t == nt - 2);
            const unsigned a1 = cA + (unsigned)(t + 1) * kstep;
            const unsigned a2 = last ? nA : cA + (unsigned)(t + 2) * kstep, b2 = last ? nB : cB + (unsigned)(t + 2) * kstep;
            const unsigned a3 = a2 + kstep, b3 = b2 + kstep;
            if (last && has_next) S.a_ready(nxt);
            if constexpr (SP2) {
            PG8_LDB(B0, 0, 0); PG8_LDB(B1, 0, 1); PG8_SCHED; PG8_LDA(At, 0, 0); PG8_STAGE(PG8_SA(1, 1), a1 + hsA, voffA);
            PG8_WAIT_V(8); PG8_WAIT_L(0); PG8_BAR; PG8_MMA(0, 0, At, B0); PG8_MMA(0, 1, At, B1); PG8_BAR; PG8_SCHED;
            PG8_LDA(At, 0, 1); PG8_STAGE(PG8_SB(0, 0), b2, voffB); PG8_STAGE(PG8_SB(0, 1), b2 + hsB, voffB); PG8_STAGE(PG8_SA(0, 0), a2, voffA);
            PG8_WAIT_V(8); PG8_WAIT_L(0); PG8_BAR; PG8_MMA(1, 0, At, B0); PG8_MMA(1, 1, At, B1); PG8_BAR; PG8_SCHED;
            PG8_LDB(B0, 1, 0); PG8_LDB(B1, 1, 1); PG8_SCHED; PG8_LDA(At, 1, 0); PG8_STAGE(PG8_SA(0, 1), a2 + hsA, voffA);
            PG8_WAIT_V(8); PG8_WAIT_L(0); PG8_BAR; PG8_MMA(0, 0, At, B0); PG8_MMA(0, 1, At, B1); PG8_BAR; PG8_SCHED;
            PG8_LDA(At, 1, 1); PG8_STAGE(PG8_SB(1, 0), b3, voffB); PG8_STAGE(PG8_SB(1, 1), b3 + hsB, voffB); PG8_STAGE(PG8_SA(1, 0), a3, voffA);
            PG8_WAIT_V(8); PG8_WAIT_L(0); PG8_BAR; PG8_MMA(1, 0, At, B0); PG8_MMA(1, 1, At, B1); PG8_BAR; PG8_SCHED;
            } else {
            PG8_LDB(B0, 0, 0); PG8_SCHED; PG8_LDA(At, 0, 0); PG8_STAGE(PG8_SA(1, 1), a1 + hsA, voffA);
            PG8_WAIT_L(8); PG8_BAR; PG8_WAIT_L(0); PG8_MMA(0, 0, At, B0); PG8_BAR; PG8_SCHED;
            PG8_LDB(B1, 0, 1); PG8_STAGE(PG8_SB(0, 0), b2, voffB);
            PG8_BAR; PG8_WAIT_L(0); PG8_MMA(0, 1, At, B1); PG8_BAR;
            PG8_LDA(At, 0, 1); PG8_STAGE(PG8_SA(0, 0), a2, voffA);
            PG8_BAR; PG8_WAIT_L(0); PG8_MMA(1, 0, At, B0); PG8_BAR; PG8_SCHED;
            PG8_STAGE(PG8_SB(0, 1), b2 + hsB, voffB);
            PG8_WAIT_V(6); PG8_BAR; PG8_MMA(1, 1, At, B1); PG8_BAR;
            PG8_LDB(B0, 1, 0); PG8_SCHED; PG8_LDA(At, 1, 0); PG8_STAGE(PG8_SA(0, 1), a2 + hsA, voffA);
            PG8_WAIT_L(8); PG8_BAR; PG8_WAIT_L(0); PG8_MMA(0, 0, At, B0); PG8_BAR; PG8_SCHED;
            PG8_LDB(B1, 1, 1); PG8_STAGE(PG8_SB(1, 0), b3, voffB);
            PG8_BAR; PG8_WAIT_L(0); PG8_MMA(0, 1, At, B1); PG8_BAR;
            PG8_LDA(At, 1, 1); PG8_STAGE(PG8_SA(1, 0), a3, voffA);
            PG8_BAR; PG8_WAIT_L(0); PG8_MMA(1, 0, At, B0); PG8_BAR; PG8_SCHED;
            PG8_STAGE(PG8_SB(1, 1), b3 + hsB, voffB);
            PG8_WAIT_V(6); PG8_BAR; PG8_MMA(1, 1, At, B1); PG8_BAR;
            }
        }
        if constexpr (ALIGN_EPI) { if (wr == 0) PG8_BAR; }
        if constexpr (!Epi::AFTER_DRAIN) { E(acc, cur, wr, wc, fr, fq); S.done(cur); }
        if (!has_next) break;
#pragma unroll
        for (int a = 0; a < 2; ++a)
#pragma unroll
            for (int b = 0; b < 2; ++b)
#pragma unroll
                for (int m = 0; m < 4; ++m)
#pragma unroll
                    for (int n = 0; n < 2; ++n) acc[a][b][m][n] = (f32x4){0.f, 0.f, 0.f, 0.f};
        cur = nxt; cA = nA; cB = nB; ++ui;
        if constexpr (ALIGN_EPI) { if (wr == 1) PG8_BAR; }
    }
    PG8_WAIT_V(0);
    if constexpr (!ALIGN_EPI) { if (wr == 0) PG8_BAR; }
    PG8_BAR;
    if constexpr (Epi::AFTER_DRAIN) { E.fused(acc, cur, wr, wc, fr, fq, lds, wid, lane); S.done(cur); }
#undef PG8_SA
#undef PG8_SB
#undef PG8_STAGE
#undef PG8_SRD_voffA
#undef PG8_SRD_voffB
#undef PG8_LDA
#undef PG8_LDB
#undef PG8_MMA
#undef PG8_WAIT_V
#undef PG8_WAIT_L
#undef PG8_BAR
#undef PG8_SCHED
}
}
#define GAS __attribute__((address_space(1)))
#define LAS __attribute__((address_space(3)))
typedef unsigned short bf16;
typedef unsigned v4u __attribute__((ext_vector_type(4)));
typedef float f32x4 __attribute__((ext_vector_type(4)));
typedef short bf16x8 __attribute__((ext_vector_type(8)));
typedef GAS unsigned gu32;
typedef GAS unsigned long long gu64;
#define RLX_AGENT __ATOMIC_RELAXED, __HIP_MEMORY_SCOPE_AGENT
#define LDS_WAIT() asm volatile("s_waitcnt lgkmcnt(0)" ::: "memory")
#define VM_WAIT() asm volatile("s_waitcnt vmcnt(0)" ::: "memory")
__device__ __forceinline__ unsigned long long rt() { return __builtin_amdgcn_s_memrealtime(); }
__device__ __forceinline__ unsigned f2bf(float f) { unsigned u = __builtin_bit_cast(unsigned, f); return (u + 0x7fffu + ((u >> 16) & 1u)) >> 16; }
__device__ __forceinline__ unsigned pk2(float lo, float hi) { return f2bf(lo) | (f2bf(hi) << 16); }

#define XB_TMO      128
#define XB_XCNT(j)  (256  + 64 * (j))
#define XB_XSUB(j)  (1280 + 64 * (j))
#define XB_XGEN(j)  (2304 + 64 * (j))
#define XB_TOP      3328
#define XB_TOPGEN   3392
#define XCD_BAR_WORDS 3456
#define XB_SPIN_CAP (1u << 18)

__device__ __forceinline__ unsigned xb_ld(unsigned* p)              { return __hip_atomic_load(p, __ATOMIC_RELAXED, __HIP_MEMORY_SCOPE_AGENT); }
__device__ __forceinline__ unsigned xb_add(unsigned* p, unsigned v) { return __hip_atomic_fetch_add(p, v, __ATOMIC_RELAXED, __HIP_MEMORY_SCOPE_AGENT); }
__device__ __forceinline__ unsigned xb_xcc_id() { return (unsigned)__builtin_amdgcn_s_getreg((3 << 11) | 20) & 0xFu; }
#define XB_SPIN(cond, bar) do { unsigned _sp = 0; while (cond) { __builtin_amdgcn_s_sleep(1); \
    if ((++_sp & 255u) == 0u) { if (xb_ld(&(bar)[XB_TMO])) break; if (_sp > XB_SPIN_CAP) { atomicAdd(&(bar)[XB_TMO], 1u); break; } } } } while (0)

struct XcdBarrier {
    unsigned* bar; unsigned x;
    volatile LAS unsigned* st;
};

__device__ __forceinline__ XcdBarrier xcd_barrier_post(unsigned* bar, volatile LAS unsigned* st, int tid) {
    XcdBarrier b; b.bar = bar; b.x = xb_xcc_id(); b.st = st;
    if (tid == 0) (void)xb_add(&bar[XB_XCNT(b.x)], 1u);
    return b;
}
__device__ __forceinline__ void xcd_barrier_complete(unsigned* bar, unsigned x, unsigned& nloc, unsigned& nx) {
    const unsigned G = gridDim.x * gridDim.y * gridDim.z;
    unsigned sum, cnt, mine, sp = 0u;
    for (;;) {
        sum = 0u; cnt = 0u; mine = 0u;
#pragma unroll
        for (unsigned j = 0; j < 16; ++j) { const unsigned c = xb_ld(&bar[XB_XCNT(j)]); sum += c; cnt += (c > 0u) ? 1u : 0u; mine = (j == x) ? c : mine; }
        if (sum == G) break;
        __builtin_amdgcn_s_sleep(1);
        if ((++sp & 255u) == 0u) { if (xb_ld(&bar[XB_TMO])) break; if (sp > XB_SPIN_CAP) { atomicAdd(&bar[XB_TMO], 1u); break; } }
    }
    nloc = mine > 0u ? mine : 1u; nx = cnt > 0u ? cnt : 1u;
}

__device__ __forceinline__ void xcd_barrier(const XcdBarrier& b, int tid) {
    asm volatile("s_waitcnt vmcnt(0)" ::: "memory");
    __syncthreads();
    if (tid == 0) {
        unsigned* bar = b.bar;
        __builtin_amdgcn_s_waitcnt(0);
        unsigned nloc = b.st[0], nx = b.st[1];
        if (nloc == 0u) { xcd_barrier_complete(bar, b.x, nloc, nx); b.st[0] = nloc; b.st[1] = nx; }
        const unsigned old = xb_add(&bar[XB_XSUB(b.x)], 1u);
        const unsigned gen = old / nloc;
        if (old + 1u == (gen + 1u) * nloc) {
            __builtin_amdgcn_fence(__ATOMIC_RELEASE, "agent");
            asm volatile("s_waitcnt vmcnt(0)" ::: "memory");
            const unsigned og = xb_add(&bar[XB_TOP], 1u);
            const unsigned tg = og / nx;
            if (og + 1u == (tg + 1u) * nx) xb_add(&bar[XB_TOPGEN], 1u);
            else XB_SPIN(xb_ld(&bar[XB_TOPGEN]) == tg, bar);
            __builtin_amdgcn_fence(__ATOMIC_ACQUIRE, "agent");
            xb_add(&bar[XB_XGEN(b.x)], 1u);
            asm volatile("s_waitcnt vmcnt(0)" ::: "memory");
        } else {
            XB_SPIN(xb_ld(&bar[XB_XGEN(b.x)]) == gen, bar);
            __builtin_amdgcn_fence(__ATOMIC_ACQUIRE, "agent");
            asm volatile("s_waitcnt vmcnt(0)" ::: "memory");
        }
    }
    __syncthreads();
}

constexpr int NWAVES = 8, NTHREADS = 512;
constexpr int BATCH = 8, SEQ = 2048, DM = 2048, M = BATCH * SEQ;
constexpr int INW = 3904, INWP = 4096;
constexpr int QW = 1536, KVW = 2048, FF = 5632, FF2 = 11264, NMOD = 12288;
constexpr int C_QLAT = 0, C_KVLAT = 512, C_KROPE = 768, C_DQ = 832, C_DK = 1856, C_DV = 2880;
constexpr int MOD_SHA = 0, MOD_SCA = 2048, MOD_GA = 4096, MOD_SHF = 6144, MOD_SCF = 8192, MOD_GF = 10240;
constexpr float EPS = 1e-6f, MLA_SCALE = 0.07216878364870322f, DIFF_SCALE = 0.125f, LAMBDA_INIT = 0.2f;
constexpr int UCH = 4096, NUCH = M / UCH;

constexpr size_t MiB = 1u << 20;
constexpr size_t WS_CTL = 0, CTL_ZERO_BYTES = 1 * MiB, WS_MOD = 512 * 1024, WS_SSQQ = 128 * 1024, WS_SSQKV = 192 * 1024;
constexpr int TKF_OFF = 1024;
constexpr size_t WS_COS = 2 * MiB, WS_SIN = 4 * MiB, WS_TK = 6 * MiB;
constexpr size_t WS_WIN = 8 * MiB, WS_WUQ = 24 * MiB, WS_WUKV = 26 * MiB, WS_WO = 28 * MiB, WS_WUP = 36 * MiB, WS_WDN = 80 * MiB;
constexpr size_t WS_H = 104 * MiB;
constexpr size_t WS_PROJ = 168 * MiB, WS_Q = 296 * MiB, WS_KV = 344 * MiB, WS_AO = 408 * MiB;
constexpr size_t WS_Y = 168 * MiB;
constexpr size_t WS_G = 168 * MiB;
constexpr size_t WS_E = 344 * MiB;
constexpr size_t WS_Y2 = 344 * MiB;
constexpr size_t WS_X1 = 408 * MiB;
constexpr size_t WS_END = 512 * MiB;
constexpr int CW_TMO = 0, CW_CODE = 1, CW_BAR = 4096;

constexpr int LDS_BYTES = 147456;
constexpr int LDSCTL_OFF = LDS_BYTES - 512, MISC_OFF = LDSCTL_OFF;

__device__ __forceinline__ float bf2f(unsigned short u) { return __uint_as_float((unsigned)u << 16); }
__device__ __forceinline__ float bflo(unsigned w) { return __uint_as_float(w << 16); }
__device__ __forceinline__ float bfhi(unsigned w) { return __uint_as_float(w & 0xffff0000u); }
__device__ __forceinline__ float wave_sum(float v) {
#pragma unroll
    for (int o = 1; o < 64; o <<= 1) v += __shfl_xor(v, o);
    return v;
}
__device__ __forceinline__ float wave_max(float v) {
#pragma unroll
    for (int o = 1; o < 64; o <<= 1) v = fmaxf(v, __shfl_xor(v, o));
    return v;
}
__device__ __forceinline__ int t5_bucket(int rel) {
    const int ret = rel > 0 ? 16 : 0; const int n = rel < 0 ? -rel : rel; const float nf = (float)(n > 1 ? n : 1);
    int large = 8 + (int)(logf(nf / 8.0f) / 2.772588722239781f * 8.0f);
    large = large < 15 ? large : 15;
    return ret + (n < 8 ? n : large);
}
__device__ __forceinline__ float gelu_tanh(float x) {
    const float z2 = 1.5957691216057308f * (x + 0.044715f * x * x * x);
    return x / (1.0f + __expf(-z2));
}


constexpr int PTR_OFF = LDSCTL_OFF + 128;
enum { P_X = 0, P_C, P_POS, P_RELB, P_ADAW, P_ADAB, P_APRE, P_APOST, P_WIN, P_QN, P_WUQ, P_KVN, P_WUKV, P_LQ1, P_LK1, P_LQ2, P_LK2, P_SUBLN, P_WO, P_FPRE, P_FPOST, P_WUP, P_CW, P_CB, P_WDN, P_OUT, P_WS };
__device__ __forceinline__ const void* ldptr(LAS unsigned char* lds, int i) {
    const unsigned long long v = *(volatile LAS unsigned long long*)(lds + PTR_OFF + 8 * i);
    const unsigned lo = __builtin_amdgcn_readfirstlane((unsigned)v), hi = __builtin_amdgcn_readfirstlane((unsigned)(v >> 32));
    return (const void*)(GAS const void*)(((unsigned long long)hi << 32) | lo);
}
#define LPF(i) ((const float*)ldptr(lds, (i)))
#define LPWS() ((unsigned char*)ldptr(lds, P_WS))

__device__ __forceinline__ int dst_row(int s, int map) {
    if (map == 1) { if (s >= C_KROPE && s < C_KROPE + 64) { const int d = s - C_KROPE; return C_KROPE + 2 * (d & 31) + (d >> 5); } return s; }
    if (map == 2) { const int h = s / 192, d = s % 192; if (d >= 128) return h * 192 + 128 + 2 * ((d - 128) & 31) + ((d - 128) >> 5); return s; }
    return s;
}
__device__ __forceinline__ void p0_transpose_item(const float* W, const float* sv, int K, int N, bf16* WT, LAS float* scr, int item, int lane, int map) {
    const int nblk = N / 64, kb = item / nblk, nb = item % nblk, k0 = 64 * kb, n0 = 64 * nb;
    const int lr = lane >> 4, lc = (lane & 15) * 4;
    f32x4 v[16];
#pragma unroll
    for (int i = 0; i < 16; ++i) v[i] = __builtin_nontemporal_load((const f32x4*)(W + (size_t)(k0 + 4 * i + lr) * N + n0 + lc));
#pragma unroll
    for (int i = 0; i < 16; ++i) { const int kk = 4 * i + lr; f32x4 w = v[i]; if (sv) w = w * sv[k0 + kk];
        LAS float* d = scr + kk * 65 + lc; d[0] = w[0]; d[1] = w[1]; d[2] = w[2]; d[3] = w[3]; }
    LDS_WAIT(); asm volatile("" ::: "memory");
    const int c = lane & 7;
#pragma unroll
    for (int j = 0; j < 8; ++j) { const int n = (lane >> 3) + 8 * j; const LAS float* s = scr + (8 * c) * 65 + n;
        v4u o; o.x = pk2(s[0 * 65], s[1 * 65]); o.y = pk2(s[2 * 65], s[3 * 65]); o.z = pk2(s[4 * 65], s[5 * 65]); o.w = pk2(s[6 * 65], s[7 * 65]);
        __builtin_nontemporal_store(o, (GAS v4u*)(WT + (size_t)dst_row(n0 + n, map) * K + k0 + 8 * c)); }
    LDS_WAIT(); asm volatile("" ::: "memory");
}
__device__ __forceinline__ void p0_prologue(LAS unsigned char* lds, int tid, int lane, int wave, int G, int bid) {
    { unsigned char* ws = LPWS(); float* mod = (float*)(ws + WS_MOD); const float* in_c = LPF(P_C); const float* in_adaw = LPF(P_ADAW); const float* in_adab = LPF(P_ADAB);
    for (int item = bid; item < 256; item += G) {
        const int kc = item >> 5, cc = item & 31;
        LAS float* scl = (LAS float*)lds;
        LAS float* red = (LAS float*)(lds + 8192);
        for (int e = tid; e < 2048; e += NTHREADS) { const int b = e >> 8, i = e & 255; const float cv = in_c[b * DM + 256 * kc + i]; scl[e] = cv / (1.0f + __expf(-cv)); }
        __syncthreads();
        if (tid < 384) {
            const int kg = tid / 96, ct = tid % 96;
            f32x4 acc[8];
#pragma unroll
            for (int b = 0; b < 8; ++b) acc[b] = (f32x4){0.f, 0.f, 0.f, 0.f};
            const float* wp = in_adaw + (size_t)(256 * kc + 64 * kg) * NMOD + 384 * cc + 4 * ct;
#pragma unroll 8
            for (int kk = 0; kk < 64; ++kk) {
                const f32x4 w = __builtin_nontemporal_load((const f32x4*)(wp + (size_t)kk * NMOD));
#pragma unroll
                for (int b = 0; b < 8; ++b) acc[b] += w * scl[b * 256 + 64 * kg + kk];
            }
#pragma unroll
            for (int b = 0; b < 8; ++b) *(LAS f32x4*)(red + (kg * 8 + b) * 384 + 4 * ct) = acc[b];
        }
        __syncthreads();
        for (int o = tid; o < 3072; o += NTHREADS) { const int b = o / 384, col = o % 384;
            float v = (red[(0 * 8 + b) * 384 + col] + red[(1 * 8 + b) * 384 + col]) + (red[(2 * 8 + b) * 384 + col] + red[(3 * 8 + b) * 384 + col]);
            if (kc == 0) v += in_adab[384 * cc + col];
            atomicAdd(mod + b * NMOD + 384 * cc + col, v); }
        __syncthreads();
    } }
    unsigned char* ws = LPWS();
    LAS float* scr = (LAS float*)(lds + wave * 16640);
    const int gw = bid * NWAVES + wave, NGW = G * NWAVES;
    constexpr int I_IN = (DM / 64) * (INW / 64), I_UQ = (512 / 64) * (QW / 64), I_UKV = (256 / 64) * (KVW / 64), I_O = (DM / 64) * (DM / 64), I_UP = (DM / 64) * (FF2 / 64), I_DN = (FF / 64) * (DM / 64);
    const int NITEMS = (G == 256) ? I_IN + I_UQ + I_UKV : I_IN + I_UQ + I_UKV + I_O + I_UP + I_DN;
    for (int it = gw; it < NITEMS; it += NGW) {
        int r = it;
        if (r < I_IN) { p0_transpose_item(LPF(P_WIN), nullptr, DM, INW, (bf16*)(ws + WS_WIN), scr, r, lane, 1); continue; } r -= I_IN;
        if (r < I_UQ) { p0_transpose_item(LPF(P_WUQ), LPF(P_QN), 512, QW, (bf16*)(ws + WS_WUQ), scr, r, lane, 2); continue; } r -= I_UQ;
        if (r < I_UKV) { p0_transpose_item(LPF(P_WUKV), LPF(P_KVN), 256, KVW, (bf16*)(ws + WS_WUKV), scr, r, lane, 0); continue; } r -= I_UKV;
        if (r < I_O) { p0_transpose_item(LPF(P_WO), nullptr, DM, DM, (bf16*)(ws + WS_WO), scr, r, lane, 0); continue; } r -= I_O;
        if (r < I_UP) { p0_transpose_item(LPF(P_WUP), nullptr, DM, FF2, (bf16*)(ws + WS_WUP), scr, r, lane, 0); continue; } r -= I_UP;
        p0_transpose_item(LPF(P_WDN), nullptr, FF, DM, (bf16*)(ws + WS_WDN), scr, r, lane, 0);
    }
    { v4u* z = (v4u*)(ws + WS_WIN + (size_t)INW * DM * 2); const v4u zero = {0u, 0u, 0u, 0u};
      for (int i = bid * NTHREADS + tid; i < (INWP - INW) * DM * 2 / 16; i += G * NTHREADS) z[i] = zero; }
    { float* COS = (float*)(ws + WS_COS); float* SIN = (float*)(ws + WS_SIN); const int* in_pos = (const int*)ldptr(lds, P_POS);
      for (int idx = bid * NTHREADS + tid; idx < M * 32; idx += G * NTHREADS) {
          const int m = idx >> 5, i = idx & 31;
          const float inv = 1.0f / exp2f((float)i * (13.287712379549449f / 32.0f));
          const float ang = (float)in_pos[m] * inv;
          double t = (double)ang * 0.15915494309189535; t -= rint(t);
          const float tf = (float)t;
          COS[idx] = __builtin_amdgcn_cosf(tf); SIN[idx] = __builtin_amdgcn_sinf(tf); } }
    { int* TK = (int*)(ws + WS_TK); const int* in_pos = (const int*)ldptr(lds, P_POS);
      for (int it = gw; it < BATCH * (SEQ / 64); it += NGW) { const int p = in_pos[it * 64 + lane]; int mn = p, mx = p;
#pragma unroll
          for (int of = 1; of < 64; of <<= 1) { mn = min(mn, __shfl_xor(mn, of)); mx = max(mx, __shfl_xor(mx, of)); }
          const bool cont = __all(p - lane == __builtin_amdgcn_readfirstlane(p));
          if (lane == 0) { TK[2 * it] = mn; TK[2 * it + 1] = mx; TK[TKF_OFF + it] = cont ? 1 : 0; } } }
}

__device__ __forceinline__ void prenorm_phase(const float* x, const float* wn, const float* mod, int off_sh, int off_sc, bf16* H, int lane, int wave, int G, int bid) {
    const int gw = bid * NWAVES + wave, NGW = G * NWAVES;
    for (int m = gw; m < M; m += NGW) {
        const f32x4* xr = (const f32x4*)(x + (size_t)m * DM) + lane;
        f32x4 v[8]; float ss = 0.f;
#pragma unroll
        for (int j = 0; j < 8; ++j) { v[j] = __builtin_nontemporal_load(xr + 64 * j); ss += (v[j].x * v[j].x + v[j].y * v[j].y) + (v[j].z * v[j].z + v[j].w * v[j].w); }
        const float rstd = rsqrtf(wave_sum(ss) * (1.0f / DM) + EPS);
        const float* mb = mod + (size_t)(m >> 11) * NMOD;
#pragma unroll
        for (int j = 0; j < 8; ++j) { const int col = (lane + 64 * j) * 4;
            const f32x4 w = *(const f32x4*)(wn + col), sh = *(const f32x4*)(mb + off_sh + col), sc = *(const f32x4*)(mb + off_sc + col);
            const f32x4 o = v[j] * rstd * w * (sc + 1.0f) + sh;
            uint2 pk; pk.x = pk2(o.x, o.y); pk.y = pk2(o.z, o.w);
            *(uint2*)(H + (size_t)m * DM + col) = pk; }
    }
}
template <bool NEXT>
__device__ __forceinline__ void post_phase(const bf16* Y, const void* xin_, void* xout_, const float* wpost, const float* mod, int off_g,
                                           const float* wn2, int off_sh, int off_sc, bf16* Hn, int lane, int wave, int G, int bid) {
    const int gw = bid * NWAVES + wave, NGW = G * NWAVES;
    for (int m = gw; m < M; m += NGW) {
        const uint2* yr = (const uint2*)(Y + (size_t)m * DM) + lane;
        const f32x4* xr = (const f32x4*)((const float*)xin_ + (size_t)m * DM) + lane;
        const uint2* xb = (const uint2*)((const bf16*)xin_ + (size_t)m * DM) + lane;
        f32x4 v[8]; float ss = 0.f;
#pragma unroll
        for (int j = 0; j < 8; ++j) { const unsigned long long yq_ = __builtin_nontemporal_load((const unsigned long long*)(yr + 64 * j)); uint2 yw; yw.x = (unsigned)yq_; yw.y = (unsigned)(yq_ >> 32); v[j] = (f32x4){bflo(yw.x), bfhi(yw.x), bflo(yw.y), bfhi(yw.y)}; ss += (v[j].x * v[j].x + v[j].y * v[j].y) + (v[j].z * v[j].z + v[j].w * v[j].w); }
        const float rstd = rsqrtf(wave_sum(ss) * (1.0f / DM) + EPS);
        const float* mb = mod + (size_t)(m >> 11) * NMOD;
        float ss2 = 0.f;
#pragma unroll
        for (int j = 0; j < 8; ++j) { const int col = (lane + 64 * j) * 4;
            const f32x4 w = *(const f32x4*)(wpost + col), g = *(const f32x4*)(mb + off_g + col);
            f32x4 xv;
            if constexpr (NEXT) xv = __builtin_nontemporal_load(xr + 64 * j);
            else { const unsigned long long xq_ = __builtin_nontemporal_load((const unsigned long long*)(xb + 64 * j)); const unsigned x0 = (unsigned)xq_, x1 = (unsigned)(xq_ >> 32); xv = (f32x4){bflo(x0), bfhi(x0), bflo(x1), bfhi(x1)}; }
            const f32x4 o = xv + g * (v[j] * rstd * w);
            v[j] = o; ss2 += (o.x * o.x + o.y * o.y) + (o.z * o.z + o.w * o.w);
            if constexpr (NEXT) { uint2 pk; pk.x = pk2(o.x, o.y); pk.y = pk2(o.z, o.w); *(uint2*)((bf16*)xout_ + (size_t)m * DM + col) = pk; }
            else *(f32x4*)((float*)xout_ + (size_t)m * DM + col) = o; }
        if (NEXT) {
            const float rstd2 = rsqrtf(wave_sum(ss2) * (1.0f / DM) + EPS);
#pragma unroll
            for (int j = 0; j < 8; ++j) { const int col = (lane + 64 * j) * 4;
                const f32x4 w = *(const f32x4*)(wn2 + col), sh = *(const f32x4*)(mb + off_sh + col), sc = *(const f32x4*)(mb + off_sc + col);
                const f32x4 o = v[j] * rstd2 * w * (sc + 1.0f) + sh;
                uint2 pk; pk.x = pk2(o.x, o.y); pk.y = pk2(o.z, o.w);
                *(uint2*)(Hn + (size_t)m * DM + col) = pk; }
        }
    }
}
__device__ __forceinline__ void fixup_phase(const bf16* E, bf16* Gb, const float* cw, const float* cb, int tid, int G, int bid) {
    constexpr int NPN = FF / 128;
    for (int idx = bid * NTHREADS + tid; idx < 256 * NPN * 16; idx += G * NTHREADS) {
        const int g = idx / (NPN * 16), rem = idx % (NPN * 16), pn = rem >> 4, fl = (rem & 15) * 8;
        if ((g & 31) == 0) continue;
        const bf16* ea = E + ((size_t)(pn * 256 + g - 1) * 4 + 2) * 256 + fl; const bf16* ec = E + ((size_t)(pn * 256 + g) * 4) * 256 + fl;
        const v4u ga = *(const v4u*)ea, gbv = *(const v4u*)(ea + 256), gc = *(const v4u*)ec, gd = *(const v4u*)(ec + 256);
        const v4u va = *(const v4u*)(ea + 128), vbv = *(const v4u*)(ea + 256 + 128), vc = *(const v4u*)(ec + 128), vd = *(const v4u*)(ec + 256 + 128);
        unsigned o0[4], o1[4];
#pragma unroll
        for (int q = 0; q < 4; ++q) {
            float r0[2], r1[2];
#pragma unroll
            for (int hh = 0; hh < 2; ++hh) { const int f = pn * 128 + fl + 2 * q + hh;
                const float a = hh ? bfhi(ga[q]) : bflo(ga[q]), b = hh ? bfhi(gbv[q]) : bflo(gbv[q]), c = hh ? bfhi(gc[q]) : bflo(gc[q]), d = hh ? bfhi(gd[q]) : bflo(gd[q]);
                const float xa = hh ? bfhi(va[q]) : bflo(va[q]), xb = hh ? bfhi(vbv[q]) : bflo(vbv[q]), xc = hh ? bfhi(vc[q]) : bflo(vc[q]), xd = hh ? bfhi(vd[q]) : bflo(vd[q]);
                const float w0 = cw[f], w1 = cw[FF2 + f], w2 = cw[2 * FF2 + f], wb = cb[f], y0 = cw[FF + f], y1 = cw[FF2 + FF + f], y2 = cw[2 * FF2 + FF + f], yb = cb[FF + f];
                r0[hh] = gelu_tanh(wb + w0 * a + w1 * b + w2 * c) * (yb + y0 * xa + y1 * xb + y2 * xc);
                r1[hh] = gelu_tanh(wb + w0 * b + w1 * c + w2 * d) * (yb + y0 * xb + y1 * xc + y2 * xd); }
            o0[q] = pk2(r0[0], r0[1]); o1[q] = pk2(r1[0], r1[1]); }
        const v4u w0 = {o0[0], o0[1], o0[2], o0[3]}, w1 = {o1[0], o1[1], o1[2], o1[3]};
        *(v4u*)(Gb + (size_t)(64 * g - 1) * FF + pn * 128 + fl) = w0; *(v4u*)(Gb + (size_t)(64 * g) * FF + pn * 128 + fl) = w1;
    }
}


namespace att {
typedef short bf16x8 __attribute__((ext_vector_type(8)));
typedef short s16x4 __attribute__((ext_vector_type(4)));
typedef float f32x16 __attribute__((ext_vector_type(16)));
typedef unsigned u32x4 __attribute__((ext_vector_type(4)));
typedef LAS char* lptr;
#define KSWZ(row, colB) ((row) * 256 + ((colB) ^ (((row) & 7) << 4)))
#define KRSWZ(row, colB) ((row) * 128 + ((colB) ^ ((((row) >> 1) & 7) << 4)))
#define SBAR() __builtin_amdgcn_sched_barrier(0)
constexpr int QBLK = 32, KVBLK = 64, SHM_V = KVBLK * 128 * 2, SHM_K = KVBLK * 128 * 2, SHM_KR = KVBLK * 64 * 2;
constexpr float LOG2E = 1.4426950408889634f;
constexpr float THRL = 8.0f * LOG2E;
__device__ __forceinline__ int crow(int r, int hi) { return (r & 3) + 8 * (r >> 2) + 4 * hi; }
__device__ __forceinline__ unsigned cvtpk(float lo, float hi) { unsigned r; asm volatile("v_cvt_pk_bf16_f32 %0, %1, %2" : "=v"(r) : "v"(lo), "v"(hi)); return r; }
__device__ __forceinline__ bf16x8 ld8(const bf16* p) { return *reinterpret_cast<const bf16x8*>(p); }

template <bool EXPALL = false>
__device__ __forceinline__ void partialSM(f32x16& p0, f32x16& p1, float C, float bl, float& m_reg, float& alpha) {
    float pmax = p0[0];
#pragma unroll
    for (int r = 1; r < 16; ++r) pmax = fmaxf(pmax, p0[r]);
#pragma unroll
    for (int r = 0; r < 16; ++r) pmax = fmaxf(pmax, p1[r]);
    { auto rr = __builtin_amdgcn_permlane32_swap(__float_as_uint(pmax), __float_as_uint(pmax), false, false);
      pmax = fmaxf(__uint_as_float(rr[0]), __uint_as_float(rr[1])); }
    const float tmax = fmaf(pmax, C, bl);
    float mn;
    if (__builtin_expect(__all(tmax - m_reg <= THRL), 1)) { mn = m_reg; alpha = 1.f; }
    else { mn = fmaxf(m_reg, tmax); alpha = __builtin_amdgcn_exp2f(m_reg - mn); m_reg = mn; }
    const float off = bl - mn;
#pragma unroll
    for (int r = 0; r < 16; ++r) p0[r] = fmaf(p0[r], C, off);
#pragma unroll
    for (int r = 0; r < 16; ++r) p1[r] = fmaf(p1[r], C, off);
#pragma unroll
    for (int r = 0; r < 16; ++r) p0[r] = __builtin_amdgcn_exp2f(p0[r]);
    if (EXPALL) {
#pragma unroll
        for (int r = 0; r < 16; ++r) p1[r] = __builtin_amdgcn_exp2f(p1[r]); }
}
__device__ __forceinline__ void lut_adjust(f32x16& p0, f32x16& p1, const LAS float* lutx, const LAS int* kp, int qp, int hi) {
#pragma unroll
    for (int r = 0; r < 16; ++r) { const int key = crow(r, hi);
        int d0 = kp[key] - qp, d1 = kp[key + 32] - qp;
        d0 = d0 < -128 ? -128 : (d0 > 128 ? 128 : d0); d1 = d1 < -128 ? -128 : (d1 > 128 ? 128 : d1);
        p0[r] += lutx[d0 + 256]; p1[r] += lutx[d1 + 256]; }
}
__device__ __forceinline__ void lut_adjust_fast(f32x16& p0, f32x16& p1, const LAS float* lutx, int kp0, int qp, int hi) {
    const LAS float* bp = lutx + (kp0 - qp + 256 + 4 * hi);
#pragma unroll
    for (int r = 0; r < 16; ++r) { const int off = (r & 3) + 8 * (r >> 2); p0[r] += bp[off]; p1[r] += bp[off + 32]; }
}
template <bool EXPDONE = false>
__device__ __forceinline__ void finishSM(f32x16& p0, f32x16& p1, float alpha, float& l_reg, bf16x8& pa0, bf16x8& pa1, bf16x8& pa2, bf16x8& pa3) {
    if (!EXPDONE) {
#pragma unroll
        for (int r = 0; r < 16; ++r) p1[r] = __builtin_amdgcn_exp2f(p1[r]); }
    float ps = 0;
#pragma unroll
    for (int r = 0; r < 16; ++r) ps += p0[r];
#pragma unroll
    for (int r = 0; r < 16; ++r) ps += p1[r];
    { auto rr = __builtin_amdgcn_permlane32_swap(__float_as_uint(ps), __float_as_uint(ps), false, false);
      ps = __uint_as_float(rr[0]) + __uint_as_float(rr[1]); }
    l_reg = l_reg * alpha + ps;
#define PK4(P, BASE, OUT) do { u32x4 w = {cvtpk(P[BASE + 0], P[BASE + 1]), cvtpk(P[BASE + 2], P[BASE + 3]), cvtpk(P[BASE + 4], P[BASE + 5]), cvtpk(P[BASE + 6], P[BASE + 7])}; \
    OUT = *reinterpret_cast<bf16x8*>(&w); } while (0)
    PK4(p0, 0, pa0); PK4(p0, 8, pa1); PK4(p1, 0, pa2); PK4(p1, 8, pa3);
#undef PK4
}
__device__ __forceinline__ int v_st(int k, int c) { const int kk = (k & ~0xC) | ((k & 4) << 1) | ((k & 8) >> 1); return ((kk >> 3) * 4 + (c >> 5)) * 512 + ((kk & 7) * 32 + (c & 31)) * 2; }
__device__ __forceinline__ int v_rd_base(int lane) { return ((lane & 3) << 3) | (((lane >> 2) & 3) << 6) | (((lane >> 4) & 1) << 5) | (((lane >> 5) & 1) << 8); }
constexpr int v_rd_off(int d0, int ks, int half) { return d0 * 512 + ks * 4096 + half * 2048; }
template <int OFF> __device__ __forceinline__ s16x4 tr_read(int vb) {
    s16x4 r; asm volatile("ds_read_b64_tr_b16 %0, %1 offset:%2" : "=&v"(r) : "v"(vb), "i"(OFF) : "memory"); return r;
}
template <int D0, bool PRIO = true> __device__ __forceinline__ void pv_one(f32x16& od, int vb, bf16x8 pa0, bf16x8 pa1, bf16x8 pa2, bf16x8 pa3) {
    const s16x4 l0 = tr_read<v_rd_off(D0, 0, 0)>(vb), h0 = tr_read<v_rd_off(D0, 0, 1)>(vb), l1 = tr_read<v_rd_off(D0, 1, 0)>(vb), h1 = tr_read<v_rd_off(D0, 1, 1)>(vb);
    const s16x4 l2 = tr_read<v_rd_off(D0, 2, 0)>(vb), h2 = tr_read<v_rd_off(D0, 2, 1)>(vb), l3 = tr_read<v_rd_off(D0, 3, 0)>(vb), h3 = tr_read<v_rd_off(D0, 3, 1)>(vb);
    asm volatile("s_waitcnt lgkmcnt(0)" ::: "memory"); SBAR();
    if (PRIO) __builtin_amdgcn_s_setprio(1);
#define PK(L, H) (bf16x8){L[0], L[1], L[2], L[3], H[0], H[1], H[2], H[3]}
    od = __builtin_amdgcn_mfma_f32_32x32x16_bf16(pa0, PK(l0, h0), od, 0, 0, 0);
    od = __builtin_amdgcn_mfma_f32_32x32x16_bf16(pa1, PK(l1, h1), od, 0, 0, 0);
    od = __builtin_amdgcn_mfma_f32_32x32x16_bf16(pa2, PK(l2, h2), od, 0, 0, 0);
    od = __builtin_amdgcn_mfma_f32_32x32x16_bf16(pa3, PK(l3, h3), od, 0, 0, 0);
    if (PRIO) __builtin_amdgcn_s_setprio(0);
#undef PK
}
template <bool PRIO = true> __device__ __forceinline__ void pv_d0(f32x16* o, int vb, bf16x8 pa0, bf16x8 pa1, bf16x8 pa2, bf16x8 pa3) {
    pv_one<0, PRIO>(o[0], vb, pa0, pa1, pa2, pa3); pv_one<1, PRIO>(o[1], vb, pa0, pa1, pa2, pa3); pv_one<2, PRIO>(o[2], vb, pa0, pa1, pa2, pa3); pv_one<3, PRIO>(o[3], vb, pa0, pa1, pa2, pa3);
}
#ifndef DF_PRIO
#define DF_PRIO false
#endif
#ifndef ML_PRIO
#define ML_PRIO true
#endif
struct KAddr { int kb[4]; int krb[4]; };
__device__ __forceinline__ KAddr make_kaddr(int r32, int hi) {
    KAddr a; const int y = (hi * 16) ^ ((r32 & 7) << 4), y2 = (hi * 16) ^ (((r32 >> 1) & 7) << 4);
#pragma unroll
    for (int j = 0; j < 4; ++j) { a.kb[j] = r32 * 256 + ((j * 32) ^ y); a.krb[j] = r32 * 128 + ((j * 32) ^ y2); }
    return a;
}
template <int ND0, int NR, bool PRIO = true>
__device__ __forceinline__ void qkt(f32x16& p0, f32x16& p1, lptr Ks, lptr KRs, lptr QRs, const bf16x8* qr, int d0b, const KAddr& ka, const f32x16& cinit) {
    if (PRIO) __builtin_amdgcn_s_setprio(1);
#pragma unroll
    for (int d0 = 0; d0 < ND0; ++d0) {
        const bf16x8 b0 = *reinterpret_cast<const LAS bf16x8*>(Ks + ka.kb[d0 & 3] + ((d0b + d0) >> 2) * 128);
        const bf16x8 b1 = *reinterpret_cast<const LAS bf16x8*>(Ks + ka.kb[d0 & 3] + ((d0b + d0) >> 2) * 128 + 32 * 256);
        if (d0 == 0) { p0 = __builtin_amdgcn_mfma_f32_32x32x16_bf16(b0, qr[d0], cinit, 0, 0, 0); p1 = __builtin_amdgcn_mfma_f32_32x32x16_bf16(b1, qr[d0], cinit, 0, 0, 0); }
        else { p0 = __builtin_amdgcn_mfma_f32_32x32x16_bf16(b0, qr[d0], p0, 0, 0, 0); p1 = __builtin_amdgcn_mfma_f32_32x32x16_bf16(b1, qr[d0], p1, 0, 0, 0); } }
#pragma unroll
    for (int d0 = 0; d0 < NR; ++d0) {
        const bf16x8 b0 = *reinterpret_cast<const LAS bf16x8*>(KRs + ka.krb[d0]);
        const bf16x8 b1 = *reinterpret_cast<const LAS bf16x8*>(KRs + ka.krb[d0] + 32 * 128);
        p0 = __builtin_amdgcn_mfma_f32_32x32x16_bf16(b0, qr[ND0 + d0], p0, 0, 0, 0);
        p1 = __builtin_amdgcn_mfma_f32_32x32x16_bf16(b1, qr[ND0 + d0], p1, 0, 0, 0); }
    if (PRIO) __builtin_amdgcn_s_setprio(0);
}
template <bool EXPALL, bool FIRST>
__device__ __forceinline__ void partialSMn(f32x16& p0, f32x16& p1, float& m_reg, float& alpha) {
    float pmax = p0[0];
#pragma unroll
    for (int r = 1; r < 16; ++r) pmax = fmaxf(pmax, p0[r]);
#pragma unroll
    for (int r = 0; r < 16; ++r) pmax = fmaxf(pmax, p1[r]);
    { auto rr = __builtin_amdgcn_permlane32_swap(__float_as_uint(pmax), __float_as_uint(pmax), false, false);
      pmax = fmaxf(__uint_as_float(rr[0]), __uint_as_float(rr[1])); }
    alpha = 1.f;
    if (FIRST) { m_reg = pmax; alpha = 0.f;
#pragma unroll
        for (int r = 0; r < 16; ++r) { p0[r] -= pmax; p1[r] -= pmax; } }
    else if (__builtin_expect(!__all(pmax <= THRL), 0)) { const float delta = fmaxf(pmax, 0.f); m_reg += delta; alpha = __builtin_amdgcn_exp2f(-delta);
#pragma unroll
        for (int r = 0; r < 16; ++r) { p0[r] -= delta; p1[r] -= delta; } }
#pragma unroll
    for (int r = 0; r < 16; ++r) p0[r] = __builtin_amdgcn_exp2f(p0[r]);
    if (EXPALL) {
#pragma unroll
        for (int r = 0; r < 16; ++r) p1[r] = __builtin_amdgcn_exp2f(p1[r]); }
}
__device__ __forceinline__ bf16x8 scale_frag(bf16x8 q, float c) {
    const u32x4 w = __builtin_bit_cast(u32x4, q); u32x4 o;
#pragma unroll
    for (int i = 0; i < 4; ++i) o[i] = cvtpk(__uint_as_float(w[i] << 16) * c, __uint_as_float(w[i] & 0xffff0000u) * c);
    return __builtin_bit_cast(bf16x8, o);
}
#define SETNEG(BL) do { const float nv_ = (BL) - m_reg; if (__any(nv_ != negv)) { negv = nv_; _Pragma("unroll") for (int r = 0; r < 16; ++r) negm[r] = nv_; asm volatile("" : "+v"(negm)); } } while (0)

__device__ __forceinline__ void glds16(const bf16* g, lptr l) { __builtin_amdgcn_global_load_lds((const unsigned*)g, (LAS unsigned*)l, 16, 0, 0); }
#define WAITV(n) asm volatile("s_waitcnt vmcnt(" #n ")" ::: "memory")
#define ABAR() do { asm volatile("s_waitcnt lgkmcnt(0)" ::: "memory"); __builtin_amdgcn_s_barrier(); asm volatile("" ::: "memory"); } while (0)
__device__ __forceinline__ long ksrc_off(int p, int lane, int stride) { const int row = 4 * p + (lane >> 4), c = (lane & 15) ^ (row & 7); return (long)row * stride + c * 8; }
__device__ __forceinline__ long krsrc_off(int p, int lane, int stride) { const int row = 8 * p + (lane >> 3), c = (lane & 7) ^ ((row >> 1) & 7); return (long)row * stride + c * 8; }
__device__ __forceinline__ long vsrc_off(int p, int lane, int stride) { const int st = 2 * p + (lane >> 5), kk = (st >> 2) * 8 + ((lane & 31) >> 2);
    const int k = kk, col = (st & 3) * 32 + (lane & 3) * 8; return (long)k * stride + col; }
#define RESC(a) do { if (__any((a) < 1.f)) { if (hi == 0) al_l[r32] = (a); asm volatile("s_waitcnt lgkmcnt(0)" ::: "memory"); \
    _Pragma("unroll") for (int d = 0; d < 4; ++d) _Pragma("unroll") for (int r = 0; r < 16; ++r) o[d][r] *= al_l[crow(r, hi)]; } } while (0)

constexpr int ML_SLOT = SHM_K + SHM_V + SHM_KR, ML_NS = 3, ML_WS = ML_NS * ML_SLOT, MLA_LDS = ML_WS + 8 * 64 * 4;
__device__ __forceinline__ void mla_unit(const bf16* __restrict__ Qb, const bf16* __restrict__ KNh, const bf16* __restrict__ KRb, bf16* __restrict__ Ob, lptr lds, int tid) {
    constexpr float C = MLA_SCALE * LOG2E;
    const int wid = __builtin_amdgcn_readfirstlane(tid >> 6), lane = tid & 63, r32 = lane & 31, hi = lane >> 5;
    LAS float* ws = (LAS float*)(lds + ML_WS) + wid * 64; LAS float* li_l = ws; LAS float* al_l = ws + 32;
    float m_reg = -1e30f, l_reg = 0; f32x16 o[4] = {}; bf16x8 qr[12]; const f32x16 zero16 = {};
    const bf16* Qw = Qb + (long)(wid * QBLK + r32) * QW + hi * 8;
#pragma unroll
    for (int d0 = 0; d0 < 12; ++d0) qr[d0] = ld8(Qw + d0 * 16);
    const KAddr ka = make_kaddr(r32, hi);
    const bf16* Vh = KNh + 128;
    const int vb0 = (int)(unsigned)(uintptr_t)lds + SHM_K + v_rd_base(lane);
    const long ko0 = ksrc_off(2 * wid, lane, KVW), ko1 = ksrc_off(2 * wid + 1, lane, KVW), vo0 = vsrc_off(2 * wid, lane, KVW), vo1 = vsrc_off(2 * wid + 1, lane, KVW), ro0 = krsrc_off(wid, lane, INWP);
    lptr dK = lds + wid * 2048, dV = lds + SHM_K + wid * 2048, dR = lds + SHM_K + SHM_V + wid * 1024;
#define DMA(t, so) do { const long kr_ = (long)(t) * KVBLK; const bf16* kp_ = KNh + kr_ * KVW; const bf16* vp_ = Vh + kr_ * KVW; const bf16* rp_ = KRb + kr_ * INWP; \
    glds16(kp_ + ko0, dK + (so)); glds16(kp_ + ko1, dK + (so) + 1024); glds16(vp_ + vo0, dV + (so)); glds16(vp_ + vo1, dV + (so) + 1024); glds16(rp_ + ro0, dR + (so)); } while (0)
#define ROT3() do { const int t_ = sp; sp = sc; sc = sn; sn = t_; } while (0)
    f32x16 pA0, pA1, pB0, pB1; float alA, alB; bf16x8 pa0, pa1, pa2, pa3; constexpr int NT = SEQ / KVBLK;
    int sp = 0, sc = 0, sn = ML_SLOT;
    DMA(0, 0); DMA(1, ML_SLOT); WAITV(5); ABAR();
    qkt<8, 4, ML_PRIO>(pA0, pA1, lds, lds + SHM_K + SHM_V, lds, qr, 0, ka, zero16); partialSM(pA0, pA1, C, 0.f, m_reg, alA);
    WAITV(0); ABAR();
    sp = 0; sc = ML_SLOT; sn = 2 * ML_SLOT;
    for (int j = 1; j + 1 < NT; j += 2) {
        DMA(j + 1, sn);
        SBAR(); qkt<8, 4, ML_PRIO>(pB0, pB1, lds + sc, lds + sc + SHM_K + SHM_V, lds, qr, 0, ka, zero16);
        finishSM(pA0, pA1, alA, l_reg, pa0, pa1, pa2, pa3); SBAR();
        pv_d0<ML_PRIO>(o, vb0 + sp, pa0, pa1, pa2, pa3); partialSM(pB0, pB1, C, 0.f, m_reg, alB);
        WAITV(0); ABAR(); RESC(alB); ROT3();
        if (j + 2 < NT) DMA(j + 2, sn);
        SBAR(); qkt<8, 4, ML_PRIO>(pA0, pA1, lds + sc, lds + sc + SHM_K + SHM_V, lds, qr, 0, ka, zero16);
        finishSM(pB0, pB1, alB, l_reg, pa0, pa1, pa2, pa3); SBAR();
        pv_d0<ML_PRIO>(o, vb0 + sp, pa0, pa1, pa2, pa3); partialSM(pA0, pA1, C, 0.f, m_reg, alA);
        WAITV(0); ABAR(); RESC(alA); ROT3();
    }
    SBAR(); qkt<8, 4, ML_PRIO>(pB0, pB1, lds + sc, lds + sc + SHM_K + SHM_V, lds, qr, 0, ka, zero16);
    finishSM(pA0, pA1, alA, l_reg, pa0, pa1, pa2, pa3); SBAR();
    pv_d0<ML_PRIO>(o, vb0 + sp, pa0, pa1, pa2, pa3); partialSM(pB0, pB1, C, 0.f, m_reg, alB);
    RESC(alB);
    finishSM(pB0, pB1, alB, l_reg, pa0, pa1, pa2, pa3); SBAR();
    pv_d0<ML_PRIO>(o, vb0 + sc, pa0, pa1, pa2, pa3);
    if (hi == 0) li_l[r32] = l_reg; asm volatile("s_waitcnt lgkmcnt(0)" ::: "memory");
    float rli[16];
#pragma unroll
    for (int r = 0; r < 16; ++r) rli[r] = __builtin_amdgcn_rcpf(li_l[crow(r, hi)]);
    bf16* Ow = Ob + (long)(wid * QBLK) * DM;
#pragma unroll
    for (int r = 0; r < 16; ++r) { const int orow = crow(r, hi);
#pragma unroll
        for (int d0 = 0; d0 < 4; ++d0) Ow[(long)orow * DM + d0 * 32 + r32] = (bf16)f2bf(o[d0][r] * rli[r]); }
    ABAR();
#undef DMA
#undef ROT3
}

struct CvStream { bool on; const float* src; unsigned char* dst; unsigned sN4  , K2  , so_src, so_dst; };
constexpr int DF_SLOT = SHM_K + SHM_V, DF_NS = 4, DF_WS = DF_NS * DF_SLOT, DF_LUT = DF_WS + 8 * 64 * 4, DF_TK = DF_LUT + 512 * 4, DF_KPOS = DF_TK + 96 * 4, DF_LDS = DF_KPOS + SEQ * 4;
__device__ __forceinline__ void diff_unit(const bf16* __restrict__ Qb  , const bf16* __restrict__ Kh  ,
                                          const bf16* __restrict__ Vh  , const int* __restrict__ qposp  ,
                                          const int* __restrict__ kposp  , const int* __restrict__ tk  , const int* __restrict__ tkf  ,
                                          const float* __restrict__ relb_h  , const float* __restrict__ subln, float lam, bf16* __restrict__ Ob  , lptr lds, int tid, const CvStream cv) {
    constexpr float C = DIFF_SCALE * LOG2E;
    const int wid = __builtin_amdgcn_readfirstlane(tid >> 6), lane = tid & 63, r32 = lane & 31, hi = lane >> 5;
    const int comp = wid >> 2, wq = wid & 3;
    LAS float* ws = (LAS float*)(lds + DF_WS) + wid * 64; LAS float* li_l = ws; LAS float* al_l = ws + 32;
    LAS int* kpos_l = (LAS int*)(lds + DF_KPOS); LAS float* lut = (LAS float*)(lds + DF_LUT); LAS int* tkl = (LAS int*)(lds + DF_TK);
    const long ko0 = ksrc_off(2 * wid, lane, INWP), ko1 = ksrc_off(2 * wid + 1, lane, INWP), vo0 = vsrc_off(2 * wid, lane, INWP), vo1 = vsrc_off(2 * wid + 1, lane, INWP);
    lptr dK = lds + wid * 2048, dV = lds + SHM_K + wid * 2048;
#define DMA(t, so) do { const long kr_ = (long)(t) * KVBLK * INWP; const bf16* kp_ = Kh + kr_; const bf16* vp_ = Vh + kr_; \
    glds16(kp_ + ko0, dK + (so)); glds16(kp_ + ko1, dK + (so) + 1024); glds16(vp_ + vo0, dV + (so)); glds16(vp_ + vo1, dV + (so) + 1024); } while (0)
    DMA(0, 0); DMA(1, DF_SLOT);
    const bool cv_on = cv.on;
    const __amdgpu_buffer_rsrc_t cv_rs = __builtin_amdgcn_make_buffer_rsrc((void*)cv.src, 0, -1, 0x00020000), cv_rd = __builtin_amdgcn_make_buffer_rsrc((void*)cv.dst, 0, -1, 0x00020000);
    unsigned cv_ss = cv.so_src, cv_sd = cv.so_dst; const unsigned cv_n4 = cv.sN4; const int cv_vs = lane * 4, cv_vd = lane * (int)cv.K2;
    unsigned cv0 = 0, cv1 = 0, cv2 = 0, cv3 = 0, cvh0 = 0, cvh1 = 0;
#define CV_LOAD() do { if (cv_on) { cv0 = __builtin_amdgcn_raw_buffer_load_b32(cv_rs, cv_vs, cv_ss, 2); cv1 = __builtin_amdgcn_raw_buffer_load_b32(cv_rs, cv_vs, cv_ss + cv_n4, 2); \
      cv2 = __builtin_amdgcn_raw_buffer_load_b32(cv_rs, cv_vs, cv_ss + 2 * cv_n4, 2); cv3 = __builtin_amdgcn_raw_buffer_load_b32(cv_rs, cv_vs, cv_ss + 3 * cv_n4, 2); cv_ss += 4 * cv_n4; } } while (0)
#define CV_HOLD() do { if (cv_on) { cvh0 = pg8::cvt_pk_bf16(__builtin_bit_cast(float, cv0), __builtin_bit_cast(float, cv1)); cvh1 = pg8::cvt_pk_bf16(__builtin_bit_cast(float, cv2), __builtin_bit_cast(float, cv3)); } } while (0)
#define CV_STORE() do { if (cv_on) { u32x4 o_; o_.x = cvh0; o_.y = cvh1; o_.z = pg8::cvt_pk_bf16(__builtin_bit_cast(float, cv0), __builtin_bit_cast(float, cv1)); o_.w = pg8::cvt_pk_bf16(__builtin_bit_cast(float, cv2), __builtin_bit_cast(float, cv3)); \
      __builtin_amdgcn_raw_buffer_store_b128(o_, cv_rd, cv_vd, cv_sd, 0); cv_sd += 16; } } while (0)
    const int ld_ = tid - 256;
    const float lutv = relb_h[t5_bucket(ld_ < -128 ? -128 : (ld_ > 128 ? 128 : ld_)) * 8] * LOG2E;
    const int tkv = (tid >= 448) ? tk[tid - 448] : ((tid >= 416) ? tkf[tid - 416] : 0);
    const u32x4 kp4 = *(const u32x4*)(kposp + tid * 4);
    const int qp = qposp[wq * QBLK + r32];
    float m_reg = 0.f, l_reg = 0; f32x16 o[4] = {}; bf16x8 qr[4]; f32x16 negm = {}; float negv = 0.f;
    const bf16* Qw = Qb + (long)(wq * QBLK + r32) * INWP + comp * 64 + hi * 8;
#pragma unroll
    for (int d0 = 0; d0 < 4; ++d0) qr[d0] = ld8(Qw + d0 * 16);
    lut[tid] = lutv;
    if (tid >= 448) tkl[tid - 448] = tkv; else if (tid >= 416) tkl[64 + tid - 416] = tkv;
    *(LAS u32x4*)(kpos_l + tid * 4) = kp4;
    int qmn = qp, qmx = qp;
#pragma unroll
    for (int of = 1; of < 32; of <<= 1) { qmn = min(qmn, __shfl_xor(qmn, of)); qmx = max(qmx, __shfl_xor(qmx, of)); }
    qmn = __builtin_amdgcn_readfirstlane(qmn); qmx = __builtin_amdgcn_readfirstlane(qmx);
    const bool qnarrow = (qmx - qmn < 32);
#pragma unroll
    for (int d0 = 0; d0 < 4; ++d0) qr[d0] = scale_frag(qr[d0], C);
    const KAddr ka = make_kaddr(r32, hi);
    const int vb0 = (int)(unsigned)(uintptr_t)lds + SHM_K + v_rd_base(lane);
#define TILEBIAS(t, BL, NEAR) const int kmn_##BL = tkl[2 * (t)], kmx_##BL = tkl[2 * (t) + 1]; const bool fr_##BL = (kmn_##BL - qmx >= 91), fl_##BL = (kmx_##BL - qmn <= -91); \
    const bool NEAR = !(fr_##BL || fl_##BL); const float BL = fr_##BL ? blR : (fl_##BL ? blL : 0.f)
#define ADJ(P0, P1, t, NEAR) do { if (NEAR) { if (qnarrow && tkl[64 + (t)] != 0) lut_adjust_fast(P0, P1, lut, tkl[2 * (t)], qp, hi); else lut_adjust(P0, P1, lut, kpos_l + (t) * 64, qp, hi); } } while (0)
#define SLOT(t) (((t) & 3) * DF_SLOT)
#define ENDSTEP(t) do { if ((t) + 2 < NT) { if (cv_on) { if ((t) & 1) WAITV(8); else if ((t) == 0) WAITV(8); else WAITV(9); } else WAITV(4); } else WAITV(0); ABAR(); } while (0)
    f32x16 pA0, pA1, pB0, pB1; float alA, alB; bf16x8 pa0, pa1, pa2, pa3; constexpr int NT = SEQ / KVBLK;
    WAITV(0); ABAR();
    const float blR = lut[256 + 128], blL = lut[256 - 128];
    DMA(2, SLOT(2));
    { TILEBIAS(0, bl0, near0); SETNEG(bl0);
      qkt<4, 0, DF_PRIO>(pA0, pA1, lds + SLOT(0), lds, lds, qr, 4 * comp, ka, negm); ADJ(pA0, pA1, 0, near0); partialSMn<true, true>(pA0, pA1, m_reg, alA); }
    CV_LOAD(); ENDSTEP(0);
    for (int j = 1; j + 1 < NT; j += 2) {
        if (j + 2 < NT) DMA(j + 2, SLOT(j + 2));
        { TILEBIAS(j, blb, nearb); SETNEG(blb);
          SBAR(); qkt<4, 0, DF_PRIO>(pB0, pB1, lds + SLOT(j), lds, lds, qr, 4 * comp, ka, negm);
          finishSM<true>(pA0, pA1, alA, l_reg, pa0, pa1, pa2, pa3); SBAR();
          ADJ(pB0, pB1, j, nearb); SBAR();
          pv_d0<DF_PRIO>(o, vb0 + SLOT(j - 1), pa0, pa1, pa2, pa3); partialSMn<true, false>(pB0, pB1, m_reg, alB); }
        CV_HOLD(); CV_LOAD(); ENDSTEP(j); RESC(alB);
        if (j + 3 < NT) DMA(j + 3, SLOT(j + 3));
        { TILEBIAS(j + 1, bla, neara); SETNEG(bla);
          SBAR(); qkt<4, 0, DF_PRIO>(pA0, pA1, lds + SLOT(j + 1), lds, lds, qr, 4 * comp, ka, negm);
          finishSM<true>(pB0, pB1, alB, l_reg, pa0, pa1, pa2, pa3); SBAR();
          ADJ(pA0, pA1, j + 1, neara); SBAR();
          pv_d0<DF_PRIO>(o, vb0 + SLOT(j), pa0, pa1, pa2, pa3); partialSMn<true, false>(pA0, pA1, m_reg, alA); }
        CV_STORE(); CV_LOAD(); ENDSTEP(j + 1); RESC(alA);
    }
    CV_HOLD(); CV_LOAD();
    { TILEBIAS(NT - 1, blz, nearz); SETNEG(blz);
      SBAR(); qkt<4, 0, DF_PRIO>(pB0, pB1, lds + SLOT(NT - 1), lds, lds, qr, 4 * comp, ka, negm);
      finishSM<true>(pA0, pA1, alA, l_reg, pa0, pa1, pa2, pa3); SBAR();
      ADJ(pB0, pB1, NT - 1, nearz); SBAR();
      pv_d0<DF_PRIO>(o, vb0 + SLOT(NT - 2), pa0, pa1, pa2, pa3); partialSMn<true, false>(pB0, pB1, m_reg, alB); }
    RESC(alB);
    finishSM<true>(pB0, pB1, alB, l_reg, pa0, pa1, pa2, pa3); SBAR();
    pv_d0<DF_PRIO>(o, vb0 + SLOT(NT - 1), pa0, pa1, pa2, pa3);
    CV_STORE();
    if (hi == 0) li_l[r32] = l_reg; asm volatile("s_waitcnt lgkmcnt(0)" ::: "memory");
    float rli[16];
#pragma unroll
    for (int r = 0; r < 16; ++r) rli[r] = __builtin_amdgcn_rcpf(li_l[crow(r, hi)]);
    ABAR();
    LAS float* X = (LAS float*)lds + (wq * 32) * 128;
    if (comp == 1) {
#pragma unroll
        for (int r = 0; r < 16; ++r) { const int orow = crow(r, hi);
#pragma unroll
            for (int d0 = 0; d0 < 4; ++d0) X[orow * 128 + d0 * 32 + r32] = o[d0][r] * rli[r] * lam; }
    }
    ABAR();
    if (comp == 0) {
        bf16* Ow = Ob + (long)(wq * QBLK) * DM;
        float sl[4];
#pragma unroll
        for (int d0 = 0; d0 < 4; ++d0) sl[d0] = subln[d0 * 32 + r32] * (1.0f - LAMBDA_INIT);
#pragma unroll
        for (int r = 0; r < 16; ++r) { const int orow = crow(r, hi);
            float v[4]; float ss = 0.f;
#pragma unroll
            for (int d0 = 0; d0 < 4; ++d0) { v[d0] = o[d0][r] * rli[r] - X[orow * 128 + d0 * 32 + r32]; ss += v[d0] * v[d0]; }
#pragma unroll
            for (int of = 1; of < 32; of <<= 1) ss += __shfl_xor(ss, of);
            const float rstd = rsqrtf(ss * (1.0f / 128.0f) + EPS);
#pragma unroll
            for (int d0 = 0; d0 < 4; ++d0) Ow[(long)orow * DM + d0 * 32 + r32] = (bf16)f2bf(v[d0] * rstd * sl[d0]); }
    }
    ABAR();
#undef DMA
#undef TILEBIAS
#undef ADJ
#undef SETNEG
#undef SLOT
#undef ENDSTEP
#undef CV_LOAD
#undef CV_STORE
#undef CV_HOLD
#undef RESC
#undef WAITV
#undef ABAR
}
#undef KSWZ
#undef KRSWZ
#undef SBAR
}

__device__ __forceinline__ void attn_phase(unsigned char* ws, const int* pos, const float* rel_bias, const float* subln, float lam, LAS unsigned char* lds, int tid, int G, int bid,
                                           const float* wsrc_o, const float* wsrc_up, const float* wsrc_dn) {
    const bf16* PROJ = (const bf16*)(ws + WS_PROJ); const bf16* Qb = (const bf16*)(ws + WS_Q); const bf16* KVb = (const bf16*)(ws + WS_KV); bf16* AO = (bf16*)(ws + WS_AO);
    const int* TK = (const int*)(ws + WS_TK);
    const int vcu = (G % 8 == 0) ? (bid % 8) * (G / 8) + bid / 8 : bid;
    { constexpr int NU = BATCH * 8 * (SEQ / 256); const int per = (NU + G - 1) / G;
      for (int i = 0; i < per; ++i) { const int un = vcu * per + i; if (un >= NU) break;
        int tidu = tid; asm volatile("" : "+v"(tidu));
        const int qb = un & 7, h = (un >> 3) & 7, b = un >> 6;
        const size_t m0 = (size_t)b * SEQ + qb * 256;
        att::mla_unit(Qb + m0 * QW + h * 192, KVb + (size_t)b * SEQ * KVW + h * 256, PROJ + (size_t)b * SEQ * INWP + C_KROPE, AO + m0 * DM + h * 128, (att::lptr)lds, tidu); } }
    { constexpr int NU = BATCH * 8 * (SEQ / 128); const int per = (NU + G - 1) / G;
      att::CvStream cvb; cvb.on = false; cvb.src = nullptr; cvb.dst = nullptr; cvb.sN4 = 0; cvb.K2 = 0; cvb.so_src = 0; cvb.so_dst = 0;
      if (G == 256) { const int gw_ = __builtin_amdgcn_readfirstlane(tid >> 6) * G + vcu; int strip = 0, kq = 0, N_ = 0, K_ = 0;
        if (gw_ < 128) { strip = gw_ >> 2; kq = gw_ & 3; N_ = DM; K_ = DM; cvb.src = wsrc_o; cvb.dst = ws + WS_WO; cvb.on = true; }
        else if (gw_ < 832) { const int g_ = gw_ - 128; strip = g_ >> 2; kq = g_ & 3; N_ = FF2; K_ = DM; cvb.src = wsrc_up; cvb.dst = ws + WS_WUP; cvb.on = true; }
        else if (gw_ < 1184) { const int g_ = gw_ - 832; strip = g_ / 11; kq = g_ % 11; N_ = DM; K_ = FF; cvb.src = wsrc_dn; cvb.dst = ws + WS_WDN; cvb.on = true; }
        cvb.sN4 = (unsigned)N_ * 4u; cvb.K2 = (unsigned)K_ * 2u;
        cvb.so_src = ((unsigned)(512 * kq) * (unsigned)N_ + 64u * strip) * 4u; cvb.so_dst = ((unsigned)(64 * strip) * (unsigned)K_ + 512u * kq) * 2u; }
      for (int i = 0; i < per; ++i) { const int un = vcu * per + i; if (un >= NU) break;
        int tidu = tid; asm volatile("" : "+v"(tidu));
        const int qb = un & 15, h = (un >> 4) & 7, b = un >> 7;
        const size_t m0 = (size_t)b * SEQ + qb * 128;
        att::CvStream cv = cvb; cv.so_src += (unsigned)(128 * i) * cvb.sN4; cv.so_dst += (unsigned)(128 * i) * 2u;
        att::diff_unit(PROJ + m0 * INWP + C_DQ + h * 128, PROJ + (size_t)b * SEQ * INWP + C_DK + h * 128, PROJ + (size_t)b * SEQ * INWP + C_DV + h * 128,
                       pos + m0, pos + (size_t)b * SEQ, TK + b * 64, TK + TKF_OFF + b * 32, rel_bias + h, subln, lam, AO + m0 * DM + 1024 + h * 128, (att::lptr)lds, tidu, cv); } }
}

constexpr int NPH = 11;
struct Args { const void* in[25]; float* out; unsigned char* ws; int ph_lo, ph_hi; };
__global__ void __launch_bounds__(NTHREADS, 2) fwd(Args args) {
    extern __shared__ __attribute__((aligned(16))) unsigned char lds_raw[];
    LAS unsigned char* lds = (LAS unsigned char*)lds_raw;
    const int tid0 = threadIdx.x, G0 = gridDim.x;
    const int wave0 = __builtin_amdgcn_readfirstlane(tid0 >> 6);
    for (int u = tid0; u < (LDS_BYTES - LDSCTL_OFF) / 4; u += NTHREADS) ((LAS unsigned*)(lds + LDSCTL_OFF))[u] = 0u;
    __syncthreads();
    if (tid0 == 0) {
        LAS unsigned long long* pt = (LAS unsigned long long*)(lds + PTR_OFF);
#pragma unroll
        for (int i = 0; i < 25; ++i) pt[i] = (unsigned long long)args.in[i];
        pt[P_OUT] = (unsigned long long)args.out; pt[P_WS] = (unsigned long long)args.ws;
    }
    __syncthreads();
    volatile LAS unsigned* MISC = (volatile LAS unsigned*)(lds + MISC_OFF);
    const int ph_lo = args.ph_lo, ph_hi = args.ph_hi;
    XcdBarrier bar; bar.bar = nullptr; bar.x = 0; bar.st = nullptr;
    if (ph_hi - ph_lo > 1) bar = xcd_barrier_post((unsigned*)(LPWS() + WS_CTL) + CW_BAR, MISC + 8, tid0);

#define PH_BEGIN(k) if (ph_lo <= (k) && (k) < ph_hi) { int G = G0, bid = (int)blockIdx.x, wave = wave0; \
        int lane = (int)__builtin_amdgcn_mbcnt_hi(~0u, __builtin_amdgcn_mbcnt_lo(~0u, 0u)); \
        asm volatile("" : "+v"(lane)); asm volatile("" : "+s"(G)); asm volatile("" : "+s"(bid)); asm volatile("" : "+s"(wave)); \
        const int tid = wave * 64 + lane; (void)tid; (void)lane; (void)G; (void)bid; unsigned char* ws = LPWS(); (void)ws;
#define PH_END(k) if ((k) + 1 < ph_hi) xcd_barrier(bar, tid); }

    PH_BEGIN(0) p0_prologue(lds, tid, lane, wave, G, bid); PH_END(0)
    PH_BEGIN(1) prenorm_phase(LPF(P_X), LPF(P_APRE), (const float*)(ws + WS_MOD), MOD_SHA, MOD_SCA, (bf16*)(ws + WS_H), lane, wave, G, bid); PH_END(1)
    for (int q = 0; q < 3; ++q) {
        const int k = (q == 0) ? 2 : 3;
        PH_BEGIN(k)
            bf16* PROJ = (bf16*)(ws + WS_PROJ);
            pg8::Gemm g; pg8::EpiX E;
            E.qscale = 1.0f; E.ssq_q = (float*)(ws + WS_SSQQ); E.ssq_kv = (float*)(ws + WS_SSQKV); E.COS = (const float*)(ws + WS_COS); E.SIN = (const float*)(ws + WS_SIN);
            if (q == 0) { g = pg8::Gemm{(const bf16*)(ws + WS_H), (const bf16*)(ws + WS_WIN), M, INWP, DM, DM, DM, 128, 256, 0}; E.O = PROJ; E.ldc = INWP; E.mode = 0; }
            else if (q == 1) { g = pg8::Gemm{PROJ + C_QLAT, (const bf16*)(ws + WS_WUQ), M, QW, 512, INWP, 512, 128, 256, 0}; E.O = (bf16*)(ws + WS_Q); E.ldc = QW; E.mode = 1; }
            else { g = pg8::Gemm{PROJ + C_KVLAT, (const bf16*)(ws + WS_WUKV), M, KVW, 256, INWP, 256, 128, 256, 0}; E.O = (bf16*)(ws + WS_KV); E.ldc = KVW; E.mode = 2; }
            const int vcu = (G % 8 == 0) ? (bid % 8) * (G / 8) + bid / 8 : bid;
            pg8::ListOrder S;
            if (G == 256) {
                if (q == 0) S = pg8::ListOrder{4 * vcu, 4, INWP / 256};
                else if (q == 1) S = (vcu < 128) ? pg8::ListOrder{2 * vcu, 2, QW / 256} : pg8::ListOrder{256 + (vcu - 128), 1, QW / 256};
                else S = (vcu < 128) ? pg8::ListOrder{vcu, 1, KVW / 256} : pg8::ListOrder{128 + 3 * (vcu - 128), 3, KVW / 256};
            } else { const int nu = (g.M / 256) * (g.N / 256), per = (nu + G - 1) / G, b0 = vcu * per; S = pg8::ListOrder{b0, (b0 >= nu) ? 0 : ((nu - b0 < per) ? nu - b0 : per), g.N / 256}; }
            pg8::gemm_phase<pg8::EpiX, pg8::ListOrder, true, true>(lds, g, S, E, tid);
            if (q == 1) { }
            else
        PH_END(k)
        else { }
    }
    PH_BEGIN(4)
        const float s1 = wave_sum(LPF(P_LQ1)[lane] * LPF(P_LK1)[lane]), s2 = wave_sum(LPF(P_LQ2)[lane] * LPF(P_LK2)[lane]);
        const float lam = expf(s1) - expf(s2) + LAMBDA_INIT;
        attn_phase(ws, (const int*)ldptr(lds, P_POS), LPF(P_RELB), LPF(P_SUBLN), lam, lds, tid, G, bid, LPF(P_WO), LPF(P_WUP), LPF(P_WDN));
    PH_END(4)
    for (int q = 0; q < 2; ++q) {
        const int k = (q == 0) ? 5 : 9;
        PH_BEGIN(k)
            pg8::Gemm g; pg8::EpiBf16 E;
            if (q == 0) { g = pg8::Gemm{(const bf16*)(ws + WS_AO), (const bf16*)(ws + WS_WO), M, DM, DM, DM, DM, 128, 256, 0}; E = pg8::EpiBf16{(bf16*)(ws + WS_Y), DM}; }
            else { g = pg8::Gemm{(const bf16*)(ws + WS_G), (const bf16*)(ws + WS_WDN), M, DM, FF, FF, FF, 128, 256, 0}; E = pg8::EpiBf16{(bf16*)(ws + WS_Y2), DM}; }
            pg8::StaticOrder S; S.init(g.M, g.N, G, bid);
            pg8::gemm_phase<pg8::EpiBf16, pg8::StaticOrder, true, true>(lds, g, S, E, tid);
        PH_END(k)
        if (q == 0) {
            PH_BEGIN(6) post_phase<true>((const bf16*)(ws + WS_Y), LPF(P_X), (void*)(ws + WS_X1), LPF(P_APOST), (const float*)(ws + WS_MOD), MOD_GA, LPF(P_FPRE), MOD_SHF, MOD_SCF, (bf16*)(ws + WS_H), lane, wave, G, bid); PH_END(6)
            PH_BEGIN(7)
                pg8::Gemm g = pg8::Gemm{(const bf16*)(ws + WS_H), (const bf16*)(ws + WS_WUP), M, FF2, DM, DM, DM, FF, 128, 1};
                pg8::EpiConv E{(bf16*)(ws + WS_G), (bf16*)(ws + WS_E), LPF(P_CW), LPF(P_CB), FF, FF2};
                pg8::StaticOrder S; S.init(g.M, g.N, G, bid);
                pg8::gemm_phase<pg8::EpiConv, pg8::StaticOrder, true, true>(lds, g, S, E, tid);
            PH_END(7)
            PH_BEGIN(8) fixup_phase((const bf16*)(ws + WS_E), (bf16*)(ws + WS_G), LPF(P_CW), LPF(P_CB), tid, G, bid); PH_END(8)
        }
    }
    PH_BEGIN(10) float* outp = (float*)ldptr(lds, P_OUT);
        post_phase<false>((const bf16*)(ws + WS_Y2), (const void*)(ws + WS_X1), outp, LPF(P_FPOST), (const float*)(ws + WS_MOD), MOD_GF, nullptr, 0, 0, nullptr, lane, wave, G, bid); PH_END(10)
#undef PH_BEGIN
#undef PH_END
}

#ifndef MK_ONE_LAUNCH
#define MK_ONE_LAUNCH 1
#endif
extern "C" void kernel_launch(void* const* d_in, const int* in_sizes, int n_in, void* d_out, int out_size, void* d_ws, size_t ws_size, hipStream_t stream) {
    static int grid = 0;
    if (grid == 0) {
        if (n_in != 25 || in_sizes[0] != M * DM || out_size != M * DM || ws_size < WS_END) {
            fprintf(stderr, "kernel_launch: shape mismatch: n_in %d in0 %d out %d ws %zu (need >= %zu)\n", n_in, n_in > 0 ? in_sizes[0] : -1, out_size, ws_size, (size_t)WS_END); grid = -1; return; }
        int dev = 0, cus = 0;
        if (hipGetDevice(&dev) != hipSuccess || hipDeviceGetAttribute(&cus, hipDeviceAttributeMultiprocessorCount, dev) != hipSuccess) { grid = -1; return; }
        if (hipFuncSetAttribute((const void*)fwd, hipFuncAttributeMaxDynamicSharedMemorySize, LDS_BYTES) != hipSuccess) { fprintf(stderr, "kernel_launch: hipFuncSetAttribute failed\n"); grid = -1; return; }
        (void)hipGetLastError();
        grid = cus;
    }
    if (grid < 0) return;
    if (hipMemsetAsync((char*)d_ws + WS_CTL, 0, CTL_ZERO_BYTES, stream) != hipSuccess) { fprintf(stderr, "kernel_launch: memset failed\n"); return; }
    Args a{};
    for (int i = 0; i < 25; ++i) a.in[i] = d_in[i];
    a.out = (float*)d_out; a.ws = (unsigned char*)d_ws;
#if MK_ONE_LAUNCH
    a.ph_lo = 0; a.ph_hi = NPH;
    hipLaunchKernelGGL(fwd, dim3(grid), dim3(NTHREADS), LDS_BYTES, stream, a);
#else
    for (int p = 0; p < NPH; ++p) { a.ph_lo = p; a.ph_hi = p + 1; hipLaunchKernelGGL(fwd, dim3(grid), dim3(NTHREADS), LDS_BYTES, stream, a); }
#endif
    const hipError_t le = hipPeekAtLastError();
    if (le != hipSuccess) fprintf(stderr, "kernel_launch: launch failed: %s\n", hipGetErrorName(le));
}
```

```cpp
#include <hip/hip_runtime.h>
#include <cstdio>
#include <cstdint>
namespace pg8 {
#define PG8_LAS __attribute__((address_space(3)))
typedef unsigned short bf16_t;
typedef short bf16x8 __attribute__((ext_vector_type(8)));
typedef float f32x4 __attribute__((ext_vector_type(4)));
typedef unsigned u32x2 __attribute__((ext_vector_type(2)));
typedef unsigned u32x4 __attribute__((ext_vector_type(4)));
constexpr int BM = 256, BK = 64, HALF = 128, HTB = HALF * BK * 2  , STAGE_BYTES = 8 * HTB, NXCD = 8, WGM = 8;

__host__ __device__ __forceinline__ int lds_byte(int r, int c) { const int st = (r >> 4) * 2 + (c >> 5), rr = r & 15, cc = c & 31, ob = rr * 64 + cc * 2; return st * 1024 + (ob ^ (((ob >> 9) & 1) << 5)); }
__host__ __device__ __forceinline__ void stage_rc(int b, int& R, int& C) { const int st = b / 1024, sb = b % 1024, swz = sb ^ (((sb >> 9) & 1) << 5); R = (st >> 1) * 16 + swz / 64; C = (st & 1) * 32 + (swz % 64) / 2; }
__host__ __device__ __forceinline__ int perm32(int rho) { const int n = rho >> 4, i = rho & 15; return 8 * (i >> 2) + 4 * n + (i & 3); }

struct Unit { int pm, pn; };
struct Gemm { const bf16_t* A; const bf16_t* Bt; int M, N, K, lda, ldb, hsb, tsb, aperm; };

struct StaticOrder {
    int nM, nN, nwg, G, c;
    __host__ __device__ void init(int M, int N, int G_, int c_) { nM = M / BM; nN = N / BM; nwg = nM * nN; G = G_; c = c_; }
    __host__ __device__ bool next(int i, Unit& u) const {
        const long L = (long)i * G + c; if (L >= nwg) return false;
        int wgid = (int)L; { const int q = nwg / NXCD, r = nwg % NXCD, xcd = wgid % NXCD, off = wgid / NXCD; wgid = (xcd < r ? xcd * (q + 1) : r * (q + 1) + (xcd - r) * q) + off; }
        const int nig = WGM * nN, gid = wgid / nig, fm = gid * WGM, gsz = (nM - fm) < WGM ? (nM - fm) : WGM;
        u.pm = fm + ((wgid % nig) % gsz); u.pn = (wgid % nig) / gsz; return true;
    }
    __device__ __forceinline__ void a_ready(const Unit&) const {}
    __device__ __forceinline__ void done(const Unit&) const {}
};


struct ListOrder {
    int base, cnt, nN;
    __host__ __device__ bool next(int i, Unit& u) const { if (i >= cnt) return false; const int id = base + i; u.pm = id / nN; u.pn = id % nN; return true; }
    __device__ __forceinline__ void a_ready(const Unit&) const {}
    __device__ __forceinline__ void done(const Unit&) const {}
};

__device__ __forceinline__ unsigned cvt_pk_bf16(float lo, float hi) { unsigned r; asm volatile("v_cvt_pk_bf16_f32 %0, %1, %2" : "=v"(r) : "v"(lo), "v"(hi)); return r; }

struct EpiF32 {
    static constexpr bool PERM = false, AFTER_DRAIN = false;
    float* C; int ldc;
    __device__ __forceinline__ void operator()(const f32x4 (&acc)[2][2][4][2], const Unit& u, int wr, int wc, int fr, int fq) const {
        const int row0 = u.pm * BM + wr * 64 + fr, col0 = u.pn * BM + wc * 32 + 4 * fq;
#pragma unroll
        for (int ai = 0; ai < 2; ++ai)
#pragma unroll
            for (int m = 0; m < 4; ++m) { float* rowp = C + (size_t)(row0 + ai * HALF + m * 16) * ldc + col0;
#pragma unroll
                for (int bj = 0; bj < 2; ++bj)
#pragma unroll
                    for (int n = 0; n < 2; ++n) *(f32x4*)(rowp + bj * HALF + n * 16) = acc[ai][bj][m][n]; }
    }
};
struct EpiBf16 {
    static constexpr bool PERM = true, AFTER_DRAIN = false;
    bf16_t* O; int ldc;
    __device__ __forceinline__ void operator()(const f32x4 (&acc)[2][2][4][2], const Unit& u, int wr, int wc, int fr, int fq) const {
        const int row0 = u.pm * BM + wr * 64 + fr; const int col0 = u.pn * BM + wc * 32 + 8 * fq;
#pragma unroll
        for (int ai = 0; ai < 2; ++ai)
#pragma unroll
            for (int m = 0; m < 4; ++m) { bf16_t* rowp = O + (size_t)(row0 + ai * HALF + m * 16) * ldc + col0;
#pragma unroll
                for (int bj = 0; bj < 2; ++bj) { const f32x4 v0 = acc[ai][bj][m][0], v1 = acc[ai][bj][m][1];
                    u32x4 w; w.x = cvt_pk_bf16(v0[0], v0[1]); w.y = cvt_pk_bf16(v0[2], v0[3]); w.z = cvt_pk_bf16(v1[0], v1[1]); w.w = cvt_pk_bf16(v1[2], v1[3]);
                    *(u32x4*)(rowp + bj * HALF) = w; } }
    }
};

struct EpiX {
    static constexpr bool PERM = true, AFTER_DRAIN = false;
    bf16_t* O; int ldc; int mode; float* ssq_q; float* ssq_kv; const float* COS; const float* SIN; float qscale;
    __device__ __forceinline__ void operator()(const f32x4 (&acc)[2][2][4][2], const Unit& u, int wr, int wc, int fr, int fq) const {
        const int row0 = u.pm * BM + wr * 64 + fr; const int col0 = u.pn * BM + wc * 32 + 8 * fq;
        const bool do_ssq = (mode == 0) && (u.pn <= 2);
#pragma unroll
        for (int ai = 0; ai < 2; ++ai)
#pragma unroll
            for (int m = 0; m < 4; ++m) { const int row = row0 + ai * HALF + m * 16; bf16_t* rowp = O + (size_t)row * ldc + col0;
                float sc = 1.0f;
                if (mode == 1) sc = rsqrtf(ssq_q[row] * (1.0f / 512.0f) + 1e-6f) * qscale; else if (mode == 2) sc = rsqrtf(ssq_kv[row] * (1.0f / 256.0f) + 1e-6f);
                float ss = 0.f;
#pragma unroll
                for (int bj = 0; bj < 2; ++bj) { f32x4 v0 = acc[ai][bj][m][0] * sc, v1 = acc[ai][bj][m][1] * sc;
                    const int span = u.pn * BM + bj * HALF + wc * 32;
                    int roff = -1;
                    if (mode == 0) { if (span == 768 || span == 800) roff = span - 768; }
                    else if (mode == 1) { const int d = span % 192; if (d >= 128) roff = d - 128; }
                    if (roff >= 0) { const int ib = (roff >> 1) + 4 * fq;
                        const f32x4 cs = *(const f32x4*)(COS + (size_t)row * 32 + ib), sn = *(const f32x4*)(SIN + (size_t)row * 32 + ib);
                        f32x4 w0, w1;
                        w0[0] = v0[0] * cs[0] - v0[1] * sn[0]; w0[1] = v0[0] * sn[0] + v0[1] * cs[0]; w0[2] = v0[2] * cs[1] - v0[3] * sn[1]; w0[3] = v0[2] * sn[1] + v0[3] * cs[1];
                        w1[0] = v1[0] * cs[2] - v1[1] * sn[2]; w1[1] = v1[0] * sn[2] + v1[1] * cs[2]; w1[2] = v1[2] * cs[3] - v1[3] * sn[3]; w1[3] = v1[2] * sn[3] + v1[3] * cs[3];
                        v0 = w0; v1 = w1; }
                    if (do_ssq) ss += ((v0[0] * v0[0] + v0[1] * v0[1]) + (v0[2] * v0[2] + v0[3] * v0[3])) + ((v1[0] * v1[0] + v1[1] * v1[1]) + (v1[2] * v1[2] + v1[3] * v1[3]));
                    u32x4 w; w.x = cvt_pk_bf16(v0[0], v0[1]); w.y = cvt_pk_bf16(v0[2], v0[3]); w.z = cvt_pk_bf16(v1[0], v1[1]); w.w = cvt_pk_bf16(v1[2], v1[3]);
                    *(u32x4*)(rowp + bj * HALF) = w; }
                if (do_ssq) { ss += __shfl_xor(ss, 16); ss += __shfl_xor(ss, 32);
                    if (fq == 0) atomicAdd((u.pn < 2 ? ssq_q : ssq_kv) + row, ss); }
            }
    }
};

struct EpiConv {
    static constexpr bool PERM = true, AFTER_DRAIN = false;
    bf16_t* G; bf16_t* E; const float* cw; const float* cb; int ff, ff2;
    template <int CTRL> static __device__ __forceinline__ float dpp(float x) { return __builtin_bit_cast(float, __builtin_amdgcn_update_dpp(0, __builtin_bit_cast(int, x), CTRL, 0xf, 0xf, true)); }
    static __device__ __forceinline__ float gelu(float x) { const float t = x * x, u = __builtin_fmaf(t, -0.10294324f, -2.3022082f); return x * __builtin_amdgcn_rcpf(1.0f + __builtin_amdgcn_exp2f(x * u)); }
    __device__ __forceinline__ void operator()(const f32x4 (&acc)[2][2][4][2], const Unit& u, int wr, int wc, int fr, int fq) const {
        const int fl = wc * 32 + 8 * fq, f0 = u.pn * HALF + fl;
        constexpr int SHR1 = 0x111, SHL1 = 0x101;
#pragma unroll
        for (int n = 0; n < 2; ++n) {
            const int f = f0 + 4 * n;
            const f32x4 g0 = *(const f32x4*)(cw + f), g1 = *(const f32x4*)(cw + ff2 + f), g2 = *(const f32x4*)(cw + 2 * ff2 + f), gb = *(const f32x4*)(cb + f);
            const f32x4 v0 = *(const f32x4*)(cw + ff + f), v1 = *(const f32x4*)(cw + ff2 + ff + f), v2 = *(const f32x4*)(cw + 2 * ff2 + ff + f), vb = *(const f32x4*)(cb + ff + f);
#pragma unroll
            for (int ai = 0; ai < 2; ++ai) {
                const int grp = u.pm * 4 + ai * 2 + wr;
#pragma unroll
                for (int m = 0; m < 4; ++m) { const int row = u.pm * BM + ai * HALF + wr * 64 + 4 * fr + m;
                    const f32x4 a = acc[ai][0][m][n], b = acc[ai][1][m][n];
                    const f32x4 ap = acc[ai][0][m > 0 ? m - 1 : 3][n], bp = acc[ai][1][m > 0 ? m - 1 : 3][n];
                    const f32x4 an = acc[ai][0][m < 3 ? m + 1 : 0][n], bn = acc[ai][1][m < 3 ? m + 1 : 0][n];
                    float og[4];
#pragma unroll
                    for (int c = 0; c < 4; ++c) {
                        float ga = __builtin_fmaf(g1[c], a[c], gb[c]), va = __builtin_fmaf(v1[c], b[c], vb[c]);
                        ga = __builtin_fmaf(g0[c], m > 0 ? ap[c] : dpp<SHR1>(ap[c]), ga); va = __builtin_fmaf(v0[c], m > 0 ? bp[c] : dpp<SHR1>(bp[c]), va);
                        ga = __builtin_fmaf(g2[c], m < 3 ? an[c] : dpp<SHL1>(an[c]), ga); va = __builtin_fmaf(v2[c], m < 3 ? bn[c] : dpp<SHL1>(bn[c]), va);
                        og[c] = gelu(ga) * va; }
                    uint2 o2; o2.x = cvt_pk_bf16(og[0], og[1]); o2.y = cvt_pk_bf16(og[2], og[3]);
                    *(uint2*)(G + (size_t)row * ff + f) = o2;
                    if ((m < 2 && fr == 0) || (m >= 2 && fr == 15)) {
                        bf16_t* ep = E + ((size_t)(u.pn * 256 + grp) * 4 + m) * 256 + fl + 4 * n;
                        uint2 eg; eg.x = cvt_pk_bf16(a[0], a[1]); eg.y = cvt_pk_bf16(a[2], a[3]); uint2 ev; ev.x = cvt_pk_bf16(b[0], b[1]); ev.y = cvt_pk_bf16(b[2], b[3]);
                        *(uint2*)ep = eg; *(uint2*)(ep + HALF) = ev; }
                }
            }
        }
    }
};
template <class Epi, class Sched, bool ALIGN_EPI = false, bool SP2 = false>
__device__ __forceinline__ void gemm_phase(PG8_LAS unsigned char* lds, const Gemm g, const Sched& S, const Epi& E, const int tid) {
    const int  wid = __builtin_amdgcn_readfirstlane(tid >> 6), lane = tid & 63, wr = wid >> 2, wc = wid & 3, fr = lane & 15, fq = lane >> 4;
    const int K = g.K, nt = K / BK;
    unsigned voffA[2], voffB[2];
#pragma unroll
    for (int i = 0; i < 2; ++i) { int R, C; stage_rc(tid * 16 + i * 8192, R, C); const int Rb = Epi::PERM ? ((R & ~31) + perm32(R & 31)) : R;
        const int Ra = g.aperm ? ((R & ~63) + 4 * (R & 15) + ((R >> 4) & 3)) : R;
        voffA[i] = (unsigned)(Ra * g.lda + C) * 2u; voffB[i] = (unsigned)(Rb * g.ldb + C) * 2u; }
    const __amdgpu_buffer_rsrc_t srdA = __builtin_amdgcn_make_buffer_rsrc((void*)g.A, 0, -1, 0x00020000), srdB = __builtin_amdgcn_make_buffer_rsrc((void*)g.Bt, 0, -1, 0x00020000);
    const unsigned kstep = (unsigned)(BK * 2);
    const unsigned hsA = (unsigned)HALF * g.lda * 2, hsB = (unsigned)g.hsb * g.ldb * 2;
    const unsigned tsA = 2 * hsA, tsB = (unsigned)g.tsb * g.ldb * 2;
    const unsigned ldsw = (unsigned)wid * 1024u;
    const int aoff = lds_byte(wr * 64 + fr, fq * 8), boff = lds_byte(wc * 32 + fr, fq * 8);
#define PG8_SA(b, h) (((b) * 2 + (h)) * HTB)
#define PG8_SB(b, h) ((4 + (b) * 2 + (h)) * HTB)
#define PG8_SRD_voffA srdA
#define PG8_SRD_voffB srdB
#define PG8_STAGE(bufoff, soff, voff) do { _Pragma("unroll") for (int _i = 0; _i < 2; ++_i) \
        __builtin_amdgcn_raw_ptr_buffer_load_lds(PG8_SRD_##voff, (PG8_LAS void*)(lds + (bufoff) + ldsw + _i * 8192), 16, (voff)[_i], (soff), 0, 0); } while (0)
#define PG8_LDA(dst, b, h) do { _Pragma("unroll") for (int m = 0; m < 4; ++m) _Pragma("unroll") for (int k = 0; k < 2; ++k) dst[m][k] = *(const PG8_LAS bf16x8*)(lds + PG8_SA(b, h) + aoff + m * 2048 + k * 1024); } while (0)
#define PG8_LDB(dst, b, h) do { _Pragma("unroll") for (int n = 0; n < 2; ++n) _Pragma("unroll") for (int k = 0; k < 2; ++k) dst[n][k] = *(const PG8_LAS bf16x8*)(lds + PG8_SB(b, h) + boff + n * 2048 + k * 1024); } while (0)
#define PG8_MMA(ai, bj, At, Bt) do { __builtin_amdgcn_s_setprio(1); _Pragma("unroll") for (int m = 0; m < 4; ++m) _Pragma("unroll") for (int n = 0; n < 2; ++n) _Pragma("unroll") for (int k = 0; k < 2; ++k) \
        acc[ai][bj][m][n] = __builtin_amdgcn_mfma_f32_16x16x32_bf16(Bt[n][k], At[m][k], acc[ai][bj][m][n], 0, 0, 0); __builtin_amdgcn_s_setprio(0); } while (0)
#define PG8_WAIT_V(n) asm volatile("s_waitcnt vmcnt(" #n ")" ::: "memory")
#define PG8_WAIT_L(n) asm volatile("s_waitcnt lgkmcnt(" #n ")" ::: "memory")
#define PG8_BAR __builtin_amdgcn_s_barrier()
#define PG8_SCHED __builtin_amdgcn_sched_barrier(0)
    Unit cur, nxt; int ui = 0;
    if (!S.next(0, cur)) return;
    f32x4 acc[2][2][4][2];
#pragma unroll
    for (int a = 0; a < 2; ++a)
#pragma unroll
        for (int b = 0; b < 2; ++b)
#pragma unroll
            for (int m = 0; m < 4; ++m)
#pragma unroll
                for (int n = 0; n < 2; ++n) acc[a][b][m][n] = (f32x4){0.f, 0.f, 0.f, 0.f};
    bf16x8 At[4][2], B0[2][2], B1[2][2];
    unsigned cA = (unsigned)cur.pm * tsA, cB = (unsigned)cur.pn * tsB;
    S.a_ready(cur);
    if constexpr (SP2) {
        PG8_STAGE(PG8_SB(0, 0), cB, voffB); PG8_STAGE(PG8_SB(0, 1), cB + hsB, voffB); PG8_STAGE(PG8_SA(0, 0), cA, voffA); PG8_STAGE(PG8_SA(0, 1), cA + hsA, voffA);
        if (wr == 1) PG8_BAR;
        PG8_WAIT_V(2); PG8_BAR;
        PG8_STAGE(PG8_SB(1, 0), cB + kstep, voffB); PG8_STAGE(PG8_SA(1, 0), cA + kstep, voffA); PG8_STAGE(PG8_SB(1, 1), cB + hsB + kstep, voffB);
        PG8_WAIT_V(6); PG8_BAR;
    } else {
        PG8_STAGE(PG8_SB(0, 0), cB, voffB); PG8_STAGE(PG8_SA(0, 0), cA, voffA); PG8_STAGE(PG8_SB(0, 1), cB + hsB, voffB); PG8_STAGE(PG8_SA(0, 1), cA + hsA, voffA);
        if (wr == 1) PG8_BAR;
        PG8_WAIT_V(4); PG8_BAR;
        PG8_STAGE(PG8_SB(1, 0), cB + kstep, voffB); PG8_STAGE(PG8_SA(1, 0), cA + kstep, voffA); PG8_STAGE(PG8_SB(1, 1), cB + hsB + kstep, voffB);
        PG8_WAIT_V(6); PG8_BAR;
    }
    for (;;) {
        const bool has_next = S.next(ui + 1, nxt);
        const unsigned nA = has_next ? (unsigned)nxt.pm * tsA : cA, nB = has_next ? (unsigned)nxt.pn * tsB : cB;
        for (int t = 0; t < nt; t += 2) {
            const bool last = (t == nt - 2);
            const unsigned a1 = cA + (unsigned)(t + 1) * kstep;
            const unsigned a2 = last ? nA : cA + (unsigned)(t + 2) * kstep, b2 = last ? nB : cB + (unsigned)(t + 2) * kstep;
            const unsigned a3 = a2 + kstep, b3 = b2 + kstep;
            if (last && has_next) S.a_ready(nxt);
            if constexpr (SP2) {
            PG8_LDB(B0, 0, 0); PG8_LDB(B1, 0, 1); PG8_SCHED; PG8_LDA(At, 0, 0); PG8_STAGE(PG8_SA(1, 1), a1 + hsA, voffA);
            PG8_WAIT_V(8); PG8_WAIT_L(0); PG8_BAR; PG8_MMA(0, 0, At, B0); PG8_MMA(0, 1, At, B1); PG8_BAR; PG8_SCHED;
            PG8_LDA(At, 0, 1); PG8_STAGE(PG8_SB(0, 0), b2, voffB); PG8_STAGE(PG8_SB(0, 1), b2 + hsB, voffB); PG8_STAGE(PG8_SA(0, 0), a2, voffA);
            PG8_WAIT_V(8); PG8_WAIT_L(0); PG8_BAR; PG8_MMA(1, 0, At, B0); PG8_MMA(1, 1, At, B1); PG8_BAR; PG8_SCHED;
            PG8_LDB(B0, 1, 0); PG8_LDB(B1, 1, 1); PG8_SCHED; PG8_LDA(At, 1, 0); PG8_STAGE(PG8_SA(0, 1), a2 + hsA, voffA);
            PG8_WAIT_V(8); PG8_WAIT_L(0); PG8_BAR; PG8_MMA(0, 0, At, B0); PG8_MMA(0, 1, At, B1); PG8_BAR; PG8_SCHED;
            PG8_LDA(At, 1, 1); PG8_STAGE(PG8_SB(1, 0), b3, voffB); PG8_STAGE(PG8_SB(1, 1), b3 + hsB, voffB); PG8_STAGE(PG8_SA(1, 0), a3, voffA);
            PG8_WAIT_V(8); PG8_WAIT_L(0); PG8_BAR; PG8_MMA(1, 0, At, B0); PG8_MMA(1, 1, At, B1); PG8_BAR; PG8_SCHED;
            } else {
            PG8_LDB(B0, 0, 0); PG8_SCHED; PG8_LDA(At, 0, 0); PG8_STAGE(PG8_SA(1, 1), a1 + hsA, voffA);
            PG8_WAIT_L(8); PG8_BAR; PG8_WAIT_L(0); PG8_MMA(0, 0, At, B0); PG8_BAR; PG8_SCHED;
            PG8_LDB(B1, 0, 1); PG8_STAGE(PG8_SB(0, 0), b2, voffB);
            PG8_BAR; PG8_WAIT_L(0); PG8_MMA(0, 1, At, B1); PG8_BAR;
            PG8_LDA(At, 0, 1); PG8_STAGE(PG8_SA(0, 0), a2, voffA);
            PG8_BAR; PG8_WAIT_L(0); PG8_MMA(1, 0, At, B0); PG8_BAR; PG8_SCHED;
            PG8_STAGE(PG8_SB(0, 1), b2 + hsB, voffB);
            PG8_WAIT_V(6); PG8_BAR; PG8_MMA(1, 1, At, B1); PG8_BAR;
            PG8_LDB(B0, 1, 0); PG8_SCHED; PG8_LDA(At, 1, 0); PG8_STAGE(PG8_SA(0, 1), a2 + hsA, voffA);
            PG8_WAIT_L(8); PG8_BAR; PG8_WAIT_L(0); PG8_MMA(0, 0, At, B0); PG8_BAR; PG8_SCHED;
            PG8_LDB(B1, 1, 1); PG8_STAGE(PG8_SB(1, 0), b3, voffB);
            PG8_BAR; PG8_WAIT_L(0); PG8_MMA(0, 1, At, B1); PG8_BAR;
            PG8_LDA(At, 1, 1); PG8_STAGE(PG8_SA(1, 0), a3, voffA);
            PG8_BAR; PG8_WAIT_L(0); PG8_MMA(1, 0, At, B0); PG8_BAR; PG8_SCHED;
            PG8_STAGE(PG8_SB(1, 1), b3 + hsB, voffB);
            PG8_WAIT_V(6); PG8_BAR; PG8_MMA(1, 1, At, B1); PG8_BAR;
            }
        }
        if constexpr (ALIGN_EPI) { if (wr == 0) PG8_BAR; }
        if constexpr (!Epi::AFTER_DRAIN) { E(acc, cur, wr, wc, fr, fq); S.done(cur); }
        if (!has_next) break;
#pragma unroll
        for (int a = 0; a < 2; ++a)
#pragma unroll
            for (int b = 0; b < 2; ++b)
#pragma unroll
                for (int m = 0; m < 4; ++m)
#pragma unroll
                    for (int n = 0; n < 2; ++n) acc[a][b][m][n] = (f32x4){0.f, 0.f, 0.f, 0.f};
        cur = nxt; cA = nA; cB = nB; ++ui;
        if constexpr (ALIGN_EPI) { if (wr == 1) PG8_BAR; }
    }
    PG8_WAIT_V(0);
    if constexpr (!ALIGN_EPI) { if (wr == 0) PG8_BAR; }
    PG8_BAR;
    if constexpr (Epi::AFTER_DRAIN) { E.fused(acc, cur, wr, wc, fr, fq, lds, wid, lane); S.done(cur); }
#undef PG8_SA
#undef PG8_SB
#undef PG8_STAGE
#undef PG8_SRD_voffA
#undef PG8_SRD_voffB
#undef PG8_LDA
#undef PG8_LDB
#undef PG8_MMA
#undef PG8_WAIT_V
#undef PG8_WAIT_L
#undef PG8_BAR
#undef PG8_SCHED
}
}
#define GAS __attribute__((address_space(1)))
#define LAS __attribute__((address_space(3)))
typedef unsigned short bf16;
typedef unsigned v4u __attribute__((ext_vector_type(4)));
typedef float f32x4 __attribute__((ext_vector_type(4)));
typedef short bf16x8 __attribute__((ext_vector_type(8)));
typedef GAS unsigned gu32;
typedef GAS unsigned long long gu64;
#define RLX_AGENT __ATOMIC_RELAXED, __HIP_MEMORY_SCOPE_AGENT
#define LDS_WAIT() asm volatile("s_waitcnt lgkmcnt(0)" ::: "memory")
#define VM_WAIT() asm volatile("s_waitcnt vmcnt(0)" ::: "memory")
__device__ __forceinline__ unsigned long long rt() { return __builtin_amdgcn_s_memrealtime(); }
__device__ __forceinline__ unsigned f2bf(float f) { unsigned u = __builtin_bit_cast(unsigned, f); return (u + 0x7fffu + ((u >> 16) & 1u)) >> 16; }
__device__ __forceinline__ unsigned pk2(float lo, float hi) { return f2bf(lo) | (f2bf(hi) << 16); }

#define XB_TMO      128
#define XB_XCNT(j)  (256  + 64 * (j))
#define XB_XSUB(j)  (1280 + 64 * (j))
#define XB_XGEN(j)  (2304 + 64 * (j))
#define XB_TOP      3328
#define XB_TOPGEN   3392
#define XCD_BAR_WORDS 3456
#define XB_SPIN_CAP (1u << 18)

__device__ __forceinline__ unsigned xb_ld(unsigned* p)              { return __hip_atomic_load(p, __ATOMIC_RELAXED, __HIP_MEMORY_SCOPE_AGENT); }
__device__ __forceinline__ unsigned xb_add(unsigned* p, unsigned v) { return __hip_atomic_fetch_add(p, v, __ATOMIC_RELAXED, __HIP_MEMORY_SCOPE_AGENT); }
__device__ __forceinline__ unsigned xb_xcc_id() { return (unsigned)__builtin_amdgcn_s_getreg((3 << 11) | 20) & 0xFu; }
#define XB_SPIN(cond, bar) do { unsigned _sp = 0; while (cond) { __builtin_amdgcn_s_sleep(1); \
    if ((++_sp & 255u) == 0u) { if (xb_ld(&(bar)[XB_TMO])) break; if (_sp > XB_SPIN_CAP) { atomicAdd(&(bar)[XB_TMO], 1u); break; } } } } while (0)

struct XcdBarrier {
    unsigned* bar; unsigned x;
    volatile LAS unsigned* st;
};

__device__ __forceinline__ XcdBarrier xcd_barrier_post(unsigned* bar, volatile LAS unsigned* st, int tid) {
    XcdBarrier b; b.bar = bar; b.x = xb_xcc_id(); b.st = st;
    if (tid == 0) (void)xb_add(&bar[XB_XCNT(b.x)], 1u);
    return b;
}
__device__ __forceinline__ void xcd_barrier_complete(unsigned* bar, unsigned x, unsigned& nloc, unsigned& nx) {
    const unsigned G = gridDim.x * gridDim.y * gridDim.z;
    unsigned sum, cnt, mine, sp = 0u;
    for (;;) {
        sum = 0u; cnt = 0u; mine = 0u;
#pragma unroll
        for (unsigned j = 0; j < 16; ++j) { const unsigned c = xb_ld(&bar[XB_XCNT(j)]); sum += c; cnt += (c > 0u) ? 1u : 0u; mine = (j == x) ? c : mine; }
        if (sum == G) break;
        __builtin_amdgcn_s_sleep(1);
        if ((++sp & 255u) == 0u) { if (xb_ld(&bar[XB_TMO])) break; if (sp > XB_SPIN_CAP) { atomicAdd(&bar[XB_TMO], 1u); break; } }
    }
    nloc = mine > 0u ? mine : 1u; nx = cnt > 0u ? cnt : 1u;
}

__device__ __forceinline__ void xcd_barrier(const XcdBarrier& b, int tid) {
    asm volatile("s_waitcnt vmcnt(0)" ::: "memory");
    __syncthreads();
    if (tid == 0) {
        unsigned* bar = b.bar;
        __builtin_amdgcn_s_waitcnt(0);
        unsigned nloc = b.st[0], nx = b.st[1];
        if (nloc == 0u) { xcd_barrier_complete(bar, b.x, nloc, nx); b.st[0] = nloc; b.st[1] = nx; }
        const unsigned old = xb_add(&bar[XB_XSUB(b.x)], 1u);
        const unsigned gen = old / nloc;
        if (old + 1u == (gen + 1u) * nloc) {
            __builtin_amdgcn_fence(__ATOMIC_RELEASE, "agent");
            asm volatile("s_waitcnt vmcnt(0)" ::: "memory");
            const unsigned og = xb_add(&bar[XB_TOP], 1u);
            const unsigned tg = og / nx;
            if (og + 1u == (tg + 1u) * nx) xb_add(&bar[XB_TOPGEN], 1u);
            else XB_SPIN(xb_ld(&bar[XB_TOPGEN]) == tg, bar);
            __builtin_amdgcn_fence(__ATOMIC_ACQUIRE, "agent");
            xb_add(&bar[XB_XGEN(b.x)], 1u);
            asm volatile("s_waitcnt vmcnt(0)" ::: "memory");
        } else {
            XB_SPIN(xb_ld(&bar[XB_XGEN(b.x)]) == gen, bar);
            __builtin_amdgcn_fence(__ATOMIC_ACQUIRE, "agent");
            asm volatile("s_waitcnt vmcnt(0)" ::: "memory");
        }
    }
    __syncthreads();
}

constexpr int NWAVES = 8, NTHREADS = 512;
constexpr int BATCH = 8, SEQ = 2048, DM = 2048, M = BATCH * SEQ;
constexpr int INW = 3904, INWP = 4096;
constexpr int QW = 1536, KVW = 2048, FF = 5632, FF2 = 11264, NMOD = 12288;
constexpr int C_QLAT = 0, C_KVLAT = 512, C_KROPE = 768, C_DQ = 832, C_DK = 1856, C_DV = 2880;
constexpr int MOD_SHA = 0, MOD_SCA = 2048, MOD_GA = 4096, MOD_SHF = 6144, MOD_SCF = 8192, MOD_GF = 10240;
constexpr float EPS = 1e-6f, MLA_SCALE = 0.07216878364870322f, DIFF_SCALE = 0.125f, LAMBDA_INIT = 0.2f;
constexpr int UCH = 4096, NUCH = M / UCH;

constexpr size_t MiB = 1u << 20;
constexpr size_t WS_CTL = 0, CTL_ZERO_BYTES = 1 * MiB, WS_MOD = 512 * 1024, WS_SSQQ = 128 * 1024, WS_SSQKV = 192 * 1024;
constexpr int TKF_OFF = 1024;
constexpr size_t WS_COS = 2 * MiB, WS_SIN = 4 * MiB, WS_TK = 6 * MiB;
constexpr size_t WS_WIN = 8 * MiB, WS_WUQ = 24 * MiB, WS_WUKV = 26 * MiB, WS_WO = 28 * MiB, WS_WUP = 36 * MiB, WS_WDN = 80 * MiB;
constexpr size_t WS_H = 104 * MiB;
constexpr size_t WS_PROJ = 168 * MiB, WS_Q = 296 * MiB, WS_KV = 344 * MiB, WS_AO = 408 * MiB;
constexpr size_t WS_Y = 168 * MiB;
constexpr size_t WS_G = 168 * MiB;
constexpr size_t WS_E = 344 * MiB;
constexpr size_t WS_Y2 = 344 * MiB;
constexpr size_t WS_X1 = 408 * MiB;
constexpr size_t WS_END = 512 * MiB;
constexpr int CW_TMO = 0, CW_CODE = 1, CW_BAR = 4096;

constexpr int LDS_BYTES = 147456;
constexpr int LDSCTL_OFF = LDS_BYTES - 512, MISC_OFF = LDSCTL_OFF;

__device__ __forceinline__ float bf2f(unsigned short u) { return __uint_as_float((unsigned)u << 16); }
__device__ __forceinline__ float bflo(unsigned w) { return __uint_as_float(w << 16); }
__device__ __forceinline__ float bfhi(unsigned w) { return __uint_as_float(w & 0xffff0000u); }
__device__ __forceinline__ float wave_sum(float v) {
#pragma unroll
    for (int o = 1; o < 64; o <<= 1) v += __shfl_xor(v, o);
    return v;
}
__device__ __forceinline__ float wave_max(float v) {
#pragma unroll
    for (int o = 1; o < 64; o <<= 1) v = fmaxf(v, __shfl_xor(v, o));
    return v;
}
__device__ __forceinline__ int t5_bucket(int rel) {
    const int ret = rel > 0 ? 16 : 0; const int n = rel < 0 ? -rel : rel; const float nf = (float)(n > 1 ? n : 1);
    int large = 8 + (int)(logf(nf / 8.0f) / 2.772588722239781f * 8.0f);
    large = large < 15 ? large : 15;
    return ret + (n < 8 ? n : large);
}
__device__ __forceinline__ float gelu_tanh(float x) {
    const float z2 = 1.5957691216057308f * (x + 0.044715f * x * x * x);
    return x / (1.0f + __expf(-z2));
}


constexpr int PTR_OFF = LDSCTL_OFF + 128;
enum { P_X = 0, P_C, P_POS, P_RELB, P_ADAW, P_ADAB, P_APRE, P_APOST, P_WIN, P_QN, P_WUQ, P_KVN, P_WUKV, P_LQ1, P_LK1, P_LQ2, P_LK2, P_SUBLN, P_WO, P_FPRE, P_FPOST, P_WUP, P_CW, P_CB, P_WDN, P_OUT, P_WS };
__device__ __forceinline__ const void* ldptr(LAS unsigned char* lds, int i) {
    const unsigned long long v = *(volatile LAS unsigned long long*)(lds + PTR_OFF + 8 * i);
    const unsigned lo = __builtin_amdgcn_readfirstlane((unsigned)v), hi = __builtin_amdgcn_readfirstlane((unsigned)(v >> 32));
    return (const void*)(GAS const void*)(((unsigned long long)hi << 32) | lo);
}
#define LPF(i) ((const float*)ldptr(lds, (i)))
#define LPWS() ((unsigned char*)ldptr(lds, P_WS))

__device__ __forceinline__ int dst_row(int s, int map) {
    if (map == 1) { if (s >= C_KROPE && s < C_KROPE + 64) { const int d = s - C_KROPE; return C_KROPE + 2 * (d & 31) + (d >> 5); } return s; }
    if (map == 2) { const int h = s / 192, d = s % 192; if (d >= 128) return h * 192 + 128 + 2 * ((d - 128) & 31) + ((d - 128) >> 5); return s; }
    return s;
}
__device__ __forceinline__ void p0_transpose_item(const float* W, const float* sv, int K, int N, bf16* WT, LAS float* scr, int item, int lane, int map) {
    const int nblk = N / 64, kb = item / nblk, nb = item % nblk, k0 = 64 * kb, n0 = 64 * nb;
    const int lr = lane >> 4, lc = (lane & 15) * 4;
    f32x4 v[16];
#pragma unroll
    for (int i = 0; i < 16; ++i) v[i] = __builtin_nontemporal_load((const f32x4*)(W + (size_t)(k0 + 4 * i + lr) * N + n0 + lc));
#pragma unroll
    for (int i = 0; i < 16; ++i) { const int kk = 4 * i + lr; f32x4 w = v[i]; if (sv) w = w * sv[k0 + kk];
        LAS float* d = scr + kk * 65 + lc; d[0] = w[0]; d[1] = w[1]; d[2] = w[2]; d[3] = w[3]; }
    LDS_WAIT(); asm volatile("" ::: "memory");
    const int c = lane & 7;
#pragma unroll
    for (int j = 0; j < 8; ++j) { const int n = (lane >> 3) + 8 * j; const LAS float* s = scr + (8 * c) * 65 + n;
        v4u o; o.x = pk2(s[0 * 65], s[1 * 65]); o.y = pk2(s[2 * 65], s[3 * 65]); o.z = pk2(s[4 * 65], s[5 * 65]); o.w = pk2(s[6 * 65], s[7 * 65]);
        __builtin_nontemporal_store(o, (GAS v4u*)(WT + (size_t)dst_row(n0 + n, map) * K + k0 + 8 * c)); }
    LDS_WAIT(); asm volatile("" ::: "memory");
}
__device__ __forceinline__ void p0_prologue(LAS unsigned char* lds, int tid, int lane, int wave, int G, int bid) {
    { unsigned char* ws = LPWS(); float* mod = (float*)(ws + WS_MOD); const float* in_c = LPF(P_C); const float* in_adaw = LPF(P_ADAW); const float* in_adab = LPF(P_ADAB);
    for (int item = bid; item < 256; item += G) {
        const int kc = item >> 5, cc = item & 31;
        LAS float* scl = (LAS float*)lds;
        LAS float* red = (LAS float*)(lds + 8192);
        for (int e = tid; e < 2048; e += NTHREADS) { const int b = e >> 8, i = e & 255; const float cv = in_c[b * DM + 256 * kc + i]; scl[e] = cv / (1.0f + __expf(-cv)); }
        __syncthreads();
        if (tid < 384) {
            const int kg = tid / 96, ct = tid % 96;
            f32x4 acc[8];
#pragma unroll
            for (int b = 0; b < 8; ++b) acc[b] = (f32x4){0.f, 0.f, 0.f, 0.f};
            const float* wp = in_adaw + (size_t)(256 * kc + 64 * kg) * NMOD + 384 * cc + 4 * ct;
#pragma unroll 8
            for (int kk = 0; kk < 64; ++kk) {
                const f32x4 w = __builtin_nontemporal_load((const f32x4*)(wp + (size_t)kk * NMOD));
#pragma unroll
                for (int b = 0; b < 8; ++b) acc[b] += w * scl[b * 256 + 64 * kg + kk];
            }
#pragma unroll
            for (int b = 0; b < 8; ++b) *(LAS f32x4*)(red + (kg * 8 + b) * 384 + 4 * ct) = acc[b];
        }
        __syncthreads();
        for (int o = tid; o < 3072; o += NTHREADS) { const int b = o / 384, col = o % 384;
            float v = (red[(0 * 8 + b) * 384 + col] + red[(1 * 8 + b) * 384 + col]) + (red[(2 * 8 + b) * 384 + col] + red[(3 * 8 + b) * 384 + col]);
            if (kc == 0) v += in_adab[384 * cc + col];
            atomicAdd(mod + b * NMOD + 384 * cc + col, v); }
        __syncthreads();
    } }
    unsigned char* ws = LPWS();
    LAS float* scr = (LAS float*)(lds + wave * 16640);
    const int gw = bid * NWAVES + wave, NGW = G * NWAVES;
    constexpr int I_IN = (DM / 64) * (INW / 64), I_UQ = (512 / 64) * (QW / 64), I_UKV = (256 / 64) * (KVW / 64), I_O = (DM / 64) * (DM / 64), I_UP = (DM / 64) * (FF2 / 64), I_DN = (FF / 64) * (DM / 64);
    const int NITEMS = (G == 256) ? I_IN + I_UQ + I_UKV : I_IN + I_UQ + I_UKV + I_O + I_UP + I_DN;
    for (int it = gw; it < NITEMS; it += NGW) {
        int r = it;
        if (r < I_IN) { p0_transpose_item(LPF(P_WIN), nullptr, DM, INW, (bf16*)(ws + WS_WIN), scr, r, lane, 1); continue; } r -= I_IN;
        if (r < I_UQ) { p0_transpose_item(LPF(P_WUQ), LPF(P_QN), 512, QW, (bf16*)(ws + WS_WUQ), scr, r, lane, 2); continue; } r -= I_UQ;
        if (r < I_UKV) { p0_transpose_item(LPF(P_WUKV), LPF(P_KVN), 256, KVW, (bf16*)(ws + WS_WUKV), scr, r, lane, 0); continue; } r -= I_UKV;
        if (r < I_O) { p0_transpose_item(LPF(P_WO), nullptr, DM, DM, (bf16*)(ws + WS_WO), scr, r, lane, 0); continue; } r -= I_O;
        if (r < I_UP) { p0_transpose_item(LPF(P_WUP), nullptr, DM, FF2, (bf16*)(ws + WS_WUP), scr, r, lane, 0); continue; } r -= I_UP;
        p0_transpose_item(LPF(P_WDN), nullptr, FF, DM, (bf16*)(ws + WS_WDN), scr, r, lane, 0);
    }
    { v4u* z = (v4u*)(ws + WS_WIN + (size_t)INW * DM * 2); const v4u zero = {0u, 0u, 0u, 0u};
      for (int i = bid * NTHREADS + tid; i < (INWP - INW) * DM * 2 / 16; i += G * NTHREADS) z[i] = zero; }
    { float* COS = (float*)(ws + WS_COS); float* SIN = (float*)(ws + WS_SIN); const int* in_pos = (const int*)ldptr(lds, P_POS);
      for (int idx = bid * NTHREADS + tid; idx < M * 32; idx += G * NTHREADS) {
          const int m = idx >> 5, i = idx & 31;
          const float inv = 1.0f / exp2f((float)i * (13.287712379549449f / 32.0f));
          const float ang = (float)in_pos[m] * inv;
          double t = (double)ang * 0.15915494309189535; t -= rint(t);
          const float tf = (float)t;
          COS[idx] = __builtin_amdgcn_cosf(tf); SIN[idx] = __builtin_amdgcn_sinf(tf); } }
    { int* TK = (int*)(ws + WS_TK); const int* in_pos = (const int*)ldptr(lds, P_POS);
      for (int it = gw; it < BATCH * (SEQ / 64); it += NGW) { const int p = in_pos[it * 64 + lane]; int mn = p, mx = p;
#pragma unroll
          for (int of = 1; of < 64; of <<= 1) { mn = min(mn, __shfl_xor(mn, of)); mx = max(mx, __shfl_xor(mx, of)); }
          const bool cont = __all(p - lane == __builtin_amdgcn_readfirstlane(p));
          if (lane == 0) { TK[2 * it] = mn; TK[2 * it + 1] = mx; TK[TKF_OFF + it] = cont ? 1 : 0; } } }
}

__device__ __forceinline__ void prenorm_phase(const float* x, const float* wn, const float* mod, int off_sh, int off_sc, bf16* H, int lane, int wave, int G, int bid) {
    const int gw = bid * NWAVES + wave, NGW = G * NWAVES;
    for (int m = gw; m < M; m += NGW) {
        const f32x4* xr = (const f32x4*)(x + (size_t)m * DM) + lane;
        f32x4 v[8]; float ss = 0.f;
#pragma unroll
        for (int j = 0; j < 8; ++j) { v[j] = __builtin_nontemporal_load(xr + 64 * j); ss += (v[j].x * v[j].x + v[j].y * v[j].y) + (v[j].z * v[j].z + v[j].w * v[j].w); }
        const float rstd = rsqrtf(wave_sum(ss) * (1.0f / DM) + EPS);
        const float* mb = mod + (size_t)(m >> 11) * NMOD;
#pragma unroll
        for (int j = 0; j < 8; ++j) { const int col = (lane + 64 * j) * 4;
            const f32x4 w = *(const f32x4*)(wn + col), sh = *(const f32x4*)(mb + off_sh + col), sc = *(const f32x4*)(mb + off_sc + col);
            const f32x4 o = v[j] * rstd * w * (sc + 1.0f) + sh;
            uint2 pk; pk.x = pk2(o.x, o.y); pk.y = pk2(o.z, o.w);
            *(uint2*)(H + (size_t)m * DM + col) = pk; }
    }
}
template <bool NEXT>
__device__ __forceinline__ void post_phase(const bf16* Y, const void* xin_, void* xout_, const float* wpost, const float* mod, int off_g,
                                           const float* wn2, int off_sh, int off_sc, bf16* Hn, int lane, int wave, int G, int bid) {
    const int gw = bid * NWAVES + wave, NGW = G * NWAVES;
    for (int m = gw; m < M; m += NGW) {
        const uint2* yr = (const uint2*)(Y + (size_t)m * DM) + lane;
        const f32x4* xr = (const f32x4*)((const float*)xin_ + (size_t)m * DM) + lane;
        const uint2* xb = (const uint2*)((const bf16*)xin_ + (size_t)m * DM) + lane;
        f32x4 v[8]; float ss = 0.f;
#pragma unroll
        for (int j = 0; j < 8; ++j) { const unsigned long long yq_ = __builtin_nontemporal_load((const unsigned long long*)(yr + 64 * j)); uint2 yw; yw.x = (unsigned)yq_; yw.y = (unsigned)(yq_ >> 32); v[j] = (f32x4){bflo(yw.x), bfhi(yw.x), bflo(yw.y), bfhi(yw.y)}; ss += (v[j].x * v[j].x + v[j].y * v[j].y) + (v[j].z * v[j].z + v[j].w * v[j].w); }
        const float rstd = rsqrtf(wave_sum(ss) * (1.0f / DM) + EPS);
        const float* mb = mod + (size_t)(m >> 11) * NMOD;
        float ss2 = 0.f;
#pragma unroll
        for (int j = 0; j < 8; ++j) { const int col = (lane + 64 * j) * 4;
            const f32x4 w = *(const f32x4*)(wpost + col), g = *(const f32x4*)(mb + off_g + col);
            f32x4 xv;
            if constexpr (NEXT) xv = __builtin_nontemporal_load(xr + 64 * j);
            else { const unsigned long long xq_ = __builtin_nontemporal_load((const unsigned long long*)(xb + 64 * j)); const unsigned x0 = (unsigned)xq_, x1 = (unsigned)(xq_ >> 32); xv = (f32x4){bflo(x0), bfhi(x0), bflo(x1), bfhi(x1)}; }
            const f32x4 o = xv + g * (v[j] * rstd * w);
            v[j] = o; ss2 += (o.x * o.x + o.y * o.y) + (o.z * o.z + o.w * o.w);
            if constexpr (NEXT) { uint2 pk; pk.x = pk2(o.x, o.y); pk.y = pk2(o.z, o.w); *(uint2*)((bf16*)xout_ + (size_t)m * DM + col) = pk; }
            else *(f32x4*)((float*)xout_ + (size_t)m * DM + col) = o; }
        if (NEXT) {
            const float rstd2 = rsqrtf(wave_sum(ss2) * (1.0f / DM) + EPS);
#pragma unroll
            for (int j = 0; j < 8; ++j) { const int col = (lane + 64 * j) * 4;
                const f32x4 w = *(const f32x4*)(wn2 + col), sh = *(const f32x4*)(mb + off_sh + col), sc = *(const f32x4*)(mb + off_sc + col);
                const f32x4 o = v[j] * rstd2 * w * (sc + 1.0f) + sh;
                uint2 pk; pk.x = pk2(o.x, o.y); pk.y = pk2(o.z, o.w);
                *(uint2*)(Hn + (size_t)m * DM + col) = pk; }
        }
    }
}
__device__ __forceinline__ void fixup_phase(const bf16* E, bf16* Gb, const float* cw, const float* cb, int tid, int G, int bid) {
    constexpr int NPN = FF / 128;
    for (int idx = bid * NTHREADS + tid; idx < 256 * NPN * 16; idx += G * NTHREADS) {
        const int g = idx / (NPN * 16), rem = idx % (NPN * 16), pn = rem >> 4, fl = (rem & 15) * 8;
        if ((g & 31) == 0) continue;
        const bf16* ea = E + ((size_t)(pn * 256 + g - 1) * 4 + 2) * 256 + fl; const bf16* ec = E + ((size_t)(pn * 256 + g) * 4) * 256 + fl;
        const v4u ga = *(const v4u*)ea, gbv = *(const v4u*)(ea + 256), gc = *(const v4u*)ec, gd = *(const v4u*)(ec + 256);
        const v4u va = *(const v4u*)(ea + 128), vbv = *(const v4u*)(ea + 256 + 128), vc = *(const v4u*)(ec + 128), vd = *(const v4u*)(ec + 256 + 128);
        unsigned o0[4], o1[4];
#pragma unroll
        for (int q = 0; q < 4; ++q) {
            float r0[2], r1[2];
#pragma unroll
            for (int hh = 0; hh < 2; ++hh) { const int f = pn * 128 + fl + 2 * q + hh;
                const float a = hh ? bfhi(ga[q]) : bflo(ga[q]), b = hh ? bfhi(gbv[q]) : bflo(gbv[q]), c = hh ? bfhi(gc[q]) : bflo(gc[q]), d = hh ? bfhi(gd[q]) : bflo(gd[q]);
                const float xa = hh ? bfhi(va[q]) : bflo(va[q]), xb = hh ? bfhi(vbv[q]) : bflo(vbv[q]), xc = hh ? bfhi(vc[q]) : bflo(vc[q]), xd = hh ? bfhi(vd[q]) : bflo(vd[q]);
                const float w0 = cw[f], w1 = cw[FF2 + f], w2 = cw[2 * FF2 + f], wb = cb[f], y0 = cw[FF + f], y1 = cw[FF2 + FF + f], y2 = cw[2 * FF2 + FF + f], yb = cb[FF + f];
                r0[hh] = gelu_tanh(wb + w0 * a + w1 * b + w2 * c) * (yb + y0 * xa + y1 * xb + y2 * xc);
                r1[hh] = gelu_tanh(wb + w0 * b + w1 * c + w2 * d) * (yb + y0 * xb + y1 * xc + y2 * xd); }
            o0[q] = pk2(r0[0], r0[1]); o1[q] = pk2(r1[0], r1[1]); }
        const v4u w0 = {o0[0], o0[1], o0[2], o0[3]}, w1 = {o1[0], o1[1], o1[2], o1[3]};
        *(v4u*)(Gb + (size_t)(64 * g - 1) * FF + pn * 128 + fl) = w0; *(v4u*)(Gb + (size_t)(64 * g) * FF + pn * 128 + fl) = w1;
    }
}


namespace att {
typedef short bf16x8 __attribute__((ext_vector_type(8)));
typedef short s16x4 __attribute__((ext_vector_type(4)));
typedef float f32x16 __attribute__((ext_vector_type(16)));
typedef unsigned u32x4 __attribute__((ext_vector_type(4)));
typedef LAS char* lptr;
#define KSWZ(row, colB) ((row) * 256 + ((colB) ^ (((row) & 7) << 4)))
#define KRSWZ(row, colB) ((row) * 128 + ((colB) ^ ((((row) >> 1) & 7) << 4)))
#define SBAR() __builtin_amdgcn_sched_barrier(0)
constexpr int QBLK = 32, KVBLK = 64, SHM_V = KVBLK * 128 * 2, SHM_K = KVBLK * 128 * 2, SHM_KR = KVBLK * 64 * 2;
constexpr float LOG2E = 1.4426950408889634f;
constexpr float THRL = 8.0f * LOG2E;
__device__ __forceinline__ int crow(int r, int hi) { return (r & 3) + 8 * (r >> 2) + 4 * hi; }
__device__ __forceinline__ unsigned cvtpk(float lo, float hi) { unsigned r; asm volatile("v_cvt_pk_bf16_f32 %0, %1, %2" : "=v"(r) : "v"(lo), "v"(hi)); return r; }
__device__ __forceinline__ bf16x8 ld8(const bf16* p) { return *reinterpret_cast<const bf16x8*>(p); }

template <bool EXPALL = false>
__device__ __forceinline__ void partialSM(f32x16& p0, f32x16& p1, float C, float bl, float& m_reg, float& alpha) {
    float pmax = p0[0];
#pragma unroll
    for (int r = 1; r < 16; ++r) pmax = fmaxf(pmax, p0[r]);
#pragma unroll
    for (int r = 0; r < 16; ++r) pmax = fmaxf(pmax, p1[r]);
    { auto rr = __builtin_amdgcn_permlane32_swap(__float_as_uint(pmax), __float_as_uint(pmax), false, false);
      pmax = fmaxf(__uint_as_float(rr[0]), __uint_as_float(rr[1])); }
    const float tmax = fmaf(pmax, C, bl);
    float mn;
    if (__builtin_expect(__all(tmax - m_reg <= THRL), 1)) { mn = m_reg; alpha = 1.f; }
    else { mn = fmaxf(m_reg, tmax); alpha = __builtin_amdgcn_exp2f(m_reg - mn); m_reg = mn; }
    const float off = bl - mn;
#pragma unroll
    for (int r = 0; r < 16; ++r) p0[r] = fmaf(p0[r], C, off);
#pragma unroll
    for (int r = 0; r < 16; ++r) p1[r] = fmaf(p1[r], C, off);
#pragma unroll
    for (int r = 0; r < 16; ++r) p0[r] = __builtin_amdgcn_exp2f(p0[r]);
    if (EXPALL) {
#pragma unroll
        for (int r = 0; r < 16; ++r) p1[r] = __builtin_amdgcn_exp2f(p1[r]); }
}
__device__ __forceinline__ void lut_adjust(f32x16& p0, f32x16& p1, const LAS float* lutx, const LAS int* kp, int qp, int hi) {
#pragma unroll
    for (int r = 0; r < 16; ++r) { const int key = crow(r, hi);
        int d0 = kp[key] - qp, d1 = kp[key + 32] - qp;
        d0 = d0 < -128 ? -128 : (d0 > 128 ? 128 : d0); d1 = d1 < -128 ? -128 : (d1 > 128 ? 128 : d1);
        p0[r] += lutx[d0 + 256]; p1[r] += lutx[d1 + 256]; }
}
__device__ __forceinline__ void lut_adjust_fast(f32x16& p0, f32x16& p1, const LAS float* lutx, int kp0, int qp, int hi) {
    const LAS float* bp = lutx + (kp0 - qp + 256 + 4 * hi);
#pragma unroll
    for (int r = 0; r < 16; ++r) { const int off = (r & 3) + 8 * (r >> 2); p0[r] += bp[off]; p1[r] += bp[off + 32]; }
}
template <bool EXPDONE = false>
__device__ __forceinline__ void finishSM(f32x16& p0, f32x16& p1, float alpha, float& l_reg, bf16x8& pa0, bf16x8& pa1, bf16x8& pa2, bf16x8& pa3) {
    if (!EXPDONE) {
#pragma unroll
        for (int r = 0; r < 16; ++r) p1[r] = __builtin_amdgcn_exp2f(p1[r]); }
    float ps = 0;
#pragma unroll
    for (int r = 0; r < 16; ++r) ps += p0[r];
#pragma unroll
    for (int r = 0; r < 16; ++r) ps += p1[r];
    { auto rr = __builtin_amdgcn_permlane32_swap(__float_as_uint(ps), __float_as_uint(ps), false, false);
      ps = __uint_as_float(rr[0]) + __uint_as_float(rr[1]); }
    l_reg = l_reg * alpha + ps;
#define PK4(P, BASE, OUT) do { u32x4 w = {cvtpk(P[BASE + 0], P[BASE + 1]), cvtpk(P[BASE + 2], P[BASE + 3]), cvtpk(P[BASE + 4], P[BASE + 5]), cvtpk(P[BASE + 6], P[BASE + 7])}; \
    OUT = *reinterpret_cast<bf16x8*>(&w); } while (0)
    PK4(p0, 0, pa0); PK4(p0, 8, pa1); PK4(p1, 0, pa2); PK4(p1, 8, pa3);
#undef PK4
}
__device__ __forceinline__ int v_st(int k, int c) { const int kk = (k & ~0xC) | ((k & 4) << 1) | ((k & 8) >> 1); return ((kk >> 3) * 4 + (c >> 5)) * 512 + ((kk & 7) * 32 + (c & 31)) * 2; }
__device__ __forceinline__ int v_rd_base(int lane) { return ((lane & 3) << 3) | (((lane >> 2) & 3) << 6) | (((lane >> 4) & 1) << 5) | (((lane >> 5) & 1) << 8); }
constexpr int v_rd_off(int d0, int ks, int half) { return d0 * 512 + ks * 4096 + half * 2048; }
template <int OFF> __device__ __forceinline__ s16x4 tr_read(int vb) {
    s16x4 r; asm volatile("ds_read_b64_tr_b16 %0, %1 offset:%2" : "=&v"(r) : "v"(vb), "i"(OFF) : "memory"); return r;
}
template <int D0, bool PRIO = true> __device__ __forceinline__ void pv_one(f32x16& od, int vb, bf16x8 pa0, bf16x8 pa1, bf16x8 pa2, bf16x8 pa3) {
    const s16x4 l0 = tr_read<v_rd_off(D0, 0, 0)>(vb), h0 = tr_read<v_rd_off(D0, 0, 1)>(vb), l1 = tr_read<v_rd_off(D0, 1, 0)>(vb), h1 = tr_read<v_rd_off(D0, 1, 1)>(vb);
    const s16x4 l2 = tr_read<v_rd_off(D0, 2, 0)>(vb), h2 = tr_read<v_rd_off(D0, 2, 1)>(vb), l3 = tr_read<v_rd_off(D0, 3, 0)>(vb), h3 = tr_read<v_rd_off(D0, 3, 1)>(vb);
    asm volatile("s_waitcnt lgkmcnt(0)" ::: "memory"); SBAR();
    if (PRIO) __builtin_amdgcn_s_setprio(1);
#define PK(L, H) (bf16x8){L[0], L[1], L[2], L[3], H[0], H[1], H[2], H[3]}
    od = __builtin_amdgcn_mfma_f32_32x32x16_bf16(pa0, PK(l0, h0), od, 0, 0, 0);
    od = __builtin_amdgcn_mfma_f32_32x32x16_bf16(pa1, PK(l1, h1), od, 0, 0, 0);
    od = __builtin_amdgcn_mfma_f32_32x32x16_bf16(pa2, PK(l2, h2), od, 0, 0, 0);
    od = __builtin_amdgcn_mfma_f32_32x32x16_bf16(pa3, PK(l3, h3), od, 0, 0, 0);
    if (PRIO) __builtin_amdgcn_s_setprio(0);
#undef PK
}
template <bool PRIO = true> __device__ __forceinline__ void pv_d0(f32x16* o, int vb, bf16x8 pa0, bf16x8 pa1, bf16x8 pa2, bf16x8 pa3) {
    pv_one<0, PRIO>(o[0], vb, pa0, pa1, pa2, pa3); pv_one<1, PRIO>(o[1], vb, pa0, pa1, pa2, pa3); pv_one<2, PRIO>(o[2], vb, pa0, pa1, pa2, pa3); pv_one<3, PRIO>(o[3], vb, pa0, pa1, pa2, pa3);
}
#ifndef DF_PRIO
#define DF_PRIO false
#endif
#ifndef ML_PRIO
#define ML_PRIO true
#endif
struct KAddr { int kb[4]; int krb[4]; };
__device__ __forceinline__ KAddr make_kaddr(int r32, int hi) {
    KAddr a; const int y = (hi * 16) ^ ((r32 & 7) << 4), y2 = (hi * 16) ^ (((r32 >> 1) & 7) << 4);
#pragma unroll
    for (int j = 0; j < 4; ++j) { a.kb[j] = r32 * 256 + ((j * 32) ^ y); a.krb[j] = r32 * 128 + ((j * 32) ^ y2); }
    return a;
}
template <int ND0, int NR, bool PRIO = true>
__device__ __forceinline__ void qkt(f32x16& p0, f32x16& p1, lptr Ks, lptr KRs, lptr QRs, const bf16x8* qr, int d0b, const KAddr& ka, const f32x16& cinit) {
    if (PRIO) __builtin_amdgcn_s_setprio(1);
#pragma unroll
    for (int d0 = 0; d0 < ND0; ++d0) {
        const bf16x8 b0 = *reinterpret_cast<const LAS bf16x8*>(Ks + ka.kb[d0 & 3] + ((d0b + d0) >> 2) * 128);
        const bf16x8 b1 = *reinterpret_cast<const LAS bf16x8*>(Ks + ka.kb[d0 & 3] + ((d0b + d0) >> 2) * 128 + 32 * 256);
        if (d0 == 0) { p0 = __builtin_amdgcn_mfma_f32_32x32x16_bf16(b0, qr[d0], cinit, 0, 0, 0); p1 = __builtin_amdgcn_mfma_f32_32x32x16_bf16(b1, qr[d0], cinit, 0, 0, 0); }
        else { p0 = __builtin_amdgcn_mfma_f32_32x32x16_bf16(b0, qr[d0], p0, 0, 0, 0); p1 = __builtin_amdgcn_mfma_f32_32x32x16_bf16(b1, qr[d0], p1, 0, 0, 0); } }
#pragma unroll
    for (int d0 = 0; d0 < NR; ++d0) {
        const bf16x8 b0 = *reinterpret_cast<const LAS bf16x8*>(KRs + ka.krb[d0]);
        const bf16x8 b1 = *reinterpret_cast<const LAS bf16x8*>(KRs + ka.krb[d0] + 32 * 128);
        p0 = __builtin_amdgcn_mfma_f32_32x32x16_bf16(b0, qr[ND0 + d0], p0, 0, 0, 0);
        p1 = __builtin_amdgcn_mfma_f32_32x32x16_bf16(b1, qr[ND0 + d0], p1, 0, 0, 0); }
    if (PRIO) __builtin_amdgcn_s_setprio(0);
}
template <bool EXPALL, bool FIRST>
__device__ __forceinline__ void partialSMn(f32x16& p0, f32x16& p1, float& m_reg, float& alpha) {
    float pmax = p0[0];
#pragma unroll
    for (int r = 1; r < 16; ++r) pmax = fmaxf(pmax, p0[r]);
#pragma unroll
    for (int r = 0; r < 16; ++r) pmax = fmaxf(pmax, p1[r]);
    { auto rr = __builtin_amdgcn_permlane32_swap(__float_as_uint(pmax), __float_as_uint(pmax), false, false);
      pmax = fmaxf(__uint_as_float(rr[0]), __uint_as_float(rr[1])); }
    alpha = 1.f;
    if (FIRST) { m_reg = pmax; alpha = 0.f;
#pragma unroll
        for (int r = 0; r < 16; ++r) { p0[r] -= pmax; p1[r] -= pmax; } }
    else if (__builtin_expect(!__all(pmax <= THRL), 0)) { const float delta = fmaxf(pmax, 0.f); m_reg += delta; alpha = __builtin_amdgcn_exp2f(-delta);
#pragma unroll
        for (int r = 0; r < 16; ++r) { p0[r] -= delta; p1[r] -= delta; } }
#pragma unroll
    for (int r = 0; r < 16; ++r) p0[r] = __builtin_amdgcn_exp2f(p0[r]);
    if (EXPALL) {
#pragma unroll
        for (int r = 0; r < 16; ++r) p1[r] = __builtin_amdgcn_exp2f(p1[r]); }
}
__device__ __forceinline__ bf16x8 scale_frag(bf16x8 q, float c) {
    const u32x4 w = __builtin_bit_cast(u32x4, q); u32x4 o;
#pragma unroll
    for (int i = 0; i < 4; ++i) o[i] = cvtpk(__uint_as_float(w[i] << 16) * c, __uint_as_float(w[i] & 0xffff0000u) * c);
    return __builtin_bit_cast(bf16x8, o);
}
#define SETNEG(BL) do { const float nv_ = (BL) - m_reg; if (__any(nv_ != negv)) { negv = nv_; _Pragma("unroll") for (int r = 0; r < 16; ++r) negm[r] = nv_; asm volatile("" : "+v"(negm)); } } while (0)

__device__ __forceinline__ void glds16(const bf16* g, lptr l) { __builtin_amdgcn_global_load_lds((const unsigned*)g, (LAS unsigned*)l, 16, 0, 0); }
#define WAITV(n) asm volatile("s_waitcnt vmcnt(" #n ")" ::: "memory")
#define ABAR() do { asm volatile("s_waitcnt lgkmcnt(0)" ::: "memory"); __builtin_amdgcn_s_barrier(); asm volatile("" ::: "memory"); } while (0)
__device__ __forceinline__ long ksrc_off(int p, int lane, int stride) { const int row = 4 * p + (lane >> 4), c = (lane & 15) ^ (row & 7); return (long)row * stride + c * 8; }
__device__ __forceinline__ long krsrc_off(int p, int lane, int stride) { const int row = 8 * p + (lane >> 3), c = (lane & 7) ^ ((row >> 1) & 7); return (long)row * stride + c * 8; }
__device__ __forceinline__ long vsrc_off(int p, int lane, int stride) { const int st = 2 * p + (lane >> 5), kk = (st >> 2) * 8 + ((lane & 31) >> 2);
    const int k = kk, col = (st & 3) * 32 + (lane & 3) * 8; return (long)k * stride + col; }
#define RESC(a) do { if (__any((a) < 1.f)) { if (hi == 0) al_l[r32] = (a); asm volatile("s_waitcnt lgkmcnt(0)" ::: "memory"); \
    _Pragma("unroll") for (int d = 0; d < 4; ++d) _Pragma("unroll") for (int r = 0; r < 16; ++r) o[d][r] *= al_l[crow(r, hi)]; } } while (0)

constexpr int ML_SLOT = SHM_K + SHM_V + SHM_KR, ML_NS = 3, ML_WS = ML_NS * ML_SLOT, MLA_LDS = ML_WS + 8 * 64 * 4;
__device__ __forceinline__ void mla_unit(const bf16* __restrict__ Qb, const bf16* __restrict__ KNh, const bf16* __restrict__ KRb, bf16* __restrict__ Ob, lptr lds, int tid) {
    constexpr float C = MLA_SCALE * LOG2E;
    const int wid = __builtin_amdgcn_readfirstlane(tid >> 6), lane = tid & 63, r32 = lane & 31, hi = lane >> 5;
    LAS float* ws = (LAS float*)(lds + ML_WS) + wid * 64; LAS float* li_l = ws; LAS float* al_l = ws + 32;
    float m_reg = -1e30f, l_reg = 0; f32x16 o[4] = {}; bf16x8 qr[12]; const f32x16 zero16 = {};
    const bf16* Qw = Qb + (long)(wid * QBLK + r32) * QW + hi * 8;
#pragma unroll
    for (int d0 = 0; d0 < 12; ++d0) qr[d0] = ld8(Qw + d0 * 16);
    const KAddr ka = make_kaddr(r32, hi);
    const bf16* Vh = KNh + 128;
    const int vb0 = (int)(unsigned)(uintptr_t)lds + SHM_K + v_rd_base(lane);
    const long ko0 = ksrc_off(2 * wid, lane, KVW), ko1 = ksrc_off(2 * wid + 1, lane, KVW), vo0 = vsrc_off(2 * wid, lane, KVW), vo1 = vsrc_off(2 * wid + 1, lane, KVW), ro0 = krsrc_off(wid, lane, INWP);
    lptr dK = lds + wid * 2048, dV = lds + SHM_K + wid * 2048, dR = lds + SHM_K + SHM_V + wid * 1024;
#define DMA(t, so) do { const long kr_ = (long)(t) * KVBLK; const bf16* kp_ = KNh + kr_ * KVW; const bf16* vp_ = Vh + kr_ * KVW; const bf16* rp_ = KRb + kr_ * INWP; \
    glds16(kp_ + ko0, dK + (so)); glds16(kp_ + ko1, dK + (so) + 1024); glds16(vp_ + vo0, dV + (so)); glds16(vp_ + vo1, dV + (so) + 1024); glds16(rp_ + ro0, dR + (so)); } while (0)
#define ROT3() do { const int t_ = sp; sp = sc; sc = sn; sn = t_; } while (0)
    f32x16 pA0, pA1, pB0, pB1; float alA, alB; bf16x8 pa0, pa1, pa2, pa3; constexpr int NT = SEQ / KVBLK;
    int sp = 0, sc = 0, sn = ML_SLOT;
    DMA(0, 0); DMA(1, ML_SLOT); WAITV(5); ABAR();
    qkt<8, 4, ML_PRIO>(pA0, pA1, lds, lds + SHM_K + SHM_V, lds, qr, 0, ka, zero16); partialSM(pA0, pA1, C, 0.f, m_reg, alA);
    WAITV(0); ABAR();
    sp = 0; sc = ML_SLOT; sn = 2 * ML_SLOT;
    for (int j = 1; j + 1 < NT; j += 2) {
        DMA(j + 1, sn);
        SBAR(); qkt<8, 4, ML_PRIO>(pB0, pB1, lds + sc, lds + sc + SHM_K + SHM_V, lds, qr, 0, ka, zero16);
        finishSM(pA0, pA1, alA, l_reg, pa0, pa1, pa2, pa3); SBAR();
        pv_d0<ML_PRIO>(o, vb0 + sp, pa0, pa1, pa2, pa3); partialSM(pB0, pB1, C, 0.f, m_reg, alB);
        WAITV(0); ABAR(); RESC(alB); ROT3();
        if (j + 2 < NT) DMA(j + 2, sn);
        SBAR(); qkt<8, 4, ML_PRIO>(pA0, pA1, lds + sc, lds + sc + SHM_K + SHM_V, lds, qr, 0, ka, zero16);
        finishSM(pB0, pB1, alB, l_reg, pa0, pa1, pa2, pa3); SBAR();
        pv_d0<ML_PRIO>(o, vb0 + sp, pa0, pa1, pa2, pa3); partialSM(pA0, pA1, C, 0.f, m_reg, alA);
        WAITV(0); ABAR(); RESC(alA); ROT3();
    }
    SBAR(); qkt<8, 4, ML_PRIO>(pB0, pB1, lds + sc, lds + sc + SHM_K + SHM_V, lds, qr, 0, ka, zero16);
    finishSM(pA0, pA1, alA, l_reg, pa0, pa1, pa2, pa3); SBAR();
    pv_d0<ML_PRIO>(o, vb0 + sp, pa0, pa1, pa2, pa3); partialSM(pB0, pB1, C, 0.f, m_reg, alB);
    RESC(alB);
    finishSM(pB0, pB1, alB, l_reg, pa0, pa1, pa2, pa3); SBAR();
    pv_d0<ML_PRIO>(o, vb0 + sc, pa0, pa1, pa2, pa3);
    if (hi == 0) li_l[r32] = l_reg; asm volatile("s_waitcnt lgkmcnt(0)" ::: "memory");
    float rli[16];
#pragma unroll
    for (int r = 0; r < 16; ++r) rli[r] = __builtin_amdgcn_rcpf(li_l[crow(r, hi)]);
    bf16* Ow = Ob + (long)(wid * QBLK) * DM;
#pragma unroll
    for (int r = 0; r < 16; ++r) { const int orow = crow(r, hi);
#pragma unroll
        for (int d0 = 0; d0 < 4; ++d0) Ow[(long)orow * DM + d0 * 32 + r32] = (bf16)f2bf(o[d0][r] * rli[r]); }
    ABAR();
#undef DMA
#undef ROT3
}

typedef float cv_f32x2 __attribute__((ext_vector_type(2)));
typedef __bf16 cv_bf16x2 __attribute__((ext_vector_type(2)));
__device__ __forceinline__ unsigned cv_pk(float lo, float hi) { const cv_f32x2 v = {lo, hi}; const cv_bf16x2 r = __builtin_convertvector(v, cv_bf16x2); return __builtin_bit_cast(unsigned, r); }
struct CvStream { bool on; const float* src; unsigned char* dst; unsigned sN4  , K2  , so_src, so_dst; int nsteps  ; };
constexpr int DF_SLOT = SHM_K + SHM_V, DF_NS = 4, DF_WS = DF_NS * DF_SLOT, DF_LUT = DF_WS + 8 * 64 * 4, DF_TK = DF_LUT + 512 * 4, DF_KPOS = DF_TK + 96 * 4, DF_LDS = DF_KPOS + SEQ * 4;
__device__ __forceinline__ void diff_unit(const bf16* __restrict__ Qb  , const bf16* __restrict__ Kh  ,
                                          const bf16* __restrict__ Vh  , const int* __restrict__ qposp  ,
                                          const int* __restrict__ kposp  , const int* __restrict__ tk  , const int* __restrict__ tkf  ,
                                          const float* __restrict__ relb_h  , const float* __restrict__ subln, float lam, bf16* __restrict__ Ob  , lptr lds, int tid, const CvStream cv) {
    constexpr float C = DIFF_SCALE * LOG2E;
    const int wid = __builtin_amdgcn_readfirstlane(tid >> 6), lane = tid & 63, r32 = lane & 31, hi = lane >> 5;
    const int comp = wid >> 2, wq = wid & 3;
    LAS float* ws = (LAS float*)(lds + DF_WS) + wid * 64; LAS float* li_l = ws; LAS float* al_l = ws + 32;
    LAS int* kpos_l = (LAS int*)(lds + DF_KPOS); LAS float* lut = (LAS float*)(lds + DF_LUT); LAS int* tkl = (LAS int*)(lds + DF_TK);
    const long ko0 = ksrc_off(2 * wid, lane, INWP), ko1 = ksrc_off(2 * wid + 1, lane, INWP), vo0 = vsrc_off(2 * wid, lane, INWP), vo1 = vsrc_off(2 * wid + 1, lane, INWP);
    lptr dK = lds + wid * 2048, dV = lds + SHM_K + wid * 2048;
#define DMA(t, so) do { const long kr_ = (long)(t) * KVBLK * INWP; const bf16* kp_ = Kh + kr_; const bf16* vp_ = Vh + kr_; \
    glds16(kp_ + ko0, dK + (so)); glds16(kp_ + ko1, dK + (so) + 1024); glds16(vp_ + vo0, dV + (so)); glds16(vp_ + vo1, dV + (so) + 1024); } while (0)
    DMA(0, 0); DMA(1, DF_SLOT);
    const bool cv_on = cv.on;
    const __amdgpu_buffer_rsrc_t cv_rs = __builtin_amdgcn_make_buffer_rsrc((void*)cv.src, 0, -1, 0x00020000), cv_rd = __builtin_amdgcn_make_buffer_rsrc((void*)cv.dst, 0, -1, 0x00020000);
    unsigned cv_ss = cv.so_src, cv_sd = cv.so_dst; const unsigned cv_n4 = cv.sN4;
    const int cv_vs = (lane >> 4) * 4 * (int)cv.sN4 + (lane & 15) * 16, cv_vd = (lane & 15) * 4 * (int)cv.K2 + (lane >> 4) * 8; int cv_left = cv.nsteps;
    u32x4 cv0 = {}, cv1 = {}, cv2 = {}, cv3 = {};
#define CV_LOAD() do { if (cv_on && cv_left > 0) { cv0 = __builtin_amdgcn_raw_buffer_load_b128(cv_rs, cv_vs, cv_ss, 2); cv1 = __builtin_amdgcn_raw_buffer_load_b128(cv_rs, cv_vs, cv_ss + cv_n4, 2); \
      cv2 = __builtin_amdgcn_raw_buffer_load_b128(cv_rs, cv_vs, cv_ss + 2 * cv_n4, 2); cv3 = __builtin_amdgcn_raw_buffer_load_b128(cv_rs, cv_vs, cv_ss + 3 * cv_n4, 2); cv_ss += 16 * cv_n4; } } while (0)
#define CV_ST1(J_, C_) do { pg8::u32x2 o_; o_.x = cv_pk(cvf0_.C_, cvf1_.C_); o_.y = cv_pk(cvf2_.C_, cvf3_.C_); \
      __builtin_amdgcn_raw_buffer_store_b64(o_, cv_rd, cv_vd, cv_sd + (J_) * cv.K2, 0); } while (0)
#define CV_STORE() do { if (cv_on && cv_left > 0) {   \
      const f32x4 cvf0_ = __builtin_bit_cast(f32x4, cv0), cvf1_ = __builtin_bit_cast(f32x4, cv1), cvf2_ = __builtin_bit_cast(f32x4, cv2), cvf3_ = __builtin_bit_cast(f32x4, cv3); \
      CV_ST1(0, x); CV_ST1(1, y); CV_ST1(2, z); CV_ST1(3, w); cv_sd += 32; --cv_left; } } while (0)
    const int ld_ = tid - 256;
    const float lutv = relb_h[t5_bucket(ld_ < -128 ? -128 : (ld_ > 128 ? 128 : ld_)) * 8] * LOG2E;
    const int tkv = (tid >= 448) ? tk[tid - 448] : ((tid >= 416) ? tkf[tid - 416] : 0);
    const u32x4 kp4 = *(const u32x4*)(kposp + tid * 4);
    const int qp = qposp[wq * QBLK + r32];
    float m_reg = 0.f, l_reg = 0; f32x16 o[4] = {}; bf16x8 qr[4]; f32x16 negm = {}; float negv = 0.f;
    const bf16* Qw = Qb + (long)(wq * QBLK + r32) * INWP + comp * 64 + hi * 8;
#pragma unroll
    for (int d0 = 0; d0 < 4; ++d0) qr[d0] = ld8(Qw + d0 * 16);
    lut[tid] = lutv;
    if (tid >= 448) tkl[tid - 448] = tkv; else if (tid >= 416) tkl[64 + tid - 416] = tkv;
    *(LAS u32x4*)(kpos_l + tid * 4) = kp4;
    int qmn = qp, qmx = qp;
#pragma unroll
    for (int of = 1; of < 32; of <<= 1) { qmn = min(qmn, __shfl_xor(qmn, of)); qmx = max(qmx, __shfl_xor(qmx, of)); }
    qmn = __builtin_amdgcn_readfirstlane(qmn); qmx = __builtin_amdgcn_readfirstlane(qmx);
    const bool qnarrow = (qmx - qmn < 32);
#pragma unroll
    for (int d0 = 0; d0 < 4; ++d0) qr[d0] = scale_frag(qr[d0], C);
    const KAddr ka = make_kaddr(r32, hi);
    const int vb0 = (int)(unsigned)(uintptr_t)lds + SHM_K + v_rd_base(lane);
#define TILEBIAS(t, BL, NEAR) const int kmn_##BL = tkl[2 * (t)], kmx_##BL = tkl[2 * (t) + 1]; const bool fr_##BL = (kmn_##BL - qmx >= 91), fl_##BL = (kmx_##BL - qmn <= -91); \
    const bool NEAR = !(fr_##BL || fl_##BL); const float BL = fr_##BL ? blR : (fl_##BL ? blL : 0.f)
#define ADJ(P0, P1, t, NEAR) do { if (NEAR) { if (qnarrow && tkl[64 + (t)] != 0) lut_adjust_fast(P0, P1, lut, tkl[2 * (t)], qp, hi); else lut_adjust(P0, P1, lut, kpos_l + (t) * 64, qp, hi); } } while (0)
#define SLOT(t) (((t) & 3) * DF_SLOT)
#define ENDWAIT(t) do { if ((t) + 2 < NT) WAITV(4); else WAITV(0); } while (0)
#define ENDSTEP(t) ABAR()
    f32x16 pA0, pA1, pB0, pB1; float alA, alB; bf16x8 pa0, pa1, pa2, pa3; constexpr int NT = SEQ / KVBLK;
    WAITV(0); ABAR();
    const float blR = lut[256 + 128], blL = lut[256 - 128];
    DMA(2, SLOT(2));
    { TILEBIAS(0, bl0, near0); SETNEG(bl0);
      qkt<4, 0, DF_PRIO>(pA0, pA1, lds + SLOT(0), lds, lds, qr, 4 * comp, ka, negm); ADJ(pA0, pA1, 0, near0); partialSMn<true, true>(pA0, pA1, m_reg, alA); }
    ENDWAIT(0); CV_LOAD(); ENDSTEP(0);
    for (int j = 1; j + 1 < NT; j += 2) {
        if (j + 2 < NT) DMA(j + 2, SLOT(j + 2));
        { TILEBIAS(j, blb, nearb); SETNEG(blb);
          SBAR(); qkt<4, 0, DF_PRIO>(pB0, pB1, lds + SLOT(j), lds, lds, qr, 4 * comp, ka, negm);
          finishSM<true>(pA0, pA1, alA, l_reg, pa0, pa1, pa2, pa3); SBAR();
          ADJ(pB0, pB1, j, nearb); SBAR();
          pv_d0<DF_PRIO>(o, vb0 + SLOT(j - 1), pa0, pa1, pa2, pa3); partialSMn<true, false>(pB0, pB1, m_reg, alB); }
        ENDWAIT(j); CV_STORE(); CV_LOAD(); ENDSTEP(j); RESC(alB);
        if (j + 3 < NT) DMA(j + 3, SLOT(j + 3));
        { TILEBIAS(j + 1, bla, neara); SETNEG(bla);
          SBAR(); qkt<4, 0, DF_PRIO>(pA0, pA1, lds + SLOT(j + 1), lds, lds, qr, 4 * comp, ka, negm);
          finishSM<true>(pB0, pB1, alB, l_reg, pa0, pa1, pa2, pa3); SBAR();
          ADJ(pA0, pA1, j + 1, neara); SBAR();
          pv_d0<DF_PRIO>(o, vb0 + SLOT(j), pa0, pa1, pa2, pa3); partialSMn<true, false>(pA0, pA1, m_reg, alA); }
        ENDWAIT(j + 1); CV_STORE(); CV_LOAD(); ENDSTEP(j + 1); RESC(alA);
    }
    CV_STORE(); CV_LOAD();
    { TILEBIAS(NT - 1, blz, nearz); SETNEG(blz);
      SBAR(); qkt<4, 0, DF_PRIO>(pB0, pB1, lds + SLOT(NT - 1), lds, lds, qr, 4 * comp, ka, negm);
      finishSM<true>(pA0, pA1, alA, l_reg, pa0, pa1, pa2, pa3); SBAR();
      ADJ(pB0, pB1, NT - 1, nearz); SBAR();
      pv_d0<DF_PRIO>(o, vb0 + SLOT(NT - 2), pa0, pa1, pa2, pa3); partialSMn<true, false>(pB0, pB1, m_reg, alB); }
    RESC(alB);
    finishSM<true>(pB0, pB1, alB, l_reg, pa0, pa1, pa2, pa3); SBAR();
    pv_d0<DF_PRIO>(o, vb0 + SLOT(NT - 1), pa0, pa1, pa2, pa3);
    CV_STORE();
    if (hi == 0) li_l[r32] = l_reg; asm volatile("s_waitcnt lgkmcnt(0)" ::: "memory");
    float rli[16];
#pragma unroll
    for (int r = 0; r < 16; ++r) rli[r] = __builtin_amdgcn_rcpf(li_l[crow(r, hi)]);
    ABAR();
    LAS float* X = (LAS float*)lds + (wq * 32) * 128;
    if (comp == 1) {
#pragma unroll
        for (int r = 0; r < 16; ++r) { const int orow = crow(r, hi);
#pragma unroll
            for (int d0 = 0; d0 < 4; ++d0) X[orow * 128 + d0 * 32 + r32] = o[d0][r] * rli[r] * lam; }
    }
    ABAR();
    if (comp == 0) {
        bf16* Ow = Ob + (long)(wq * QBLK) * DM;
        float sl[4];
#pragma unroll
        for (int d0 = 0; d0 < 4; ++d0) sl[d0] = subln[d0 * 32 + r32] * (1.0f - LAMBDA_INIT);
#pragma unroll
        for (int r = 0; r < 16; ++r) { const int orow = crow(r, hi);
            float v[4]; float ss = 0.f;
#pragma unroll
            for (int d0 = 0; d0 < 4; ++d0) { v[d0] = o[d0][r] * rli[r] - X[orow * 128 + d0 * 32 + r32]; ss += v[d0] * v[d0]; }
#pragma unroll
            for (int of = 1; of < 32; of <<= 1) ss += __shfl_xor(ss, of);
            const float rstd = rsqrtf(ss * (1.0f / 128.0f) + EPS);
#pragma unroll
            for (int d0 = 0; d0 < 4; ++d0) Ow[(long)orow * DM + d0 * 32 + r32] = (bf16)f2bf(v[d0] * rstd * sl[d0]); }
    }
    ABAR();
#undef DMA
#undef TILEBIAS
#undef ADJ
#undef SETNEG
#undef SLOT
#undef ENDSTEP
#undef ENDWAIT
#undef CV_LOAD
#undef CV_STORE
#undef CV_ST1
#undef RESC
#undef WAITV
#undef ABAR
}
#undef KSWZ
#undef KRSWZ
#undef SBAR
}

__device__ __forceinline__ void attn_phase(unsigned char* ws, const int* pos, const float* rel_bias, const float* subln, float lam, LAS unsigned char* lds, int tid, int G, int bid,
                                           const float* wsrc_o, const float* wsrc_up, const float* wsrc_dn) {
    const bf16* PROJ = (const bf16*)(ws + WS_PROJ); const bf16* Qb = (const bf16*)(ws + WS_Q); const bf16* KVb = (const bf16*)(ws + WS_KV); bf16* AO = (bf16*)(ws + WS_AO);
    const int* TK = (const int*)(ws + WS_TK);
    const int vcu = (G % 8 == 0) ? (bid % 8) * (G / 8) + bid / 8 : bid;
    { constexpr int NU = BATCH * 8 * (SEQ / 256); const int per = (NU + G - 1) / G;
      for (int i = 0; i < per; ++i) { const int un = vcu * per + i; if (un >= NU) break;
        int tidu = tid; asm volatile("" : "+v"(tidu));
        const int qb = un & 7, h = (un >> 3) & 7, b = un >> 6;
        const size_t m0 = (size_t)b * SEQ + qb * 256;
        att::mla_unit(Qb + m0 * QW + h * 192, KVb + (size_t)b * SEQ * KVW + h * 256, PROJ + (size_t)b * SEQ * INWP + C_KROPE, AO + m0 * DM + h * 128, (att::lptr)lds, tidu); } }
    { constexpr int NU = BATCH * 8 * (SEQ / 128); const int per = (NU + G - 1) / G;
      att::CvStream cvb; cvb.on = false; cvb.src = nullptr; cvb.dst = nullptr; cvb.sN4 = 0; cvb.K2 = 0; cvb.so_src = 0; cvb.so_dst = 0; cvb.nsteps = 0; int cv_kunit = 0;
      if (G == 256) { const int gw_ = __builtin_amdgcn_readfirstlane(tid >> 6) * G + vcu; int strip = 0, kb_ = 0, N_ = 0, K_ = 0;
        if (gw_ < 32) { strip = gw_; N_ = DM; K_ = DM; cvb.src = wsrc_o; cvb.dst = ws + WS_WO; cvb.on = true; cvb.nsteps = 32; cv_kunit = 512; }
        else if (gw_ < 208) { strip = gw_ - 32; N_ = FF2; K_ = DM; cvb.src = wsrc_up; cvb.dst = ws + WS_WUP; cvb.on = true; cvb.nsteps = 32; cv_kunit = 512; }
        else if (gw_ < 336) { const int g_ = gw_ - 208; strip = g_ >> 2; kb_ = 1408 * (g_ & 3); N_ = DM; K_ = FF; cvb.src = wsrc_dn; cvb.dst = ws + WS_WDN; cvb.on = true; cvb.nsteps = 22; cv_kunit = 352; }
        cvb.sN4 = (unsigned)N_ * 4u; cvb.K2 = (unsigned)K_ * 2u;
        cvb.so_src = ((unsigned)kb_ * (unsigned)N_ + 64u * strip) * 4u; cvb.so_dst = ((unsigned)(64 * strip) * (unsigned)K_ + (unsigned)kb_) * 2u; }
      for (int i = 0; i < per; ++i) { const int un = vcu * per + i; if (un >= NU) break;
        int tidu = tid; asm volatile("" : "+v"(tidu));
        const int qb = un & 15, h = (un >> 4) & 7, b = un >> 7;
        const size_t m0 = (size_t)b * SEQ + qb * 128;
        att::CvStream cv = cvb; cv.so_src += (unsigned)(cv_kunit * i) * cvb.sN4; cv.so_dst += (unsigned)(cv_kunit * i) * 2u;
        att::diff_unit(PROJ + m0 * INWP + C_DQ + h * 128, PROJ + (size_t)b * SEQ * INWP + C_DK + h * 128, PROJ + (size_t)b * SEQ * INWP + C_DV + h * 128,
                       pos + m0, pos + (size_t)b * SEQ, TK + b * 64, TK + TKF_OFF + b * 32, rel_bias + h, subln, lam, AO + m0 * DM + 1024 + h * 128, (att::lptr)lds, tidu, cv); } }
}

constexpr int NPH = 11;
struct Args { const void* in[25]; float* out; unsigned char* ws; int ph_lo, ph_hi; };
__global__ void __launch_bounds__(NTHREADS, 2) fwd(Args args) {
    extern __shared__ __attribute__((aligned(16))) unsigned char lds_raw[];
    LAS unsigned char* lds = (LAS unsigned char*)lds_raw;
    const int tid0 = threadIdx.x, G0 = gridDim.x;
    const int wave0 = __builtin_amdgcn_readfirstlane(tid0 >> 6);
    for (int u = tid0; u < (LDS_BYTES - LDSCTL_OFF) / 4; u += NTHREADS) ((LAS unsigned*)(lds + LDSCTL_OFF))[u] = 0u;
    __syncthreads();
    if (tid0 == 0) {
        LAS unsigned long long* pt = (LAS unsigned long long*)(lds + PTR_OFF);
#pragma unroll
        for (int i = 0; i < 25; ++i) pt[i] = (unsigned long long)args.in[i];
        pt[P_OUT] = (unsigned long long)args.out; pt[P_WS] = (unsigned long long)args.ws;
    }
    __syncthreads();
    volatile LAS unsigned* MISC = (volatile LAS unsigned*)(lds + MISC_OFF);
    const int ph_lo = args.ph_lo, ph_hi = args.ph_hi;
    XcdBarrier bar; bar.bar = nullptr; bar.x = 0; bar.st = nullptr;
    if (ph_hi - ph_lo > 1) bar = xcd_barrier_post((unsigned*)(LPWS() + WS_CTL) + CW_BAR, MISC + 8, tid0);

#define PH_BEGIN(k) if (ph_lo <= (k) && (k) < ph_hi) { int G = G0, bid = (int)blockIdx.x, wave = wave0; \
        int lane = (int)__builtin_amdgcn_mbcnt_hi(~0u, __builtin_amdgcn_mbcnt_lo(~0u, 0u)); \
        asm volatile("" : "+v"(lane)); asm volatile("" : "+s"(G)); asm volatile("" : "+s"(bid)); asm volatile("" : "+s"(wave)); \
        const int tid = wave * 64 + lane; (void)tid; (void)lane; (void)G; (void)bid; unsigned char* ws = LPWS(); (void)ws;
#define PH_END(k) if ((k) + 1 < ph_hi) xcd_barrier(bar, tid); }

    PH_BEGIN(0) p0_prologue(lds, tid, lane, wave, G, bid); PH_END(0)
    PH_BEGIN(1) prenorm_phase(LPF(P_X), LPF(P_APRE), (const float*)(ws + WS_MOD), MOD_SHA, MOD_SCA, (bf16*)(ws + WS_H), lane, wave, G, bid); PH_END(1)
    for (int q = 0; q < 3; ++q) {
        const int k = (q == 0) ? 2 : 3;
        PH_BEGIN(k)
            bf16* PROJ = (bf16*)(ws + WS_PROJ);
            pg8::Gemm g; pg8::EpiX E;
            E.qscale = 1.0f; E.ssq_q = (float*)(ws + WS_SSQQ); E.ssq_kv = (float*)(ws + WS_SSQKV); E.COS = (const float*)(ws + WS_COS); E.SIN = (const float*)(ws + WS_SIN);
            if (q == 0) { g = pg8::Gemm{(const bf16*)(ws + WS_H), (const bf16*)(ws + WS_WIN), M, INWP, DM, DM, DM, 128, 256, 0}; E.O = PROJ; E.ldc = INWP; E.mode = 0; }
            else if (q == 1) { g = pg8::Gemm{PROJ + C_QLAT, (const bf16*)(ws + WS_WUQ), M, QW, 512, INWP, 512, 128, 256, 0}; E.O = (bf16*)(ws + WS_Q); E.ldc = QW; E.mode = 1; }
            else { g = pg8::Gemm{PROJ + C_KVLAT, (const bf16*)(ws + WS_WUKV), M, KVW, 256, INWP, 256, 128, 256, 0}; E.O = (bf16*)(ws + WS_KV); E.ldc = KVW; E.mode = 2; }
            const int vcu = (G % 8 == 0) ? (bid % 8) * (G / 8) + bid / 8 : bid;
            pg8::ListOrder S;
            if (G == 256) {
                if (q == 0) S = pg8::ListOrder{4 * vcu, 4, INWP / 256};
                else if (q == 1) S = (vcu < 128) ? pg8::ListOrder{2 * vcu, 2, QW / 256} : pg8::ListOrder{256 + (vcu - 128), 1, QW / 256};
                else S = (vcu < 128) ? pg8::ListOrder{vcu, 1, KVW / 256} : pg8::ListOrder{128 + 3 * (vcu - 128), 3, KVW / 256};
            } else { const int nu = (g.M / 256) * (g.N / 256), per = (nu + G - 1) / G, b0 = vcu * per; S = pg8::ListOrder{b0, (b0 >= nu) ? 0 : ((nu - b0 < per) ? nu - b0 : per), g.N / 256}; }
            pg8::gemm_phase<pg8::EpiX, pg8::ListOrder, true, true>(lds, g, S, E, tid);
            if (q == 1) { }
            else
        PH_END(k)
        else { }
    }
    PH_BEGIN(4)
        const float s1 = wave_sum(LPF(P_LQ1)[lane] * LPF(P_LK1)[lane]), s2 = wave_sum(LPF(P_LQ2)[lane] * LPF(P_LK2)[lane]);
        const float lam = expf(s1) - expf(s2) + LAMBDA_INIT;
        attn_phase(ws, (const int*)ldptr(lds, P_POS), LPF(P_RELB), LPF(P_SUBLN), lam, lds, tid, G, bid, LPF(P_WO), LPF(P_WUP), LPF(P_WDN));
    PH_END(4)
    for (int q = 0; q < 2; ++q) {
        const int k = (q == 0) ? 5 : 9;
        PH_BEGIN(k)
            pg8::Gemm g; pg8::EpiBf16 E;
            if (q == 0) { g = pg8::Gemm{(const bf16*)(ws + WS_AO), (const bf16*)(ws + WS_WO), M, DM, DM, DM, DM, 128, 256, 0}; E = pg8::EpiBf16{(bf16*)(ws + WS_Y), DM}; }
            else { g = pg8::Gemm{(const bf16*)(ws + WS_G), (const bf16*)(ws + WS_WDN), M, DM, FF, FF, FF, 128, 256, 0}; E = pg8::EpiBf16{(bf16*)(ws + WS_Y2), DM}; }
            pg8::StaticOrder S; S.init(g.M, g.N, G, bid);
            pg8::gemm_phase<pg8::EpiBf16, pg8::StaticOrder, true, true>(lds, g, S, E, tid);
        PH_END(k)
        if (q == 0) {
            PH_BEGIN(6) post_phase<true>((const bf16*)(ws + WS_Y), LPF(P_X), (void*)(ws + WS_X1), LPF(P_APOST), (const float*)(ws + WS_MOD), MOD_GA, LPF(P_FPRE), MOD_SHF, MOD_SCF, (bf16*)(ws + WS_H), lane, wave, G, bid); PH_END(6)
            PH_BEGIN(7)
                pg8::Gemm g = pg8::Gemm{(const bf16*)(ws + WS_H), (const bf16*)(ws + WS_WUP), M, FF2, DM, DM, DM, FF, 128, 1};
                pg8::EpiConv E{(bf16*)(ws + WS_G), (bf16*)(ws + WS_E), LPF(P_CW), LPF(P_CB), FF, FF2};
                pg8::StaticOrder S; S.init(g.M, g.N, G, bid);
                pg8::gemm_phase<pg8::EpiConv, pg8::StaticOrder, true, true>(lds, g, S, E, tid);
            PH_END(7)
            PH_BEGIN(8) fixup_phase((const bf16*)(ws + WS_E), (bf16*)(ws + WS_G), LPF(P_CW), LPF(P_CB), tid, G, bid); PH_END(8)
        }
    }
    PH_BEGIN(10) float* outp = (float*)ldptr(lds, P_OUT);
        post_phase<false>((const bf16*)(ws + WS_Y2), (const void*)(ws + WS_X1), outp, LPF(P_FPOST), (const float*)(ws + WS_MOD), MOD_GF, nullptr, 0, 0, nullptr, lane, wave, G, bid); PH_END(10)
#undef PH_BEGIN
#undef PH_END
}

#ifndef MK_ONE_LAUNCH
#define MK_ONE_LAUNCH 1
#endif
extern "C" void kernel_launch(void* const* d_in, const int* in_sizes, int n_in, void* d_out, int out_size, void* d_ws, size_t ws_size, hipStream_t stream) {
    static int grid = 0;
    if (grid == 0) {
        if (n_in != 25 || in_sizes[0] != M * DM || out_size != M * DM || ws_size < WS_END) {
            fprintf(stderr, "kernel_launch: shape mismatch: n_in %d in0 %d out %d ws %zu (need >= %zu)\n", n_in, n_in > 0 ? in_sizes[0] : -1, out_size, ws_size, (size_t)WS_END); grid = -1; return; }
        int dev = 0, cus = 0;
        if (hipGetDevice(&dev) != hipSuccess || hipDeviceGetAttribute(&cus, hipDeviceAttributeMultiprocessorCount, dev) != hipSuccess) { grid = -1; return; }
        if (hipFuncSetAttribute((const void*)fwd, hipFuncAttributeMaxDynamicSharedMemorySize, LDS_BYTES) != hipSuccess) { fprintf(stderr, "kernel_launch: hipFuncSetAttribute failed\n"); grid = -1; return; }
        (void)hipGetLastError();
        grid = cus;
    }
    if (grid < 0) return;
    if (hipMemsetAsync((char*)d_ws + WS_CTL, 0, CTL_ZERO_BYTES, stream) != hipSuccess) { fprintf(stderr, "kernel_launch: memset failed\n"); return; }
    Args a{};
    for (int i = 0; i < 25; ++i) a.in[i] = d_in[i];
    a.out = (float*)d_out; a.ws = (unsigned char*)d_ws;
#if MK_ONE_LAUNCH
    a.ph_lo = 0; a.ph_hi = NPH;
    hipLaunchKernelGGL(fwd, dim3(grid), dim3(NTHREADS), LDS_BYTES, stream, a);
#else
    for (int p = 0; p < NPH; ++p) { a.ph_lo = p; a.ph_hi = p + 1; hipLaunchKernelGGL(fwd, dim3(grid), dim3(NTHREADS), LDS_BYTES, stream, a); }
#endif
    const hipError_t le = hipPeekAtLastError();
    if (le != hipSuccess) fprintf(stderr, "kernel_launch: launch failed: %s\n", hipGetErrorName(le));
}
```

```cpp
#include <hip/hip_runtime.h>
#include <cstdio>
#include <cstdint>
namespace pg8 {
#define PG8_LAS __attribute__((address_space(3)))
typedef unsigned short bf16_t;
typedef short bf16x8 __attribute__((ext_vector_type(8)));
typedef float f32x4 __attribute__((ext_vector_type(4)));
typedef unsigned u32x2 __attribute__((ext_vector_type(2)));
typedef unsigned u32x4 __attribute__((ext_vector_type(4)));
constexpr int BM = 256, BK = 64, HALF = 128, HTB = HALF * BK * 2  , STAGE_BYTES = 8 * HTB, NXCD = 8, WGM = 8;

__host__ __device__ __forceinline__ int lds_byte(int r, int c) { const int st = (r >> 4) * 2 + (c >> 5), rr = r & 15, cc = c & 31, ob = rr * 64 + cc * 2; return st * 1024 + (ob ^ (((ob >> 9) & 1) << 5)); }
__host__ __device__ __forceinline__ void stage_rc(int b, int& R, int& C) { const int st = b / 1024, sb = b % 1024, swz = sb ^ (((sb >> 9) & 1) << 5); R = (st >> 1) * 16 + swz / 64; C = (st & 1) * 32 + (swz % 64) / 2; }
__host__ __device__ __forceinline__ int perm32(int rho) { const int n = rho >> 4, i = rho & 15; return 8 * (i >> 2) + 4 * n + (i & 3); }

struct Unit { int pm, pn; };
struct Gemm { const bf16_t* A; const bf16_t* Bt; int M, N, K, lda, ldb, hsb, tsb, aperm; };

struct StaticOrder {
    int nM, nN, nwg, G, c;
    __host__ __device__ void init(int M, int N, int G_, int c_) { nM = M / BM; nN = N / BM; nwg = nM * nN; G = G_; c = c_; }
    __host__ __device__ bool next(int i, Unit& u) const {
        const long L = (long)i * G + c; if (L >= nwg) return false;
        int wgid = (int)L; { const int q = nwg / NXCD, r = nwg % NXCD, xcd = wgid % NXCD, off = wgid / NXCD; wgid = (xcd < r ? xcd * (q + 1) : r * (q + 1) + (xcd - r) * q) + off; }
        const int nig = WGM * nN, gid = wgid / nig, fm = gid * WGM, gsz = (nM - fm) < WGM ? (nM - fm) : WGM;
        u.pm = fm + ((wgid % nig) % gsz); u.pn = (wgid % nig) / gsz; return true;
    }
    __device__ __forceinline__ void a_ready(const Unit&) const {}
    __device__ __forceinline__ void done(const Unit&) const {}
};


struct ListOrder {
    int base, cnt, nN;
    __host__ __device__ bool next(int i, Unit& u) const { if (i >= cnt) return false; const int id = base + i; u.pm = id / nN; u.pn = id % nN; return true; }
    __device__ __forceinline__ void a_ready(const Unit&) const {}
    __device__ __forceinline__ void done(const Unit&) const {}
};

__device__ __forceinline__ unsigned cvt_pk_bf16(float lo, float hi) { unsigned r; asm volatile("v_cvt_pk_bf16_f32 %0, %1, %2" : "=v"(r) : "v"(lo), "v"(hi)); return r; }

struct EpiF32 {
    static constexpr bool PERM = false, AFTER_DRAIN = false;
    float* C; int ldc;
    __device__ __forceinline__ void operator()(const f32x4 (&acc)[2][2][4][2], const Unit& u, int wr, int wc, int fr, int fq) const {
        const int row0 = u.pm * BM + wr * 64 + fr, col0 = u.pn * BM + wc * 32 + 4 * fq;
#pragma unroll
        for (int ai = 0; ai < 2; ++ai)
#pragma unroll
            for (int m = 0; m < 4; ++m) { float* rowp = C + (size_t)(row0 + ai * HALF + m * 16) * ldc + col0;
#pragma unroll
                for (int bj = 0; bj < 2; ++bj)
#pragma unroll
                    for (int n = 0; n < 2; ++n) *(f32x4*)(rowp + bj * HALF + n * 16) = acc[ai][bj][m][n]; }
    }
};
struct EpiBf16 {
    static constexpr bool PERM = true, AFTER_DRAIN = false;
    bf16_t* O; int ldc;
    __device__ __forceinline__ void operator()(const f32x4 (&acc)[2][2][4][2], const Unit& u, int wr, int wc, int fr, int fq) const {
        const int row0 = u.pm * BM + wr * 64 + fr; const int col0 = u.pn * BM + wc * 32 + 8 * fq;
#pragma unroll
        for (int ai = 0; ai < 2; ++ai)
#pragma unroll
            for (int m = 0; m < 4; ++m) { bf16_t* rowp = O + (size_t)(row0 + ai * HALF + m * 16) * ldc + col0;
#pragma unroll
                for (int bj = 0; bj < 2; ++bj) { const f32x4 v0 = acc[ai][bj][m][0], v1 = acc[ai][bj][m][1];
                    u32x4 w; w.x = cvt_pk_bf16(v0[0], v0[1]); w.y = cvt_pk_bf16(v0[2], v0[3]); w.z = cvt_pk_bf16(v1[0], v1[1]); w.w = cvt_pk_bf16(v1[2], v1[3]);
                    *(u32x4*)(rowp + bj * HALF) = w; } }
    }
};

struct EpiX {
    static constexpr bool PERM = true, AFTER_DRAIN = false;
    bf16_t* O; int ldc; int mode; float* ssq_q; float* ssq_kv; const float* COS; const float* SIN; float qscale;
    __device__ __forceinline__ void operator()(const f32x4 (&acc)[2][2][4][2], const Unit& u, int wr, int wc, int fr, int fq) const {
        const int row0 = u.pm * BM + wr * 64 + fr; const int col0 = u.pn * BM + wc * 32 + 8 * fq;
        const bool do_ssq = (mode == 0) && (u.pn <= 2);
#pragma unroll
        for (int ai = 0; ai < 2; ++ai)
#pragma unroll
            for (int m = 0; m < 4; ++m) { const int row = row0 + ai * HALF + m * 16; bf16_t* rowp = O + (size_t)row * ldc + col0;
                float sc = 1.0f;
                if (mode == 1) sc = rsqrtf(ssq_q[row] * (1.0f / 512.0f) + 1e-6f) * qscale; else if (mode == 2) sc = rsqrtf(ssq_kv[row] * (1.0f / 256.0f) + 1e-6f);
                float ss = 0.f;
#pragma unroll
                for (int bj = 0; bj < 2; ++bj) { f32x4 v0 = acc[ai][bj][m][0] * sc, v1 = acc[ai][bj][m][1] * sc;
                    const int span = u.pn * BM + bj * HALF + wc * 32;
                    int roff = -1;
                    if (mode == 0) { if (span == 768 || span == 800) roff = span - 768; }
                    else if (mode == 1) { const int d = span % 192; if (d >= 128) roff = d - 128; }
                    if (roff >= 0) { const int ib = (roff >> 1) + 4 * fq;
                        const f32x4 cs = *(const f32x4*)(COS + (size_t)row * 32 + ib), sn = *(const f32x4*)(SIN + (size_t)row * 32 + ib);
                        f32x4 w0, w1;
                        w0[0] = v0[0] * cs[0] - v0[1] * sn[0]; w0[1] = v0[0] * sn[0] + v0[1] * cs[0]; w0[2] = v0[2] * cs[1] - v0[3] * sn[1]; w0[3] = v0[2] * sn[1] + v0[3] * cs[1];
                        w1[0] = v1[0] * cs[2] - v1[1] * sn[2]; w1[1] = v1[0] * sn[2] + v1[1] * cs[2]; w1[2] = v1[2] * cs[3] - v1[3] * sn[3]; w1[3] = v1[2] * sn[3] + v1[3] * cs[3];
                        v0 = w0; v1 = w1; }
                    if (do_ssq) ss += ((v0[0] * v0[0] + v0[1] * v0[1]) + (v0[2] * v0[2] + v0[3] * v0[3])) + ((v1[0] * v1[0] + v1[1] * v1[1]) + (v1[2] * v1[2] + v1[3] * v1[3]));
                    u32x4 w; w.x = cvt_pk_bf16(v0[0], v0[1]); w.y = cvt_pk_bf16(v0[2], v0[3]); w.z = cvt_pk_bf16(v1[0], v1[1]); w.w = cvt_pk_bf16(v1[2], v1[3]);
                    *(u32x4*)(rowp + bj * HALF) = w; }
                if (do_ssq) { ss += __shfl_xor(ss, 16); ss += __shfl_xor(ss, 32);
                    if (fq == 0) atomicAdd((u.pn < 2 ? ssq_q : ssq_kv) + row, ss); }
            }
    }
};

struct EpiConv {
    static constexpr bool PERM = true, AFTER_DRAIN = false;
    bf16_t* G; bf16_t* E; const float* cw; const float* cb; int ff, ff2;
    template <int CTRL> static __device__ __forceinline__ float dpp(float x) { return __builtin_bit_cast(float, __builtin_amdgcn_update_dpp(0, __builtin_bit_cast(int, x), CTRL, 0xf, 0xf, true)); }
    static __device__ __forceinline__ float gelu(float x) { const float t = x * x, u = __builtin_fmaf(t, -0.10294324f, -2.3022082f); return x * __builtin_amdgcn_rcpf(1.0f + __builtin_amdgcn_exp2f(x * u)); }
    __device__ __forceinline__ void operator()(const f32x4 (&acc)[2][2][4][2], const Unit& u, int wr, int wc, int fr, int fq) const {
        const int fl = wc * 32 + 8 * fq, f0 = u.pn * HALF + fl;
        constexpr int SHR1 = 0x111, SHL1 = 0x101;
#pragma unroll
        for (int n = 0; n < 2; ++n) {
            const int f = f0 + 4 * n;
            const f32x4 g0 = *(const f32x4*)(cw + f), g1 = *(const f32x4*)(cw + ff2 + f), g2 = *(const f32x4*)(cw + 2 * ff2 + f), gb = *(const f32x4*)(cb + f);
            const f32x4 v0 = *(const f32x4*)(cw + ff + f), v1 = *(const f32x4*)(cw + ff2 + ff + f), v2 = *(const f32x4*)(cw + 2 * ff2 + ff + f), vb = *(const f32x4*)(cb + ff + f);
#pragma unroll
            for (int ai = 0; ai < 2; ++ai) {
                const int grp = u.pm * 4 + ai * 2 + wr;
#pragma unroll
                for (int m = 0; m < 4; ++m) { const int row = u.pm * BM + ai * HALF + wr * 64 + 4 * fr + m;
                    const f32x4 a = acc[ai][0][m][n], b = acc[ai][1][m][n];
                    const f32x4 ap = acc[ai][0][m > 0 ? m - 1 : 3][n], bp = acc[ai][1][m > 0 ? m - 1 : 3][n];
                    const f32x4 an = acc[ai][0][m < 3 ? m + 1 : 0][n], bn = acc[ai][1][m < 3 ? m + 1 : 0][n];
                    float og[4];
#pragma unroll
                    for (int c = 0; c < 4; ++c) {
                        float ga = __builtin_fmaf(g1[c], a[c], gb[c]), va = __builtin_fmaf(v1[c], b[c], vb[c]);
                        ga = __builtin_fmaf(g0[c], m > 0 ? ap[c] : dpp<SHR1>(ap[c]), ga); va = __builtin_fmaf(v0[c], m > 0 ? bp[c] : dpp<SHR1>(bp[c]), va);
                        ga = __builtin_fmaf(g2[c], m < 3 ? an[c] : dpp<SHL1>(an[c]), ga); va = __builtin_fmaf(v2[c], m < 3 ? bn[c] : dpp<SHL1>(bn[c]), va);
                        og[c] = gelu(ga) * va; }
                    uint2 o2; o2.x = cvt_pk_bf16(og[0], og[1]); o2.y = cvt_pk_bf16(og[2], og[3]);
                    *(uint2*)(G + (size_t)row * ff + f) = o2;
                    if ((m < 2 && fr == 0) || (m >= 2 && fr == 15)) {
                        bf16_t* ep = E + ((size_t)(u.pn * 256 + grp) * 4 + m) * 256 + fl + 4 * n;
                        uint2 eg; eg.x = cvt_pk_bf16(a[0], a[1]); eg.y = cvt_pk_bf16(a[2], a[3]); uint2 ev; ev.x = cvt_pk_bf16(b[0], b[1]); ev.y = cvt_pk_bf16(b[2], b[3]);
                        *(uint2*)ep = eg; *(uint2*)(ep + HALF) = ev; }
                }
            }
        }
    }
};
template <class Epi, class Sched, bool ALIGN_EPI = false, bool SP2 = false>
__device__ __forceinline__ void gemm_phase(PG8_LAS unsigned char* lds, const Gemm g, const Sched& S, const Epi& E, const int tid) {
    const int  wid = __builtin_amdgcn_readfirstlane(tid >> 6), lane = tid & 63, wr = wid >> 2, wc = wid & 3, fr = lane & 15, fq = lane >> 4;
    const int K = g.K, nt = K / BK;
    unsigned voffA[2], voffB[2];
#pragma unroll
    for (int i = 0; i < 2; ++i) { int R, C; stage_rc(tid * 16 + i * 8192, R, C); const int Rb = Epi::PERM ? ((R & ~31) + perm32(R & 31)) : R;
        const int Ra = g.aperm ? ((R & ~63) + 4 * (R & 15) + ((R >> 4) & 3)) : R;
        voffA[i] = (unsigned)(Ra * g.lda + C) * 2u; voffB[i] = (unsigned)(Rb * g.ldb + C) * 2u; }
    const __amdgpu_buffer_rsrc_t srdA = __builtin_amdgcn_make_buffer_rsrc((void*)g.A, 0, -1, 0x00020000), srdB = __builtin_amdgcn_make_buffer_rsrc((void*)g.Bt, 0, -1, 0x00020000);
    const unsigned kstep = (unsigned)(BK * 2);
    const unsigned hsA = (unsigned)HALF * g.lda * 2, hsB = (unsigned)g.hsb * g.ldb * 2;
    const unsigned tsA = 2 * hsA, tsB = (unsigned)g.tsb * g.ldb * 2;
    const unsigned ldsw = (unsigned)wid * 1024u;
    const int aoff = lds_byte(wr * 64 + fr, fq * 8), boff = lds_byte(wc * 32 + fr, fq * 8);
#define PG8_SA(b, h) (((b) * 2 + (h)) * HTB)
#define PG8_SB(b, h) ((4 + (b) * 2 + (h)) * HTB)
#define PG8_SRD_voffA srdA
#define PG8_SRD_voffB srdB
#define PG8_STAGE(bufoff, soff, voff) do { _Pragma("unroll") for (int _i = 0; _i < 2; ++_i) \
        __builtin_amdgcn_raw_ptr_buffer_load_lds(PG8_SRD_##voff, (PG8_LAS void*)(lds + (bufoff) + ldsw + _i * 8192), 16, (voff)[_i], (soff), 0, 0); } while (0)
#define PG8_LDA(dst, b, h) do { _Pragma("unroll") for (int m = 0; m < 4; ++m) _Pragma("unroll") for (int k = 0; k < 2; ++k) dst[m][k] = *(const PG8_LAS bf16x8*)(lds + PG8_SA(b, h) + aoff + m * 2048 + k * 1024); } while (0)
#define PG8_LDB(dst, b, h) do { _Pragma("unroll") for (int n = 0; n < 2; ++n) _Pragma("unroll") for (int k = 0; k < 2; ++k) dst[n][k] = *(const PG8_LAS bf16x8*)(lds + PG8_SB(b, h) + boff + n * 2048 + k * 1024); } while (0)
#define PG8_MMA(ai, bj, At, Bt) do { __builtin_amdgcn_s_setprio(1); _Pragma("unroll") for (int m = 0; m < 4; ++m) _Pragma("unroll") for (int n = 0; n < 2; ++n) _Pragma("unroll") for (int k = 0; k < 2; ++k) \
        acc[ai][bj][m][n] = __builtin_amdgcn_mfma_f32_16x16x32_bf16(Bt[n][k], At[m][k], acc[ai][bj][m][n], 0, 0, 0); __builtin_amdgcn_s_setprio(0); } while (0)
#define PG8_WAIT_V(n) asm volatile("s_waitcnt vmcnt(" #n ")" ::: "memory")
#define PG8_WAIT_L(n) asm volatile("s_waitcnt lgkmcnt(" #n ")" ::: "memory")
#define PG8_BAR __builtin_amdgcn_s_barrier()
#define PG8_SCHED __builtin_amdgcn_sched_barrier(0)
    Unit cur, nxt; int ui = 0;
    if (!S.next(0, cur)) return;
    f32x4 acc[2][2][4][2];
#pragma unroll
    for (int a = 0; a < 2; ++a)
#pragma unroll
        for (int b = 0; b < 2; ++b)
#pragma unroll
            for (int m = 0; m < 4; ++m)
#pragma unroll
                for (int n = 0; n < 2; ++n) acc[a][b][m][n] = (f32x4){0.f, 0.f, 0.f, 0.f};
    bf16x8 At[4][2], B0[2][2], B1[2][2];
    unsigned cA = (unsigned)cur.pm * tsA, cB = (unsigned)cur.pn * tsB;
    S.a_ready(cur);
    if constexpr (SP2) {
        PG8_STAGE(PG8_SB(0, 0), cB, voffB); PG8_STAGE(PG8_SB(0, 1), cB + hsB, voffB); PG8_STAGE(PG8_SA(0, 0), cA, voffA); PG8_STAGE(PG8_SA(0, 1), cA + hsA, voffA);
        if (wr == 1) PG8_BAR;
        PG8_WAIT_V(2); PG8_BAR;
        PG8_STAGE(PG8_SB(1, 0), cB + kstep, voffB); PG8_STAGE(PG8_SA(1, 0), cA + kstep, voffA); PG8_STAGE(PG8_SB(1, 1), cB + hsB + kstep, voffB);
        PG8_WAIT_V(6); PG8_BAR;
    } else {
        PG8_STAGE(PG8_SB(0, 0), cB, voffB); PG8_STAGE(PG8_SA(0, 0), cA, voffA); PG8_STAGE(PG8_SB(0, 1), cB + hsB, voffB); PG8_STAGE(PG8_SA(0, 1), cA + hsA, voffA);
        if (wr == 1) PG8_BAR;
        PG8_WAIT_V(4); PG8_BAR;
        PG8_STAGE(PG8_SB(1, 0), cB + kstep, voffB); PG8_STAGE(PG8_SA(1, 0), cA + kstep, voffA); PG8_STAGE(PG8_SB(1, 1), cB + hsB + kstep, voffB);
        PG8_WAIT_V(6); PG8_BAR;
    }
    for (;;) {
        const bool has_next = S.next(ui + 1, nxt);
        const unsigned nA = has_next ? (unsigned)nxt.pm * tsA : cA, nB = has_next ? (unsigned)nxt.pn * tsB : cB;
        for (int t = 0; t < nt; t += 2) {
            const bool last = (t == nt - 2);
            const unsigned a1 = cA + (unsigned)(t + 1) * kstep;
            const unsigned a2 = last ? nA : cA + (unsigned)(t + 2) * kstep, b2 = last ? nB : cB + (unsigned)(t + 2) * kstep;
            const unsigned a3 = a2 + kstep, b3 = b2 + kstep;
            if (last && has_next) S.a_ready(nxt);
            if constexpr (SP2) {
            PG8_LDB(B0, 0, 0); PG8_LDB(B1, 0, 1); PG8_SCHED; PG8_LDA(At, 0, 0); PG8_STAGE(PG8_SA(1, 1), a1 + hsA, voffA);
            PG8_WAIT_V(8); PG8_WAIT_L(0); PG8_BAR; PG8_MMA(0, 0, At, B0); PG8_MMA(0, 1, At, B1); PG8_BAR; PG8_SCHED;
            PG8_LDA(At, 0, 1); PG8_STAGE(PG8_SB(0, 0), b2, voffB); PG8_STAGE(PG8_SB(0, 1), b2 + hsB, voffB); PG8_STAGE(PG8_SA(0, 0), a2, voffA);
            PG8_WAIT_V(8); PG8_WAIT_L(0); PG8_BAR; PG8_MMA(1, 0, At, B0); PG8_MMA(1, 1, At, B1); PG8_BAR; PG8_SCHED;
            PG8_LDB(B0, 1, 0); PG8_LDB(B1, 1, 1); PG8_SCHED; PG8_LDA(At, 1, 0); PG8_STAGE(PG8_SA(0, 1), a2 + hsA, voffA);
            PG8_WAIT_V(8); PG8_WAIT_L(0); PG8_BAR; PG8_MMA(0, 0, At, B0); PG8_MMA(0, 1, At, B1); PG8_BAR; PG8_SCHED;
            PG8_LDA(At, 1, 1); PG8_STAGE(PG8_SB(1, 0), b3, voffB); PG8_STAGE(PG8_SB(1, 1), b3 + hsB, voffB); PG8_STAGE(PG8_SA(1, 0), a3, voffA);
            PG8_WAIT_V(8); PG8_WAIT_L(0); PG8_BAR; PG8_MMA(1, 0, At, B0); PG8_MMA(1, 1, At, B1); PG8_BAR; PG8_SCHED;
            } else {
            PG8_LDB(B0, 0, 0); PG8_SCHED; PG8_LDA(At, 0, 0); PG8_STAGE(PG8_SA(1, 1), a1 + hsA, voffA);
            PG8_WAIT_L(8); PG8_BAR; PG8_WAIT_L(0); PG8_MMA(0, 0, At, B0); PG8_BAR; PG8_SCHED;
            PG8_LDB(B1, 0, 1); PG8_STAGE(PG8_SB(0, 0), b2, voffB);
            PG8_BAR; PG8_WAIT_L(0); PG8_MMA(0, 1, At, B1); PG8_BAR;
            PG8_LDA(At, 0, 1); PG8_STAGE(PG8_SA(0, 0), a2, voffA);
            PG8_BAR; PG8_WAIT_L(0); PG8_MMA(1, 0, At, B0); PG8_BAR; PG8_SCHED;
            PG8_STAGE(PG8_SB(0, 1), b2 + hsB, voffB);
            PG8_WAIT_V(6); PG8_BAR; PG8_MMA(1, 1, At, B1); PG8_BAR;
            PG8_LDB(B0, 1, 0); PG8_SCHED; PG8_LDA(At, 1, 0); PG8_STAGE(PG8_SA(0, 1), a2 + hsA, voffA);
            PG8_WAIT_L(8); PG8_BAR; PG8_WAIT_L(0); PG8_MMA(0, 0, At, B0); PG8_BAR; PG8_SCHED;
            PG8_LDB(B1, 1, 1); PG8_STAGE(PG8_SB(1, 0), b3, voffB);
            PG8_BAR; PG8_WAIT_L(0); PG8_MMA(0, 1, At, B1); PG8_BAR;
            PG8_LDA(At, 1, 1); PG8_STAGE(PG8_SA(1, 0), a3, voffA);
            PG8_BAR; PG8_WAIT_L(0); PG8_MMA(1, 0, At, B0); PG8_BAR; PG8_SCHED;
            PG8_STAGE(PG8_SB(1, 1), b3 + hsB, voffB);
            PG8_WAIT_V(6); PG8_BAR; PG8_MMA(1, 1, At, B1); PG8_BAR;
            }
        }
        if constexpr (ALIGN_EPI) { if (wr == 0) PG8_BAR; }
        if constexpr (!Epi::AFTER_DRAIN) { E(acc, cur, wr, wc, fr, fq); S.done(cur); }
        if (!has_next) break;
#pragma unroll
        for (int a = 0; a < 2; ++a)
#pragma unroll
            for (int b = 0; b < 2; ++b)
#pragma unroll
                for (int m = 0; m < 4; ++m)
#pragma unroll
                    for (int n = 0; n < 2; ++n) acc[a][b][m][n] = (f32x4){0.f, 0.f, 0.f, 0.f};
        cur = nxt; cA = nA; cB = nB; ++ui;
        if constexpr (ALIGN_EPI) { if (wr == 1) PG8_BAR; }
    }
    PG8_WAIT_V(0);
    if constexpr (!ALIGN_EPI) { if (wr == 0) PG8_BAR; }
    PG8_BAR;
    if constexpr (Epi::AFTER_DRAIN) { E.fused(acc, cur, wr, wc, fr, fq, lds, wid, lane); S.done(cur); }
#undef PG8_SA
#undef PG8_SB
#undef PG8_STAGE
#undef PG8_SRD_voffA
#undef PG8_SRD_voffB
#undef PG8_LDA
#undef PG8_LDB
#undef PG8_MMA
#undef PG8_WAIT_V
#undef PG8_WAIT_L
#undef PG8_BAR
#undef PG8_SCHED
}
}
#define GAS __attribute__((address_space(1)))
#define LAS __attribute__((address_space(3)))
typedef unsigned short bf16;
typedef unsigned v4u __attribute__((ext_vector_type(4)));
typedef float f32x4 __attribute__((ext_vector_type(4)));
typedef short bf16x8 __attribute__((ext_vector_type(8)));
typedef GAS unsigned gu32;
typedef GAS unsigned long long gu64;
#define RLX_AGENT __ATOMIC_RELAXED, __HIP_MEMORY_SCOPE_AGENT
#define LDS_WAIT() asm volatile("s_waitcnt lgkmcnt(0)" ::: "memory")
#define VM_WAIT() asm volatile("s_waitcnt vmcnt(0)" ::: "memory")
__device__ __forceinline__ unsigned long long rt() { return __builtin_amdgcn_s_memrealtime(); }
__device__ __forceinline__ unsigned f2bf(float f) { unsigned u = __builtin_bit_cast(unsigned, f); return (u + 0x7fffu + ((u >> 16) & 1u)) >> 16; }
__device__ __forceinline__ unsigned pk2(float lo, float hi) { return f2bf(lo) | (f2bf(hi) << 16); }

#define XB_TMO      128
#define XB_XCNT(j)  (256  + 64 * (j))
#define XB_XSUB(j)  (1280 + 64 * (j))
#define XB_XGEN(j)  (2304 + 64 * (j))
#define XB_TOP      3328
#define XB_TOPGEN   3392
#define XCD_BAR_WORDS 3456
#define XB_SPIN_CAP (1u << 18)

__device__ __forceinline__ unsigned xb_ld(unsigned* p)              { return __hip_atomic_load(p, __ATOMIC_RELAXED, __HIP_MEMORY_SCOPE_AGENT); }
__device__ __forceinline__ unsigned xb_add(unsigned* p, unsigned v) { return __hip_atomic_fetch_add(p, v, __ATOMIC_RELAXED, __HIP_MEMORY_SCOPE_AGENT); }
__device__ __forceinline__ unsigned xb_xcc_id() { return (unsigned)__builtin_amdgcn_s_getreg((3 << 11) | 20) & 0xFu; }
#define XB_SPIN(cond, bar) do { unsigned _sp = 0; while (cond) { __builtin_amdgcn_s_sleep(1); \
    if ((++_sp & 255u) == 0u) { if (xb_ld(&(bar)[XB_TMO])) break; if (_sp > XB_SPIN_CAP) { atomicAdd(&(bar)[XB_TMO], 1u); break; } } } } while (0)

struct XcdBarrier {
    unsigned* bar; unsigned x;
    volatile LAS unsigned* st;
};

__device__ __forceinline__ XcdBarrier xcd_barrier_post(unsigned* bar, volatile LAS unsigned* st, int tid) {
    XcdBarrier b; b.bar = bar; b.x = xb_xcc_id(); b.st = st;
    if (tid == 0) (void)xb_add(&bar[XB_XCNT(b.x)], 1u);
    return b;
}
__device__ __forceinline__ void xcd_barrier_complete(unsigned* bar, unsigned x, unsigned& nloc, unsigned& nx) {
    const unsigned G = gridDim.x * gridDim.y * gridDim.z;
    unsigned sum, cnt, mine, sp = 0u;
    for (;;) {
        sum = 0u; cnt = 0u; mine = 0u;
#pragma unroll
        for (unsigned j = 0; j < 16; ++j) { const unsigned c = xb_ld(&bar[XB_XCNT(j)]); sum += c; cnt += (c > 0u) ? 1u : 0u; mine = (j == x) ? c : mine; }
        if (sum == G) break;
        __builtin_amdgcn_s_sleep(1);
        if ((++sp & 255u) == 0u) { if (xb_ld(&bar[XB_TMO])) break; if (sp > XB_SPIN_CAP) { atomicAdd(&bar[XB_TMO], 1u); break; } }
    }
    nloc = mine > 0u ? mine : 1u; nx = cnt > 0u ? cnt : 1u;
}

__device__ __forceinline__ void xcd_barrier(const XcdBarrier& b, int tid) {
    asm volatile("s_waitcnt vmcnt(0)" ::: "memory");
    __syncthreads();
    if (tid == 0) {
        unsigned* bar = b.bar;
        __builtin_amdgcn_s_waitcnt(0);
        unsigned nloc = b.st[0], nx = b.st[1];
        if (nloc == 0u) { xcd_barrier_complete(bar, b.x, nloc, nx); b.st[0] = nloc; b.st[1] = nx; }
        const unsigned old = xb_add(&bar[XB_XSUB(b.x)], 1u);
        const unsigned gen = old / nloc;
        if (old + 1u == (gen + 1u) * nloc) {
            __builtin_amdgcn_fence(__ATOMIC_RELEASE, "agent");
            asm volatile("s_waitcnt vmcnt(0)" ::: "memory");
            const unsigned og = xb_add(&bar[XB_TOP], 1u);
            const unsigned tg = og / nx;
            if (og + 1u == (tg + 1u) * nx) xb_add(&bar[XB_TOPGEN], 1u);
            else XB_SPIN(xb_ld(&bar[XB_TOPGEN]) == tg, bar);
            __builtin_amdgcn_fence(__ATOMIC_ACQUIRE, "agent");
            xb_add(&bar[XB_XGEN(b.x)], 1u);
            asm volatile("s_waitcnt vmcnt(0)" ::: "memory");
        } else {
            XB_SPIN(xb_ld(&bar[XB_XGEN(b.x)]) == gen, bar);
            __builtin_amdgcn_fence(__ATOMIC_ACQUIRE, "agent");
            asm volatile("s_waitcnt vmcnt(0)" ::: "memory");
        }
    }
    __syncthreads();
}

constexpr int NWAVES = 8, NTHREADS = 512;
constexpr int BATCH = 8, SEQ = 2048, DM = 2048, M = BATCH * SEQ;
constexpr int INW = 3904, INWP = 4096;
constexpr int QW = 1536, KVW = 2048, FF = 5632, FF2 = 11264, NMOD = 12288;
constexpr int C_QLAT = 0, C_KVLAT = 512, C_KROPE = 768, C_DQ = 832, C_DK = 1856, C_DV = 2880;
constexpr int MOD_SHA = 0, MOD_SCA = 2048, MOD_GA = 4096, MOD_SHF = 6144, MOD_SCF = 8192, MOD_GF = 10240;
constexpr float EPS = 1e-6f, MLA_SCALE = 0.07216878364870322f, DIFF_SCALE = 0.125f, LAMBDA_INIT = 0.2f;
constexpr int UCH = 4096, NUCH = M / UCH;

constexpr size_t MiB = 1u << 20;
constexpr size_t WS_CTL = 0, CTL_ZERO_BYTES = 1 * MiB, WS_MOD = 512 * 1024, WS_SSQQ = 128 * 1024, WS_SSQKV = 192 * 1024;
constexpr int TKF_OFF = 1024;
constexpr size_t WS_COS = 2 * MiB, WS_SIN = 4 * MiB, WS_TK = 6 * MiB;
constexpr size_t WS_WIN = 8 * MiB, WS_WUQ = 24 * MiB, WS_WUKV = 26 * MiB, WS_WO = 28 * MiB, WS_WUP = 36 * MiB, WS_WDN = 80 * MiB;
constexpr size_t WS_H = 104 * MiB;
constexpr size_t WS_PROJ = 168 * MiB, WS_Q = 296 * MiB, WS_KV = 344 * MiB, WS_AO = 408 * MiB;
constexpr size_t WS_Y = 168 * MiB;
constexpr size_t WS_G = 168 * MiB;
constexpr size_t WS_E = 344 * MiB;
constexpr size_t WS_Y2 = 344 * MiB;
constexpr size_t WS_X1 = 408 * MiB;
constexpr size_t WS_END = 512 * MiB;
constexpr int CW_TMO = 0, CW_CODE = 1, CW_BAR = 4096;

constexpr int LDS_BYTES = 147456;
constexpr int LDSCTL_OFF = LDS_BYTES - 512, MISC_OFF = LDSCTL_OFF;

__device__ __forceinline__ float bf2f(unsigned short u) { return __uint_as_float((unsigned)u << 16); }
__device__ __forceinline__ float bflo(unsigned w) { return __uint_as_float(w << 16); }
__device__ __forceinline__ float bfhi(unsigned w) { return __uint_as_float(w & 0xffff0000u); }
__device__ __forceinline__ float wave_sum(float v) {
#pragma unroll
    for (int o = 1; o < 64; o <<= 1) v += __shfl_xor(v, o);
    return v;
}
__device__ __forceinline__ float wave_max(float v) {
#pragma unroll
    for (int o = 1; o < 64; o <<= 1) v = fmaxf(v, __shfl_xor(v, o));
    return v;
}
__device__ __forceinline__ int t5_bucket(int rel) {
    const int ret = rel > 0 ? 16 : 0; const int n = rel < 0 ? -rel : rel; const float nf = (float)(n > 1 ? n : 1);
    int large = 8 + (int)(logf(nf / 8.0f) / 2.772588722239781f * 8.0f);
    large = large < 15 ? large : 15;
    return ret + (n < 8 ? n : large);
}
__device__ __forceinline__ float gelu_tanh(float x) {
    const float z2 = 1.5957691216057308f * (x + 0.044715f * x * x * x);
    return x / (1.0f + __expf(-z2));
}


constexpr int PTR_OFF = LDSCTL_OFF + 128;
enum { P_X = 0, P_C, P_POS, P_RELB, P_ADAW, P_ADAB, P_APRE, P_APOST, P_WIN, P_QN, P_WUQ, P_KVN, P_WUKV, P_LQ1, P_LK1, P_LQ2, P_LK2, P_SUBLN, P_WO, P_FPRE, P_FPOST, P_WUP, P_CW, P_CB, P_WDN, P_OUT, P_WS };
__device__ __forceinline__ const void* ldptr(LAS unsigned char* lds, int i) {
    const unsigned long long v = *(volatile LAS unsigned long long*)(lds + PTR_OFF + 8 * i);
    const unsigned lo = __builtin_amdgcn_readfirstlane((unsigned)v), hi = __builtin_amdgcn_readfirstlane((unsigned)(v >> 32));
    return (const void*)(GAS const void*)(((unsigned long long)hi << 32) | lo);
}
#define LPF(i) ((const float*)ldptr(lds, (i)))
#define LPWS() ((unsigned char*)ldptr(lds, P_WS))

__device__ __forceinline__ int dst_row(int s, int map) {
    if (map == 1) { if (s >= C_KROPE && s < C_KROPE + 64) { const int d = s - C_KROPE; return C_KROPE + 2 * (d & 31) + (d >> 5); } return s; }
    if (map == 2) { const int h = s / 192, d = s % 192; if (d >= 128) return h * 192 + 128 + 2 * ((d - 128) & 31) + ((d - 128) >> 5); return s; }
    return s;
}
__device__ __forceinline__ void p0_transpose_item(const float* W, const float* sv, int K, int N, bf16* WT, LAS float* scr, int item, int lane, int map) {
    const int nblk = N / 64, kb = item / nblk, nb = item % nblk, k0 = 64 * kb, n0 = 64 * nb;
    const int lr = lane >> 4, lc = (lane & 15) * 4;
    f32x4 v[16];
#pragma unroll
    for (int i = 0; i < 16; ++i) v[i] = __builtin_nontemporal_load((const f32x4*)(W + (size_t)(k0 + 4 * i + lr) * N + n0 + lc));
#pragma unroll
    for (int i = 0; i < 16; ++i) { const int kk = 4 * i + lr; f32x4 w = v[i]; if (sv) w = w * sv[k0 + kk];
        LAS float* d = scr + kk * 65 + lc; d[0] = w[0]; d[1] = w[1]; d[2] = w[2]; d[3] = w[3]; }
    LDS_WAIT(); asm volatile("" ::: "memory");
    const int c = lane & 7;
#pragma unroll
    for (int j = 0; j < 8; ++j) { const int n = (lane >> 3) + 8 * j; const LAS float* s = scr + (8 * c) * 65 + n;
        v4u o; o.x = pk2(s[0 * 65], s[1 * 65]); o.y = pk2(s[2 * 65], s[3 * 65]); o.z = pk2(s[4 * 65], s[5 * 65]); o.w = pk2(s[6 * 65], s[7 * 65]);
        __builtin_nontemporal_store(o, (GAS v4u*)(WT + (size_t)dst_row(n0 + n, map) * K + k0 + 8 * c)); }
    LDS_WAIT(); asm volatile("" ::: "memory");
}
__device__ __forceinline__ void p0_prologue(LAS unsigned char* lds, int tid, int lane, int wave, int G, int bid) {
    { unsigned char* ws = LPWS(); float* mod = (float*)(ws + WS_MOD); const float* in_c = LPF(P_C); const float* in_adaw = LPF(P_ADAW); const float* in_adab = LPF(P_ADAB);
    for (int item = bid; item < 256; item += G) {
        const int kc = item >> 5, cc = item & 31;
        LAS float* scl = (LAS float*)lds;
        LAS float* red = (LAS float*)(lds + 8192);
        for (int e = tid; e < 2048; e += NTHREADS) { const int b = e >> 8, i = e & 255; const float cv = in_c[b * DM + 256 * kc + i]; scl[e] = cv / (1.0f + __expf(-cv)); }
        __syncthreads();
        if (tid < 384) {
            const int kg = tid / 96, ct = tid % 96;
            f32x4 acc[8];
#pragma unroll
            for (int b = 0; b < 8; ++b) acc[b] = (f32x4){0.f, 0.f, 0.f, 0.f};
            const float* wp = in_adaw + (size_t)(256 * kc + 64 * kg) * NMOD + 384 * cc + 4 * ct;
#pragma unroll 8
            for (int kk = 0; kk < 64; ++kk) {
                const f32x4 w = __builtin_nontemporal_load((const f32x4*)(wp + (size_t)kk * NMOD));
#pragma unroll
                for (int b = 0; b < 8; ++b) acc[b] += w * scl[b * 256 + 64 * kg + kk];
            }
#pragma unroll
            for (int b = 0; b < 8; ++b) *(LAS f32x4*)(red + (kg * 8 + b) * 384 + 4 * ct) = acc[b];
        }
        __syncthreads();
        for (int o = tid; o < 3072; o += NTHREADS) { const int b = o / 384, col = o % 384;
            float v = (red[(0 * 8 + b) * 384 + col] + red[(1 * 8 + b) * 384 + col]) + (red[(2 * 8 + b) * 384 + col] + red[(3 * 8 + b) * 384 + col]);
            if (kc == 0) v += in_adab[384 * cc + col];
            atomicAdd(mod + b * NMOD + 384 * cc + col, v); }
        __syncthreads();
    } }
    unsigned char* ws = LPWS();
    LAS float* scr = (LAS float*)(lds + wave * 16640);
    const int gw = bid * NWAVES + wave, NGW = G * NWAVES;
    constexpr int I_IN = (DM / 64) * (INW / 64), I_UQ = (512 / 64) * (QW / 64), I_UKV = (256 / 64) * (KVW / 64), I_O = (DM / 64) * (DM / 64), I_UP = (DM / 64) * (FF2 / 64), I_DN = (FF / 64) * (DM / 64);
    const int NITEMS = (G == 256) ? I_IN + I_UQ + I_UKV : I_IN + I_UQ + I_UKV + I_O + I_UP + I_DN;
    for (int it = gw; it < NITEMS; it += NGW) {
        int r = it;
        if (r < I_IN) { p0_transpose_item(LPF(P_WIN), nullptr, DM, INW, (bf16*)(ws + WS_WIN), scr, r, lane, 1); continue; } r -= I_IN;
        if (r < I_UQ) { p0_transpose_item(LPF(P_WUQ), LPF(P_QN), 512, QW, (bf16*)(ws + WS_WUQ), scr, r, lane, 2); continue; } r -= I_UQ;
        if (r < I_UKV) { p0_transpose_item(LPF(P_WUKV), LPF(P_KVN), 256, KVW, (bf16*)(ws + WS_WUKV), scr, r, lane, 0); continue; } r -= I_UKV;
        if (r < I_O) { p0_transpose_item(LPF(P_WO), nullptr, DM, DM, (bf16*)(ws + WS_WO), scr, r, lane, 0); continue; } r -= I_O;
        if (r < I_UP) { p0_transpose_item(LPF(P_WUP), nullptr, DM, FF2, (bf16*)(ws + WS_WUP), scr, r, lane, 0); continue; } r -= I_UP;
        p0_transpose_item(LPF(P_WDN), nullptr, FF, DM, (bf16*)(ws + WS_WDN), scr, r, lane, 0);
    }
    { v4u* z = (v4u*)(ws + WS_WIN + (size_t)INW * DM * 2); const v4u zero = {0u, 0u, 0u, 0u};
      for (int i = bid * NTHREADS + tid; i < (INWP - INW) * DM * 2 / 16; i += G * NTHREADS) z[i] = zero; }
    { float* COS = (float*)(ws + WS_COS); float* SIN = (float*)(ws + WS_SIN); const int* in_pos = (const int*)ldptr(lds, P_POS);
      for (int idx = bid * NTHREADS + tid; idx < M * 32; idx += G * NTHREADS) {
          const int m = idx >> 5, i = idx & 31;
          const float inv = 1.0f / exp2f((float)i * (13.287712379549449f / 32.0f));
          const float ang = (float)in_pos[m] * inv;
          double t = (double)ang * 0.15915494309189535; t -= rint(t);
          const float tf = (float)t;
          COS[idx] = __builtin_amdgcn_cosf(tf); SIN[idx] = __builtin_amdgcn_sinf(tf); } }
    { int* TK = (int*)(ws + WS_TK); const int* in_pos = (const int*)ldptr(lds, P_POS);
      for (int it = gw; it < BATCH * (SEQ / 64); it += NGW) { const int p = in_pos[it * 64 + lane]; int mn = p, mx = p;
#pragma unroll
          for (int of = 1; of < 64; of <<= 1) { mn = min(mn, __shfl_xor(mn, of)); mx = max(mx, __shfl_xor(mx, of)); }
          const bool cont = __all(p - lane == __builtin_amdgcn_readfirstlane(p));
          if (lane == 0) { TK[2 * it] = mn; TK[2 * it + 1] = mx; TK[TKF_OFF + it] = cont ? 1 : 0; } } }
}

__device__ __forceinline__ void prenorm_phase(const float* x, const float* wn, const float* mod, int off_sh, int off_sc, bf16* H, int lane, int wave, int G, int bid) {
    const int gw = bid * NWAVES + wave, NGW = G * NWAVES;
    const int rpw = M / NGW;
    if (rpw * NGW == M && rpw > 0 && (SEQ % rpw) == 0) {
        const int m0 = gw * rpw; const float* mb = mod + (size_t)(m0 >> 11) * NMOD;
        f32x4 cc[8], sh[8];
#pragma unroll
        for (int j = 0; j < 8; ++j) { const int col = (lane + 64 * j) * 4; cc[j] = *(const f32x4*)(wn + col) * (*(const f32x4*)(mb + off_sc + col) + 1.0f); sh[j] = *(const f32x4*)(mb + off_sh + col); }
        for (int r = 0; r < rpw; ++r) { const int m = m0 + r;
            const f32x4* xr = (const f32x4*)(x + (size_t)m * DM) + lane;
            f32x4 v[8]; float ss = 0.f;
#pragma unroll
            for (int j = 0; j < 8; ++j) { v[j] = __builtin_nontemporal_load(xr + 64 * j); ss += (v[j].x * v[j].x + v[j].y * v[j].y) + (v[j].z * v[j].z + v[j].w * v[j].w); }
            const float rstd = rsqrtf(wave_sum(ss) * (1.0f / DM) + EPS);
#pragma unroll
            for (int j = 0; j < 8; ++j) { const int col = (lane + 64 * j) * 4;
                const f32x4 o = v[j] * rstd * cc[j] + sh[j];
                uint2 pk; pk.x = pk2(o.x, o.y); pk.y = pk2(o.z, o.w);
                *(uint2*)(H + (size_t)m * DM + col) = pk; } }
        return;
    }
    for (int m = gw; m < M; m += NGW) {
        const f32x4* xr = (const f32x4*)(x + (size_t)m * DM) + lane;
        f32x4 v[8]; float ss = 0.f;
#pragma unroll
        for (int j = 0; j < 8; ++j) { v[j] = __builtin_nontemporal_load(xr + 64 * j); ss += (v[j].x * v[j].x + v[j].y * v[j].y) + (v[j].z * v[j].z + v[j].w * v[j].w); }
        const float rstd = rsqrtf(wave_sum(ss) * (1.0f / DM) + EPS);
        const float* mb = mod + (size_t)(m >> 11) * NMOD;
#pragma unroll
        for (int j = 0; j < 8; ++j) { const int col = (lane + 64 * j) * 4;
            const f32x4 w = *(const f32x4*)(wn + col), sh = *(const f32x4*)(mb + off_sh + col), sc = *(const f32x4*)(mb + off_sc + col);
            const f32x4 o = v[j] * rstd * w * (sc + 1.0f) + sh;
            uint2 pk; pk.x = pk2(o.x, o.y); pk.y = pk2(o.z, o.w);
            *(uint2*)(H + (size_t)m * DM + col) = pk; }
    }
}
template <bool NEXT>
__device__ __forceinline__ void post_phase(const bf16* Y, const void* xin_, void* xout_, const float* wpost, const float* mod, int off_g,
                                           const float* wn2, int off_sh, int off_sc, bf16* Hn, int lane, int wave, int G, int bid) {
    const int gw = bid * NWAVES + wave, NGW = G * NWAVES;
    const int rpw = M / NGW;
    if (rpw * NGW == M && rpw > 0 && (SEQ % rpw) == 0) {
        const int m0 = gw * rpw; const float* mb = mod + (size_t)(m0 >> 11) * NMOD;
        f32x4 gwv[8], c2[8], s2[8];
#pragma unroll
        for (int j = 0; j < 8; ++j) { const int col = (lane + 64 * j) * 4; gwv[j] = *(const f32x4*)(wpost + col) * *(const f32x4*)(mb + off_g + col);
            if constexpr (NEXT) { c2[j] = *(const f32x4*)(wn2 + col) * (*(const f32x4*)(mb + off_sc + col) + 1.0f); s2[j] = *(const f32x4*)(mb + off_sh + col); } }
        for (int r = 0; r < rpw; ++r) { const int m = m0 + r;
            const uint2* yr = (const uint2*)(Y + (size_t)m * DM) + lane;
            const f32x4* xr = (const f32x4*)((const float*)xin_ + (size_t)m * DM) + lane;
            const uint2* xb = (const uint2*)((const bf16*)xin_ + (size_t)m * DM) + lane;
            f32x4 v[8]; float ss = 0.f;
#pragma unroll
            for (int j = 0; j < 8; ++j) { const unsigned long long yq_ = __builtin_nontemporal_load((const unsigned long long*)(yr + 64 * j)); const unsigned y0 = (unsigned)yq_, y1 = (unsigned)(yq_ >> 32);
                v[j] = (f32x4){bflo(y0), bfhi(y0), bflo(y1), bfhi(y1)}; ss += (v[j].x * v[j].x + v[j].y * v[j].y) + (v[j].z * v[j].z + v[j].w * v[j].w); }
            const float rstd = rsqrtf(wave_sum(ss) * (1.0f / DM) + EPS);
            float ss2 = 0.f;
#pragma unroll
            for (int j = 0; j < 8; ++j) { const int col = (lane + 64 * j) * 4;
                f32x4 xv;
                if constexpr (NEXT) xv = __builtin_nontemporal_load(xr + 64 * j);
                else { const unsigned long long xq_ = __builtin_nontemporal_load((const unsigned long long*)(xb + 64 * j)); const unsigned x0 = (unsigned)xq_, x1 = (unsigned)(xq_ >> 32); xv = (f32x4){bflo(x0), bfhi(x0), bflo(x1), bfhi(x1)}; }
                const f32x4 o = xv + gwv[j] * (v[j] * rstd);
                v[j] = o; ss2 += (o.x * o.x + o.y * o.y) + (o.z * o.z + o.w * o.w);
                if constexpr (NEXT) { uint2 pk; pk.x = pk2(o.x, o.y); pk.y = pk2(o.z, o.w); *(uint2*)((bf16*)xout_ + (size_t)m * DM + col) = pk; }
                else *(f32x4*)((float*)xout_ + (size_t)m * DM + col) = o; }
            if constexpr (NEXT) {
                const float rstd2 = rsqrtf(wave_sum(ss2) * (1.0f / DM) + EPS);
#pragma unroll
                for (int j = 0; j < 8; ++j) { const int col = (lane + 64 * j) * 4;
                    const f32x4 o = v[j] * rstd2 * c2[j] + s2[j];
                    uint2 pk; pk.x = pk2(o.x, o.y); pk.y = pk2(o.z, o.w);
                    *(uint2*)(Hn + (size_t)m * DM + col) = pk; }
            } }
        return;
    }
    for (int m = gw; m < M; m += NGW) {
        const uint2* yr = (const uint2*)(Y + (size_t)m * DM) + lane;
        const f32x4* xr = (const f32x4*)((const float*)xin_ + (size_t)m * DM) + lane;
        const uint2* xb = (const uint2*)((const bf16*)xin_ + (size_t)m * DM) + lane;
        f32x4 v[8]; float ss = 0.f;
#pragma unroll
        for (int j = 0; j < 8; ++j) { const unsigned long long yq_ = __builtin_nontemporal_load((const unsigned long long*)(yr + 64 * j)); uint2 yw; yw.x = (unsigned)yq_; yw.y = (unsigned)(yq_ >> 32); v[j] = (f32x4){bflo(yw.x), bfhi(yw.x), bflo(yw.y), bfhi(yw.y)}; ss += (v[j].x * v[j].x + v[j].y * v[j].y) + (v[j].z * v[j].z + v[j].w * v[j].w); }
        const float rstd = rsqrtf(wave_sum(ss) * (1.0f / DM) + EPS);
        const float* mb = mod + (size_t)(m >> 11) * NMOD;
        float ss2 = 0.f;
#pragma unroll
        for (int j = 0; j < 8; ++j) { const int col = (lane + 64 * j) * 4;
            const f32x4 w = *(const f32x4*)(wpost + col), g = *(const f32x4*)(mb + off_g + col);
            f32x4 xv;
            if constexpr (NEXT) xv = __builtin_nontemporal_load(xr + 64 * j);
            else { const unsigned long long xq_ = __builtin_nontemporal_load((const unsigned long long*)(xb + 64 * j)); const unsigned x0 = (unsigned)xq_, x1 = (unsigned)(xq_ >> 32); xv = (f32x4){bflo(x0), bfhi(x0), bflo(x1), bfhi(x1)}; }
            const f32x4 o = xv + g * (v[j] * rstd * w);
            v[j] = o; ss2 += (o.x * o.x + o.y * o.y) + (o.z * o.z + o.w * o.w);
            if constexpr (NEXT) { uint2 pk; pk.x = pk2(o.x, o.y); pk.y = pk2(o.z, o.w); *(uint2*)((bf16*)xout_ + (size_t)m * DM + col) = pk; }
            else *(f32x4*)((float*)xout_ + (size_t)m * DM + col) = o; }
        if (NEXT) {
            const float rstd2 = rsqrtf(wave_sum(ss2) * (1.0f / DM) + EPS);
#pragma unroll
            for (int j = 0; j < 8; ++j) { const int col = (lane + 64 * j) * 4;
                const f32x4 w = *(const f32x4*)(wn2 + col), sh = *(const f32x4*)(mb + off_sh + col), sc = *(const f32x4*)(mb + off_sc + col);
                const f32x4 o = v[j] * rstd2 * w * (sc + 1.0f) + sh;
                uint2 pk; pk.x = pk2(o.x, o.y); pk.y = pk2(o.z, o.w);
                *(uint2*)(Hn + (size_t)m * DM + col) = pk; }
        }
    }
}
__device__ __forceinline__ void fixup_phase(const bf16* E, bf16* Gb, const float* cw, const float* cb, int tid, int G, int bid) {
    constexpr int NPN = FF / 128;
    for (int idx = bid * NTHREADS + tid; idx < 256 * NPN * 16; idx += G * NTHREADS) {
        const int g = idx / (NPN * 16), rem = idx % (NPN * 16), pn = rem >> 4, fl = (rem & 15) * 8;
        if ((g & 31) == 0) continue;
        const bf16* ea = E + ((size_t)(pn * 256 + g - 1) * 4 + 2) * 256 + fl; const bf16* ec = E + ((size_t)(pn * 256 + g) * 4) * 256 + fl;
        const v4u ga = *(const v4u*)ea, gbv = *(const v4u*)(ea + 256), gc = *(const v4u*)ec, gd = *(const v4u*)(ec + 256);
        const v4u va = *(const v4u*)(ea + 128), vbv = *(const v4u*)(ea + 256 + 128), vc = *(const v4u*)(ec + 128), vd = *(const v4u*)(ec + 256 + 128);
        const int f8 = pn * 128 + fl;
        f32x4 pw[8][2];
#pragma unroll
        for (int hq = 0; hq < 2; ++hq) { const int fo = f8 + 4 * hq;
            pw[0][hq] = *(const f32x4*)(cw + fo); pw[1][hq] = *(const f32x4*)(cw + FF2 + fo); pw[2][hq] = *(const f32x4*)(cw + 2 * FF2 + fo); pw[3][hq] = *(const f32x4*)(cb + fo);
            pw[4][hq] = *(const f32x4*)(cw + FF + fo); pw[5][hq] = *(const f32x4*)(cw + FF2 + FF + fo); pw[6][hq] = *(const f32x4*)(cw + 2 * FF2 + FF + fo); pw[7][hq] = *(const f32x4*)(cb + FF + fo); }
        unsigned o0[4], o1[4];
#pragma unroll
        for (int q = 0; q < 4; ++q) {
            float r0[2], r1[2];
#pragma unroll
            for (int hh = 0; hh < 2; ++hh) { const int e = 2 * q + hh, eh = e >> 2, ec4 = e & 3;
                const float a = hh ? bfhi(ga[q]) : bflo(ga[q]), b = hh ? bfhi(gbv[q]) : bflo(gbv[q]), c = hh ? bfhi(gc[q]) : bflo(gc[q]), d = hh ? bfhi(gd[q]) : bflo(gd[q]);
                const float xa = hh ? bfhi(va[q]) : bflo(va[q]), xb = hh ? bfhi(vbv[q]) : bflo(vbv[q]), xc = hh ? bfhi(vc[q]) : bflo(vc[q]), xd = hh ? bfhi(vd[q]) : bflo(vd[q]);
                const float w0 = pw[0][eh][ec4], w1 = pw[1][eh][ec4], w2 = pw[2][eh][ec4], wb = pw[3][eh][ec4], y0 = pw[4][eh][ec4], y1 = pw[5][eh][ec4], y2 = pw[6][eh][ec4], yb = pw[7][eh][ec4];
                r0[hh] = gelu_tanh(wb + w0 * a + w1 * b + w2 * c) * (yb + y0 * xa + y1 * xb + y2 * xc);
                r1[hh] = gelu_tanh(wb + w0 * b + w1 * c + w2 * d) * (yb + y0 * xb + y1 * xc + y2 * xd); }
            o0[q] = pk2(r0[0], r0[1]); o1[q] = pk2(r1[0], r1[1]); }
        const v4u w0 = {o0[0], o0[1], o0[2], o0[3]}, w1 = {o1[0], o1[1], o1[2], o1[3]};
        *(v4u*)(Gb + (size_t)(64 * g - 1) * FF + pn * 128 + fl) = w0; *(v4u*)(Gb + (size_t)(64 * g) * FF + pn * 128 + fl) = w1;
    }
}


namespace att {
typedef short bf16x8 __attribute__((ext_vector_type(8)));
typedef short s16x4 __attribute__((ext_vector_type(4)));
typedef float f32x16 __attribute__((ext_vector_type(16)));
typedef unsigned u32x4 __attribute__((ext_vector_type(4)));
typedef LAS char* lptr;
#define KSWZ(row, colB) ((row) * 256 + ((colB) ^ (((row) & 7) << 4)))
#define KRSWZ(row, colB) ((row) * 128 + ((colB) ^ ((((row) >> 1) & 7) << 4)))
#define SBAR() __builtin_amdgcn_sched_barrier(0)
constexpr int QBLK = 32, KVBLK = 64, SHM_V = KVBLK * 128 * 2, SHM_K = KVBLK * 128 * 2, SHM_KR = KVBLK * 64 * 2;
constexpr float LOG2E = 1.4426950408889634f;
constexpr float THRL = 8.0f * LOG2E;
__device__ __forceinline__ int crow(int r, int hi) { return (r & 3) + 8 * (r >> 2) + 4 * hi; }
__device__ __forceinline__ unsigned cvtpk(float lo, float hi) { unsigned r; asm volatile("v_cvt_pk_bf16_f32 %0, %1, %2" : "=v"(r) : "v"(lo), "v"(hi)); return r; }
__device__ __forceinline__ bf16x8 ld8(const bf16* p) { return *reinterpret_cast<const bf16x8*>(p); }

template <bool EXPALL = false>
__device__ __forceinline__ void partialSM(f32x16& p0, f32x16& p1, float C, float bl, float& m_reg, float& alpha) {
    float pmax = p0[0];
#pragma unroll
    for (int r = 1; r < 16; ++r) pmax = fmaxf(pmax, p0[r]);
#pragma unroll
    for (int r = 0; r < 16; ++r) pmax = fmaxf(pmax, p1[r]);
    { auto rr = __builtin_amdgcn_permlane32_swap(__float_as_uint(pmax), __float_as_uint(pmax), false, false);
      pmax = fmaxf(__uint_as_float(rr[0]), __uint_as_float(rr[1])); }
    const float tmax = fmaf(pmax, C, bl);
    float mn;
    if (__builtin_expect(__all(tmax - m_reg <= THRL), 1)) { mn = m_reg; alpha = 1.f; }
    else { mn = fmaxf(m_reg, tmax); alpha = __builtin_amdgcn_exp2f(m_reg - mn); m_reg = mn; }
    const float off = bl - mn;
#pragma unroll
    for (int r = 0; r < 16; ++r) p0[r] = fmaf(p0[r], C, off);
#pragma unroll
    for (int r = 0; r < 16; ++r) p1[r] = fmaf(p1[r], C, off);
#pragma unroll
    for (int r = 0; r < 16; ++r) p0[r] = __builtin_amdgcn_exp2f(p0[r]);
    if (EXPALL) {
#pragma unroll
        for (int r = 0; r < 16; ++r) p1[r] = __builtin_amdgcn_exp2f(p1[r]); }
}
__device__ __forceinline__ void lut_adjust(f32x16& p0, f32x16& p1, const LAS float* lutx, const LAS int* kp, int qp, int hi) {
#pragma unroll
    for (int r = 0; r < 16; ++r) { const int key = crow(r, hi);
        int d0 = kp[key] - qp, d1 = kp[key + 32] - qp;
        d0 = d0 < -128 ? -128 : (d0 > 128 ? 128 : d0); d1 = d1 < -128 ? -128 : (d1 > 128 ? 128 : d1);
        p0[r] += lutx[d0 + 256]; p1[r] += lutx[d1 + 256]; }
}
__device__ __forceinline__ void lut_adjust_fast(f32x16& p0, f32x16& p1, const LAS float* lutx, int kp0, int qp, int hi) {
    const LAS float* bp = lutx + (kp0 - qp + 256 + 4 * hi);
#pragma unroll
    for (int r = 0; r < 16; ++r) { const int off = (r & 3) + 8 * (r >> 2); p0[r] += bp[off]; p1[r] += bp[off + 32]; }
}
template <bool EXPDONE = false>
__device__ __forceinline__ void finishSM(f32x16& p0, f32x16& p1, float alpha, float& l_reg, bf16x8& pa0, bf16x8& pa1, bf16x8& pa2, bf16x8& pa3) {
    if (!EXPDONE) {
#pragma unroll
        for (int r = 0; r < 16; ++r) p1[r] = __builtin_amdgcn_exp2f(p1[r]); }
    float ps = 0;
#pragma unroll
    for (int r = 0; r < 16; ++r) ps += p0[r];
#pragma unroll
    for (int r = 0; r < 16; ++r) ps += p1[r];
    { auto rr = __builtin_amdgcn_permlane32_swap(__float_as_uint(ps), __float_as_uint(ps), false, false);
      ps = __uint_as_float(rr[0]) + __uint_as_float(rr[1]); }
    l_reg = l_reg * alpha + ps;
#define PK4(P, BASE, OUT) do { u32x4 w = {cvtpk(P[BASE + 0], P[BASE + 1]), cvtpk(P[BASE + 2], P[BASE + 3]), cvtpk(P[BASE + 4], P[BASE + 5]), cvtpk(P[BASE + 6], P[BASE + 7])}; \
    OUT = *reinterpret_cast<bf16x8*>(&w); } while (0)
    PK4(p0, 0, pa0); PK4(p0, 8, pa1); PK4(p1, 0, pa2); PK4(p1, 8, pa3);
#undef PK4
}
__device__ __forceinline__ int v_st(int k, int c) { const int kk = (k & ~0xC) | ((k & 4) << 1) | ((k & 8) >> 1); return ((kk >> 3) * 4 + (c >> 5)) * 512 + ((kk & 7) * 32 + (c & 31)) * 2; }
__device__ __forceinline__ int v_rd_base(int lane) { return ((lane & 3) << 3) | (((lane >> 2) & 3) << 6) | (((lane >> 4) & 1) << 5) | (((lane >> 5) & 1) << 8); }
constexpr int v_rd_off(int d0, int ks, int half) { return d0 * 512 + ks * 4096 + half * 2048; }
template <int OFF> __device__ __forceinline__ s16x4 tr_read(int vb) {
    s16x4 r; asm volatile("ds_read_b64_tr_b16 %0, %1 offset:%2" : "=&v"(r) : "v"(vb), "i"(OFF) : "memory"); return r;
}
template <int D0, bool PRIO = true> __device__ __forceinline__ void pv_one(f32x16& od, int vb, bf16x8 pa0, bf16x8 pa1, bf16x8 pa2, bf16x8 pa3) {
    const s16x4 l0 = tr_read<v_rd_off(D0, 0, 0)>(vb), h0 = tr_read<v_rd_off(D0, 0, 1)>(vb), l1 = tr_read<v_rd_off(D0, 1, 0)>(vb), h1 = tr_read<v_rd_off(D0, 1, 1)>(vb);
    const s16x4 l2 = tr_read<v_rd_off(D0, 2, 0)>(vb), h2 = tr_read<v_rd_off(D0, 2, 1)>(vb), l3 = tr_read<v_rd_off(D0, 3, 0)>(vb), h3 = tr_read<v_rd_off(D0, 3, 1)>(vb);
    asm volatile("s_waitcnt lgkmcnt(0)" ::: "memory"); SBAR();
    if (PRIO) __builtin_amdgcn_s_setprio(1);
#define PK(L, H) (bf16x8){L[0], L[1], L[2], L[3], H[0], H[1], H[2], H[3]}
    od = __builtin_amdgcn_mfma_f32_32x32x16_bf16(pa0, PK(l0, h0), od, 0, 0, 0);
    od = __builtin_amdgcn_mfma_f32_32x32x16_bf16(pa1, PK(l1, h1), od, 0, 0, 0);
    od = __builtin_amdgcn_mfma_f32_32x32x16_bf16(pa2, PK(l2, h2), od, 0, 0, 0);
    od = __builtin_amdgcn_mfma_f32_32x32x16_bf16(pa3, PK(l3, h3), od, 0, 0, 0);
    if (PRIO) __builtin_amdgcn_s_setprio(0);
#undef PK
}
template <bool PRIO = true> __device__ __forceinline__ void pv_d0(f32x16* o, int vb, bf16x8 pa0, bf16x8 pa1, bf16x8 pa2, bf16x8 pa3) {
    pv_one<0, PRIO>(o[0], vb, pa0, pa1, pa2, pa3); pv_one<1, PRIO>(o[1], vb, pa0, pa1, pa2, pa3); pv_one<2, PRIO>(o[2], vb, pa0, pa1, pa2, pa3); pv_one<3, PRIO>(o[3], vb, pa0, pa1, pa2, pa3);
}
#ifndef DF_PRIO
#define DF_PRIO false
#endif
#ifndef ML_PRIO
#define ML_PRIO true
#endif
struct KAddr { int kb[4]; int krb[4]; };
__device__ __forceinline__ KAddr make_kaddr(int r32, int hi) {
    KAddr a; const int y = (hi * 16) ^ ((r32 & 7) << 4), y2 = (hi * 16) ^ (((r32 >> 1) & 7) << 4);
#pragma unroll
    for (int j = 0; j < 4; ++j) { a.kb[j] = r32 * 256 + ((j * 32) ^ y); a.krb[j] = r32 * 128 + ((j * 32) ^ y2); }
    return a;
}
template <int ND0, int NR, bool PRIO = true>
__device__ __forceinline__ void qkt(f32x16& p0, f32x16& p1, lptr Ks, lptr KRs, lptr QRs, const bf16x8* qr, int d0b, const KAddr& ka, const f32x16& cinit) {
    if (PRIO) __builtin_amdgcn_s_setprio(1);
#pragma unroll
    for (int d0 = 0; d0 < ND0; ++d0) {
        const bf16x8 b0 = *reinterpret_cast<const LAS bf16x8*>(Ks + ka.kb[d0 & 3] + ((d0b + d0) >> 2) * 128);
        const bf16x8 b1 = *reinterpret_cast<const LAS bf16x8*>(Ks + ka.kb[d0 & 3] + ((d0b + d0) >> 2) * 128 + 32 * 256);
        if (d0 == 0) { p0 = __builtin_amdgcn_mfma_f32_32x32x16_bf16(b0, qr[d0], cinit, 0, 0, 0); p1 = __builtin_amdgcn_mfma_f32_32x32x16_bf16(b1, qr[d0], cinit, 0, 0, 0); }
        else { p0 = __builtin_amdgcn_mfma_f32_32x32x16_bf16(b0, qr[d0], p0, 0, 0, 0); p1 = __builtin_amdgcn_mfma_f32_32x32x16_bf16(b1, qr[d0], p1, 0, 0, 0); } }
#pragma unroll
    for (int d0 = 0; d0 < NR; ++d0) {
        const bf16x8 b0 = *reinterpret_cast<const LAS bf16x8*>(KRs + ka.krb[d0]);
        const bf16x8 b1 = *reinterpret_cast<const LAS bf16x8*>(KRs + ka.krb[d0] + 32 * 128);
        p0 = __builtin_amdgcn_mfma_f32_32x32x16_bf16(b0, qr[ND0 + d0], p0, 0, 0, 0);
        p1 = __builtin_amdgcn_mfma_f32_32x32x16_bf16(b1, qr[ND0 + d0], p1, 0, 0, 0); }
    if (PRIO) __builtin_amdgcn_s_setprio(0);
}
template <bool EXPALL, bool FIRST>
__device__ __forceinline__ void partialSMn(f32x16& p0, f32x16& p1, float& m_reg, float& alpha) {
    float pmax = p0[0];
#pragma unroll
    for (int r = 1; r < 16; ++r) pmax = fmaxf(pmax, p0[r]);
#pragma unroll
    for (int r = 0; r < 16; ++r) pmax = fmaxf(pmax, p1[r]);
    { auto rr = __builtin_amdgcn_permlane32_swap(__float_as_uint(pmax), __float_as_uint(pmax), false, false);
      pmax = fmaxf(__uint_as_float(rr[0]), __uint_as_float(rr[1])); }
    alpha = 1.f;
    if (FIRST) { m_reg = pmax; alpha = 0.f;
#pragma unroll
        for (int r = 0; r < 16; ++r) { p0[r] -= pmax; p1[r] -= pmax; } }
    else if (__builtin_expect(!__all(pmax <= THRL), 0)) { const float delta = fmaxf(pmax, 0.f); m_reg += delta; alpha = __builtin_amdgcn_exp2f(-delta);
#pragma unroll
        for (int r = 0; r < 16; ++r) { p0[r] -= delta; p1[r] -= delta; } }
#pragma unroll
    for (int r = 0; r < 16; ++r) p0[r] = __builtin_amdgcn_exp2f(p0[r]);
    if (EXPALL) {
#pragma unroll
        for (int r = 0; r < 16; ++r) p1[r] = __builtin_amdgcn_exp2f(p1[r]); }
}
__device__ __forceinline__ bf16x8 scale_frag(bf16x8 q, float c) {
    const u32x4 w = __builtin_bit_cast(u32x4, q); u32x4 o;
#pragma unroll
    for (int i = 0; i < 4; ++i) o[i] = cvtpk(__uint_as_float(w[i] << 16) * c, __uint_as_float(w[i] & 0xffff0000u) * c);
    return __builtin_bit_cast(bf16x8, o);
}
#define SETNEG(BL) do { const float nv_ = (BL) - m_reg; if (__any(nv_ != negv)) { negv = nv_; _Pragma("unroll") for (int r = 0; r < 16; ++r) negm[r] = nv_; asm volatile("" : "+v"(negm)); } } while (0)

__device__ __forceinline__ void glds16(const bf16* g, lptr l) { __builtin_amdgcn_global_load_lds((const unsigned*)g, (LAS unsigned*)l, 16, 0, 0); }
#define WAITV(n) asm volatile("s_waitcnt vmcnt(" #n ")" ::: "memory")
#define ABAR() do { asm volatile("s_waitcnt lgkmcnt(0)" ::: "memory"); __builtin_amdgcn_s_barrier(); asm volatile("" ::: "memory"); } while (0)
__device__ __forceinline__ long ksrc_off(int p, int lane, int stride) { const int row = 4 * p + (lane >> 4), c = (lane & 15) ^ (row & 7); return (long)row * stride + c * 8; }
__device__ __forceinline__ long krsrc_off(int p, int lane, int stride) { const int row = 8 * p + (lane >> 3), c = (lane & 7) ^ ((row >> 1) & 7); return (long)row * stride + c * 8; }
__device__ __forceinline__ long vsrc_off(int p, int lane, int stride) { const int st = 2 * p + (lane >> 5), kk = (st >> 2) * 8 + ((lane & 31) >> 2);
    const int k = kk, col = (st & 3) * 32 + (lane & 3) * 8; return (long)k * stride + col; }
#define RESC(a) do { if (__any((a) < 1.f)) { if (hi == 0) al_l[r32] = (a); asm volatile("s_waitcnt lgkmcnt(0)" ::: "memory"); \
    _Pragma("unroll") for (int d = 0; d < 4; ++d) _Pragma("unroll") for (int r = 0; r < 16; ++r) o[d][r] *= al_l[crow(r, hi)]; } } while (0)

constexpr int ML_SLOT = SHM_K + SHM_V + SHM_KR, ML_NS = 3, ML_WS = ML_NS * ML_SLOT, MLA_LDS = ML_WS + 8 * 64 * 4;
__device__ __forceinline__ void mla_unit(const bf16* __restrict__ Qb, const bf16* __restrict__ KNh, const bf16* __restrict__ KRb, bf16* __restrict__ Ob, lptr lds, int tid) {
    constexpr float C = MLA_SCALE * LOG2E;
    const int wid = __builtin_amdgcn_readfirstlane(tid >> 6), lane = tid & 63, r32 = lane & 31, hi = lane >> 5;
    LAS float* ws = (LAS float*)(lds + ML_WS) + wid * 64; LAS float* li_l = ws; LAS float* al_l = ws + 32;
    float m_reg = -1e30f, l_reg = 0; f32x16 o[4] = {}; bf16x8 qr[12]; const f32x16 zero16 = {};
    const bf16* Qw = Qb + (long)(wid * QBLK + r32) * QW + hi * 8;
#pragma unroll
    for (int d0 = 0; d0 < 12; ++d0) qr[d0] = ld8(Qw + d0 * 16);
    const KAddr ka = make_kaddr(r32, hi);
    const bf16* Vh = KNh + 128;
    const int vb0 = (int)(unsigned)(uintptr_t)lds + SHM_K + v_rd_base(lane);
    const long ko0 = ksrc_off(2 * wid, lane, KVW), ko1 = ksrc_off(2 * wid + 1, lane, KVW), vo0 = vsrc_off(2 * wid, lane, KVW), vo1 = vsrc_off(2 * wid + 1, lane, KVW), ro0 = krsrc_off(wid, lane, INWP);
    lptr dK = lds + wid * 2048, dV = lds + SHM_K + wid * 2048, dR = lds + SHM_K + SHM_V + wid * 1024;
#define DMA(t, so) do { const long kr_ = (long)(t) * KVBLK; const bf16* kp_ = KNh + kr_ * KVW; const bf16* vp_ = Vh + kr_ * KVW; const bf16* rp_ = KRb + kr_ * INWP; \
    glds16(kp_ + ko0, dK + (so)); glds16(kp_ + ko1, dK + (so) + 1024); glds16(vp_ + vo0, dV + (so)); glds16(vp_ + vo1, dV + (so) + 1024); glds16(rp_ + ro0, dR + (so)); } while (0)
#define ROT3() do { const int t_ = sp; sp = sc; sc = sn; sn = t_; } while (0)
    f32x16 pA0, pA1, pB0, pB1; float alA, alB; bf16x8 pa0, pa1, pa2, pa3; constexpr int NT = SEQ / KVBLK;
    int sp = 0, sc = 0, sn = ML_SLOT;
    DMA(0, 0); DMA(1, ML_SLOT); WAITV(5); ABAR();
    qkt<8, 4, ML_PRIO>(pA0, pA1, lds, lds + SHM_K + SHM_V, lds, qr, 0, ka, zero16); partialSM(pA0, pA1, C, 0.f, m_reg, alA);
    WAITV(0); ABAR();
    sp = 0; sc = ML_SLOT; sn = 2 * ML_SLOT;
    for (int j = 1; j + 1 < NT; j += 2) {
        DMA(j + 1, sn);
        SBAR(); qkt<8, 4, ML_PRIO>(pB0, pB1, lds + sc, lds + sc + SHM_K + SHM_V, lds, qr, 0, ka, zero16);
        finishSM(pA0, pA1, alA, l_reg, pa0, pa1, pa2, pa3); SBAR();
        pv_d0<ML_PRIO>(o, vb0 + sp, pa0, pa1, pa2, pa3); partialSM(pB0, pB1, C, 0.f, m_reg, alB);
        WAITV(0); ABAR(); RESC(alB); ROT3();
        if (j + 2 < NT) DMA(j + 2, sn);
        SBAR(); qkt<8, 4, ML_PRIO>(pA0, pA1, lds + sc, lds + sc + SHM_K + SHM_V, lds, qr, 0, ka, zero16);
        finishSM(pB0, pB1, alB, l_reg, pa0, pa1, pa2, pa3); SBAR();
        pv_d0<ML_PRIO>(o, vb0 + sp, pa0, pa1, pa2, pa3); partialSM(pA0, pA1, C, 0.f, m_reg, alA);
        WAITV(0); ABAR(); RESC(alA); ROT3();
    }
    SBAR(); qkt<8, 4, ML_PRIO>(pB0, pB1, lds + sc, lds + sc + SHM_K + SHM_V, lds, qr, 0, ka, zero16);
    finishSM(pA0, pA1, alA, l_reg, pa0, pa1, pa2, pa3); SBAR();
    pv_d0<ML_PRIO>(o, vb0 + sp, pa0, pa1, pa2, pa3); partialSM(pB0, pB1, C, 0.f, m_reg, alB);
    RESC(alB);
    finishSM(pB0, pB1, alB, l_reg, pa0, pa1, pa2, pa3); SBAR();
    pv_d0<ML_PRIO>(o, vb0 + sc, pa0, pa1, pa2, pa3);
    if (hi == 0) li_l[r32] = l_reg; asm volatile("s_waitcnt lgkmcnt(0)" ::: "memory");
    float rli[16];
#pragma unroll
    for (int r = 0; r < 16; ++r) rli[r] = __builtin_amdgcn_rcpf(li_l[crow(r, hi)]);
    bf16* Ow = Ob + (long)(wid * QBLK) * DM;
#pragma unroll
    for (int r = 0; r < 16; ++r) { const int orow = crow(r, hi);
#pragma unroll
        for (int d0 = 0; d0 < 4; ++d0) Ow[(long)orow * DM + d0 * 32 + r32] = (bf16)f2bf(o[d0][r] * rli[r]); }
    ABAR();
#undef DMA
#undef ROT3
}

typedef float cv_f32x2 __attribute__((ext_vector_type(2)));
typedef __bf16 cv_bf16x2 __attribute__((ext_vector_type(2)));
__device__ __forceinline__ unsigned cv_pk(float lo, float hi) { const cv_f32x2 v = {lo, hi}; const cv_bf16x2 r = __builtin_convertvector(v, cv_bf16x2); return __builtin_bit_cast(unsigned, r); }
struct CvStream { bool on; const float* src; unsigned char* dst; unsigned sN4  , K2  , so_src, so_dst; int nsteps  ; };
constexpr int DF_SLOT = SHM_K + SHM_V, DF_NS = 4, DF_WS = DF_NS * DF_SLOT, DF_LUT = DF_WS + 8 * 64 * 4, DF_TK = DF_LUT + 512 * 4, DF_KPOS = DF_TK + 96 * 4, DF_LDS = DF_KPOS + SEQ * 4;
__device__ __forceinline__ void diff_unit(const bf16* __restrict__ Qb  , const bf16* __restrict__ Kh  ,
                                          const bf16* __restrict__ Vh  , const int* __restrict__ qposp  ,
                                          const int* __restrict__ kposp  , const int* __restrict__ tk  , const int* __restrict__ tkf  ,
                                          const float* __restrict__ relb_h  , const float* __restrict__ subln, float lam, bf16* __restrict__ Ob  , lptr lds, int tid, const CvStream cv) {
    constexpr float C = DIFF_SCALE * LOG2E;
    const int wid = __builtin_amdgcn_readfirstlane(tid >> 6), lane = tid & 63, r32 = lane & 31, hi = lane >> 5;
    const int comp = wid >> 2, wq = wid & 3;
    LAS float* ws = (LAS float*)(lds + DF_WS) + wid * 64; LAS float* li_l = ws; LAS float* al_l = ws + 32;
    LAS int* kpos_l = (LAS int*)(lds + DF_KPOS); LAS float* lut = (LAS float*)(lds + DF_LUT); LAS int* tkl = (LAS int*)(lds + DF_TK);
    const long ko0 = ksrc_off(2 * wid, lane, INWP), ko1 = ksrc_off(2 * wid + 1, lane, INWP), vo0 = vsrc_off(2 * wid, lane, INWP), vo1 = vsrc_off(2 * wid + 1, lane, INWP);
    lptr dK = lds + wid * 2048, dV = lds + SHM_K + wid * 2048;
#define DMA(t, so) do { const long kr_ = (long)(t) * KVBLK * INWP; const bf16* kp_ = Kh + kr_; const bf16* vp_ = Vh + kr_; \
    glds16(kp_ + ko0, dK + (so)); glds16(kp_ + ko1, dK + (so) + 1024); glds16(vp_ + vo0, dV + (so)); glds16(vp_ + vo1, dV + (so) + 1024); } while (0)
    DMA(0, 0); DMA(1, DF_SLOT);
    const bool cv_on = cv.on;
    const __amdgpu_buffer_rsrc_t cv_rs = __builtin_amdgcn_make_buffer_rsrc((void*)cv.src, 0, -1, 0x00020000), cv_rd = __builtin_amdgcn_make_buffer_rsrc((void*)cv.dst, 0, -1, 0x00020000);
    unsigned cv_ss = cv.so_src, cv_sd = cv.so_dst; const unsigned cv_n4 = cv.sN4;
    const int cv_vs = (lane >> 4) * 4 * (int)cv.sN4 + (lane & 15) * 16, cv_vd = (lane & 15) * 4 * (int)cv.K2 + (lane >> 4) * 8; int cv_left = cv.nsteps;
    u32x4 cv0 = {}, cv1 = {}, cv2 = {}, cv3 = {};
#define CV_LOAD() do { if (cv_on && cv_left > 0) { cv0 = __builtin_amdgcn_raw_buffer_load_b128(cv_rs, cv_vs, cv_ss, 2); cv1 = __builtin_amdgcn_raw_buffer_load_b128(cv_rs, cv_vs, cv_ss + cv_n4, 2); \
      cv2 = __builtin_amdgcn_raw_buffer_load_b128(cv_rs, cv_vs, cv_ss + 2 * cv_n4, 2); cv3 = __builtin_amdgcn_raw_buffer_load_b128(cv_rs, cv_vs, cv_ss + 3 * cv_n4, 2); cv_ss += 16 * cv_n4; } } while (0)
#define CV_ST1(J_, C_) do { pg8::u32x2 o_; o_.x = cv_pk(cvf0_.C_, cvf1_.C_); o_.y = cv_pk(cvf2_.C_, cvf3_.C_); \
      __builtin_amdgcn_raw_buffer_store_b64(o_, cv_rd, cv_vd, cv_sd + (J_) * cv.K2, 0); } while (0)
#define CV_STORE() do { if (cv_on && cv_left > 0) {   \
      const f32x4 cvf0_ = __builtin_bit_cast(f32x4, cv0), cvf1_ = __builtin_bit_cast(f32x4, cv1), cvf2_ = __builtin_bit_cast(f32x4, cv2), cvf3_ = __builtin_bit_cast(f32x4, cv3); \
      CV_ST1(0, x); CV_ST1(1, y); CV_ST1(2, z); CV_ST1(3, w); cv_sd += 32; --cv_left; } } while (0)
    const int ld_ = tid - 256;
    const float lutv = relb_h[t5_bucket(ld_ < -128 ? -128 : (ld_ > 128 ? 128 : ld_)) * 8] * LOG2E;
    const int tkv = (tid >= 448) ? tk[tid - 448] : ((tid >= 416) ? tkf[tid - 416] : 0);
    const u32x4 kp4 = *(const u32x4*)(kposp + tid * 4);
    const int qp = qposp[wq * QBLK + r32];
    float m_reg = 0.f, l_reg = 0; f32x16 o[4] = {}; bf16x8 qr[4]; f32x16 negm = {}; float negv = 0.f;
    const bf16* Qw = Qb + (long)(wq * QBLK + r32) * INWP + comp * 64 + hi * 8;
#pragma unroll
    for (int d0 = 0; d0 < 4; ++d0) qr[d0] = ld8(Qw + d0 * 16);
    lut[tid] = lutv;
    if (tid >= 448) tkl[tid - 448] = tkv; else if (tid >= 416) tkl[64 + tid - 416] = tkv;
    *(LAS u32x4*)(kpos_l + tid * 4) = kp4;
    int qmn = qp, qmx = qp;
#pragma unroll
    for (int of = 1; of < 32; of <<= 1) { qmn = min(qmn, __shfl_xor(qmn, of)); qmx = max(qmx, __shfl_xor(qmx, of)); }
    qmn = __builtin_amdgcn_readfirstlane(qmn); qmx = __builtin_amdgcn_readfirstlane(qmx);
    const bool qnarrow = (qmx - qmn < 32);
#pragma unroll
    for (int d0 = 0; d0 < 4; ++d0) qr[d0] = scale_frag(qr[d0], C);
    const KAddr ka = make_kaddr(r32, hi);
    const int vb0 = (int)(unsigned)(uintptr_t)lds + SHM_K + v_rd_base(lane);
#define TILEBIAS(t, BL, NEAR) const int kmn_##BL = tkl[2 * (t)], kmx_##BL = tkl[2 * (t) + 1]; const bool fr_##BL = (kmn_##BL - qmx >= 91), fl_##BL = (kmx_##BL - qmn <= -91); \
    const bool NEAR = !(fr_##BL || fl_##BL); const float BL = fr_##BL ? blR : (fl_##BL ? blL : 0.f)
#define ADJ(P0, P1, t, NEAR) do { if (NEAR) { if (qnarrow && tkl[64 + (t)] != 0) lut_adjust_fast(P0, P1, lut, tkl[2 * (t)], qp, hi); else lut_adjust(P0, P1, lut, kpos_l + (t) * 64, qp, hi); } } while (0)
#define SLOT(t) (((t) & 3) * DF_SLOT)
#define ENDWAIT(t) do { if ((t) + 2 < NT) WAITV(4); else WAITV(0); } while (0)
#define ENDSTEP(t) ABAR()
    f32x16 pA0, pA1, pB0, pB1; float alA, alB; bf16x8 pa0, pa1, pa2, pa3; constexpr int NT = SEQ / KVBLK;
    WAITV(0); ABAR();
    const float blR = lut[256 + 128], blL = lut[256 - 128];
    DMA(2, SLOT(2));
    { TILEBIAS(0, bl0, near0); SETNEG(bl0);
      qkt<4, 0, DF_PRIO>(pA0, pA1, lds + SLOT(0), lds, lds, qr, 4 * comp, ka, negm); ADJ(pA0, pA1, 0, near0); partialSMn<true, true>(pA0, pA1, m_reg, alA); }
    ENDWAIT(0); CV_LOAD(); ENDSTEP(0);
    for (int j = 1; j + 1 < NT; j += 2) {
        if (j + 2 < NT) DMA(j + 2, SLOT(j + 2));
        { TILEBIAS(j, blb, nearb); SETNEG(blb);
          SBAR(); qkt<4, 0, DF_PRIO>(pB0, pB1, lds + SLOT(j), lds, lds, qr, 4 * comp, ka, negm);
          finishSM<true>(pA0, pA1, alA, l_reg, pa0, pa1, pa2, pa3); SBAR();
          ADJ(pB0, pB1, j, nearb); SBAR();
          pv_d0<DF_PRIO>(o, vb0 + SLOT(j - 1), pa0, pa1, pa2, pa3); partialSMn<true, false>(pB0, pB1, m_reg, alB); }
        ENDWAIT(j); CV_STORE(); CV_LOAD(); ENDSTEP(j); RESC(alB);
        if (j + 3 < NT) DMA(j + 3, SLOT(j + 3));
        { TILEBIAS(j + 1, bla, neara); SETNEG(bla);
          SBAR(); qkt<4, 0, DF_PRIO>(pA0, pA1, lds + SLOT(j + 1), lds, lds, qr, 4 * comp, ka, negm);
          finishSM<true>(pB0, pB1, alB, l_reg, pa0, pa1, pa2, pa3); SBAR();
          ADJ(pA0, pA1, j + 1, neara); SBAR();
          pv_d0<DF_PRIO>(o, vb0 + SLOT(j), pa0, pa1, pa2, pa3); partialSMn<true, false>(pA0, pA1, m_reg, alA); }
        ENDWAIT(j + 1); CV_STORE(); CV_LOAD(); ENDSTEP(j + 1); RESC(alA);
    }
    CV_STORE(); CV_LOAD();
    { TILEBIAS(NT - 1, blz, nearz); SETNEG(blz);
      SBAR(); qkt<4, 0, DF_PRIO>(pB0, pB1, lds + SLOT(NT - 1), lds, lds, qr, 4 * comp, ka, negm);
      finishSM<true>(pA0, pA1, alA, l_reg, pa0, pa1, pa2, pa3); SBAR();
      ADJ(pB0, pB1, NT - 1, nearz); SBAR();
      pv_d0<DF_PRIO>(o, vb0 + SLOT(NT - 2), pa0, pa1, pa2, pa3); partialSMn<true, false>(pB0, pB1, m_reg, alB); }
    RESC(alB);
    finishSM<true>(pB0, pB1, alB, l_reg, pa0, pa1, pa2, pa3); SBAR();
    pv_d0<DF_PRIO>(o, vb0 + SLOT(NT - 1), pa0, pa1, pa2, pa3);
    CV_STORE();
    if (hi == 0) li_l[r32] = l_reg; asm volatile("s_waitcnt lgkmcnt(0)" ::: "memory");
    float rli[16];
#pragma unroll
    for (int r = 0; r < 16; ++r) rli[r] = __builtin_amdgcn_rcpf(li_l[crow(r, hi)]);
    ABAR();
    LAS float* X = (LAS float*)lds + (wq * 32) * 128;
    if (comp == 1) {
#pragma unroll
        for (int r = 0; r < 16; ++r) { const int orow = crow(r, hi);
#pragma unroll
            for (int d0 = 0; d0 < 4; ++d0) X[orow * 128 + d0 * 32 + r32] = o[d0][r] * rli[r] * lam; }
    }
    ABAR();
    if (comp == 0) {
        bf16* Ow = Ob + (long)(wq * QBLK) * DM;
        float sl[4];
#pragma unroll
        for (int d0 = 0; d0 < 4; ++d0) sl[d0] = subln[d0 * 32 + r32] * (1.0f - LAMBDA_INIT);
#pragma unroll
        for (int r = 0; r < 16; ++r) { const int orow = crow(r, hi);
            float v[4]; float ss = 0.f;
#pragma unroll
            for (int d0 = 0; d0 < 4; ++d0) { v[d0] = o[d0][r] * rli[r] - X[orow * 128 + d0 * 32 + r32]; ss += v[d0] * v[d0]; }
#pragma unroll
            for (int of = 1; of < 32; of <<= 1) ss += __shfl_xor(ss, of);
            const float rstd = rsqrtf(ss * (1.0f / 128.0f) + EPS);
#pragma unroll
            for (int d0 = 0; d0 < 4; ++d0) Ow[(long)orow * DM + d0 * 32 + r32] = (bf16)f2bf(v[d0] * rstd * sl[d0]); }
    }
    ABAR();
#undef DMA
#undef TILEBIAS
#undef ADJ
#undef SETNEG
#undef SLOT
#undef ENDSTEP
#undef ENDWAIT
#undef CV_LOAD
#undef CV_STORE
#undef CV_ST1
#undef RESC
#undef WAITV
#undef ABAR
}
#undef KSWZ
#undef KRSWZ
#undef SBAR
}

__device__ __forceinline__ void attn_phase(unsigned char* ws, const int* pos, const float* rel_bias, const float* subln, float lam, LAS unsigned char* lds, int tid, int G, int bid,
                                           const float* wsrc_o, const float* wsrc_up, const float* wsrc_dn) {
    const bf16* PROJ = (const bf16*)(ws + WS_PROJ); const bf16* Qb = (const bf16*)(ws + WS_Q); const bf16* KVb = (const bf16*)(ws + WS_KV); bf16* AO = (bf16*)(ws + WS_AO);
    const int* TK = (const int*)(ws + WS_TK);
    const int vcu = (G % 8 == 0) ? (bid % 8) * (G / 8) + bid / 8 : bid;
    { constexpr int NU = BATCH * 8 * (SEQ / 256); const int per = (NU + G - 1) / G;
      for (int i = 0; i < per; ++i) { const int un = vcu * per + i; if (un >= NU) break;
        int tidu = tid; asm volatile("" : "+v"(tidu));
        const int qb = un & 7, h = (un >> 3) & 7, b = un >> 6;
        const size_t m0 = (size_t)b * SEQ + qb * 256;
        att::mla_unit(Qb + m0 * QW + h * 192, KVb + (size_t)b * SEQ * KVW + h * 256, PROJ + (size_t)b * SEQ * INWP + C_KROPE, AO + m0 * DM + h * 128, (att::lptr)lds, tidu); } }
    { constexpr int NU = BATCH * 8 * (SEQ / 128); const int per = (NU + G - 1) / G;
      att::CvStream cvb; cvb.on = false; cvb.src = nullptr; cvb.dst = nullptr; cvb.sN4 = 0; cvb.K2 = 0; cvb.so_src = 0; cvb.so_dst = 0; cvb.nsteps = 0; int cv_kunit = 0;
      if (G == 256) { const int gw_ = __builtin_amdgcn_readfirstlane(tid >> 6) * G + vcu; int strip = 0, kb_ = 0, N_ = 0, K_ = 0;
        if (gw_ < 32) { strip = gw_; N_ = DM; K_ = DM; cvb.src = wsrc_o; cvb.dst = ws + WS_WO; cvb.on = true; cvb.nsteps = 32; cv_kunit = 512; }
        else if (gw_ < 208) { strip = gw_ - 32; N_ = FF2; K_ = DM; cvb.src = wsrc_up; cvb.dst = ws + WS_WUP; cvb.on = true; cvb.nsteps = 32; cv_kunit = 512; }
        else if (gw_ < 336) { const int g_ = gw_ - 208; strip = g_ >> 2; kb_ = 1408 * (g_ & 3); N_ = DM; K_ = FF; cvb.src = wsrc_dn; cvb.dst = ws + WS_WDN; cvb.on = true; cvb.nsteps = 22; cv_kunit = 352; }
        cvb.sN4 = (unsigned)N_ * 4u; cvb.K2 = (unsigned)K_ * 2u;
        cvb.so_src = ((unsigned)kb_ * (unsigned)N_ + 64u * strip) * 4u; cvb.so_dst = ((unsigned)(64 * strip) * (unsigned)K_ + (unsigned)kb_) * 2u; }
      for (int i = 0; i < per; ++i) { const int un = vcu * per + i; if (un >= NU) break;
        int tidu = tid; asm volatile("" : "+v"(tidu));
        const int qb = un & 15, h = (un >> 4) & 7, b = un >> 7;
        const size_t m0 = (size_t)b * SEQ + qb * 128;
        att::CvStream cv = cvb; cv.so_src += (unsigned)(cv_kunit * i) * cvb.sN4; cv.so_dst += (unsigned)(cv_kunit * i) * 2u;
        att::diff_unit(PROJ + m0 * INWP + C_DQ + h * 128, PROJ + (size_t)b * SEQ * INWP + C_DK + h * 128, PROJ + (size_t)b * SEQ * INWP + C_DV + h * 128,
                       pos + m0, pos + (size_t)b * SEQ, TK + b * 64, TK + TKF_OFF + b * 32, rel_bias + h, subln, lam, AO + m0 * DM + 1024 + h * 128, (att::lptr)lds, tidu, cv); } }
}

constexpr int NPH = 11;
struct Args { const void* in[25]; float* out; unsigned char* ws; int ph_lo, ph_hi; };
__global__ void __launch_bounds__(NTHREADS, 2) fwd(Args args) {
    extern __shared__ __attribute__((aligned(16))) unsigned char lds_raw[];
    LAS unsigned char* lds = (LAS unsigned char*)lds_raw;
    const int tid0 = threadIdx.x, G0 = gridDim.x;
    const int wave0 = __builtin_amdgcn_readfirstlane(tid0 >> 6);
    for (int u = tid0; u < (LDS_BYTES - LDSCTL_OFF) / 4; u += NTHREADS) ((LAS unsigned*)(lds + LDSCTL_OFF))[u] = 0u;
    __syncthreads();
    if (tid0 == 0) {
        LAS unsigned long long* pt = (LAS unsigned long long*)(lds + PTR_OFF);
#pragma unroll
        for (int i = 0; i < 25; ++i) pt[i] = (unsigned long long)args.in[i];
        pt[P_OUT] = (unsigned long long)args.out; pt[P_WS] = (unsigned long long)args.ws;
    }
    __syncthreads();
    volatile LAS unsigned* MISC = (volatile LAS unsigned*)(lds + MISC_OFF);
    const int ph_lo = args.ph_lo, ph_hi = args.ph_hi;
    XcdBarrier bar; bar.bar = nullptr; bar.x = 0; bar.st = nullptr;
    if (ph_hi - ph_lo > 1) bar = xcd_barrier_post((unsigned*)(LPWS() + WS_CTL) + CW_BAR, MISC + 8, tid0);

#define PH_BEGIN(k) if (ph_lo <= (k) && (k) < ph_hi) { int G = G0, bid = (int)blockIdx.x, wave = wave0; \
        int lane = (int)__builtin_amdgcn_mbcnt_hi(~0u, __builtin_amdgcn_mbcnt_lo(~0u, 0u)); \
        asm volatile("" : "+v"(lane)); asm volatile("" : "+s"(G)); asm volatile("" : "+s"(bid)); asm volatile("" : "+s"(wave)); \
        const int tid = wave * 64 + lane; (void)tid; (void)lane; (void)G; (void)bid; unsigned char* ws = LPWS(); (void)ws;
#define PH_END(k) if ((k) + 1 < ph_hi) xcd_barrier(bar, tid); }

    PH_BEGIN(0) p0_prologue(lds, tid, lane, wave, G, bid); PH_END(0)
    PH_BEGIN(1) prenorm_phase(LPF(P_X), LPF(P_APRE), (const float*)(ws + WS_MOD), MOD_SHA, MOD_SCA, (bf16*)(ws + WS_H), lane, wave, G, bid); PH_END(1)
    for (int q = 0; q < 3; ++q) {
        const int k = (q == 0) ? 2 : 3;
        PH_BEGIN(k)
            bf16* PROJ = (bf16*)(ws + WS_PROJ);
            pg8::Gemm g; pg8::EpiX E;
            E.qscale = 1.0f; E.ssq_q = (float*)(ws + WS_SSQQ); E.ssq_kv = (float*)(ws + WS_SSQKV); E.COS = (const float*)(ws + WS_COS); E.SIN = (const float*)(ws + WS_SIN);
            if (q == 0) { g = pg8::Gemm{(const bf16*)(ws + WS_H), (const bf16*)(ws + WS_WIN), M, INWP, DM, DM, DM, 128, 256, 0}; E.O = PROJ; E.ldc = INWP; E.mode = 0; }
            else if (q == 1) { g = pg8::Gemm{PROJ + C_QLAT, (const bf16*)(ws + WS_WUQ), M, QW, 512, INWP, 512, 128, 256, 0}; E.O = (bf16*)(ws + WS_Q); E.ldc = QW; E.mode = 1; }
            else { g = pg8::Gemm{PROJ + C_KVLAT, (const bf16*)(ws + WS_WUKV), M, KVW, 256, INWP, 256, 128, 256, 0}; E.O = (bf16*)(ws + WS_KV); E.ldc = KVW; E.mode = 2; }
            const int vcu = (G % 8 == 0) ? (bid % 8) * (G / 8) + bid / 8 : bid;
            pg8::ListOrder S;
            if (G == 256) {
                if (q == 0) S = pg8::ListOrder{4 * vcu, 4, INWP / 256};
                else if (q == 1) S = (vcu < 128) ? pg8::ListOrder{2 * vcu, 2, QW / 256} : pg8::ListOrder{256 + (vcu - 128), 1, QW / 256};
                else S = (vcu < 128) ? pg8::ListOrder{vcu, 1, KVW / 256} : pg8::ListOrder{128 + 3 * (vcu - 128), 3, KVW / 256};
            } else { const int nu = (g.M / 256) * (g.N / 256), per = (nu + G - 1) / G, b0 = vcu * per; S = pg8::ListOrder{b0, (b0 >= nu) ? 0 : ((nu - b0 < per) ? nu - b0 : per), g.N / 256}; }
            pg8::gemm_phase<pg8::EpiX, pg8::ListOrder, true, true>(lds, g, S, E, tid);
            if (q == 1) { }
            else
        PH_END(k)
        else { }
    }
    PH_BEGIN(4)
        const float s1 = wave_sum(LPF(P_LQ1)[lane] * LPF(P_LK1)[lane]), s2 = wave_sum(LPF(P_LQ2)[lane] * LPF(P_LK2)[lane]);
        const float lam = expf(s1) - expf(s2) + LAMBDA_INIT;
        attn_phase(ws, (const int*)ldptr(lds, P_POS), LPF(P_RELB), LPF(P_SUBLN), lam, lds, tid, G, bid, LPF(P_WO), LPF(P_WUP), LPF(P_WDN));
    PH_END(4)
    for (int q = 0; q < 2; ++q) {
        const int k = (q == 0) ? 5 : 9;
        PH_BEGIN(k)
            pg8::Gemm g; pg8::EpiBf16 E;
            if (q == 0) { g = pg8::Gemm{(const bf16*)(ws + WS_AO), (const bf16*)(ws + WS_WO), M, DM, DM, DM, DM, 128, 256, 0}; E = pg8::EpiBf16{(bf16*)(ws + WS_Y), DM}; }
            else { g = pg8::Gemm{(const bf16*)(ws + WS_G), (const bf16*)(ws + WS_WDN), M, DM, FF, FF, FF, 128, 256, 0}; E = pg8::EpiBf16{(bf16*)(ws + WS_Y2), DM}; }
            pg8::StaticOrder S; S.init(g.M, g.N, G, bid);
            pg8::gemm_phase<pg8::EpiBf16, pg8::StaticOrder, true, true>(lds, g, S, E, tid);
        PH_END(k)
        if (q == 0) {
            PH_BEGIN(6) post_phase<true>((const bf16*)(ws + WS_Y), LPF(P_X), (void*)(ws + WS_X1), LPF(P_APOST), (const float*)(ws + WS_MOD), MOD_GA, LPF(P_FPRE), MOD_SHF, MOD_SCF, (bf16*)(ws + WS_H), lane, wave, G, bid); PH_END(6)
            PH_BEGIN(7)
                pg8::Gemm g = pg8::Gemm{(const bf16*)(ws + WS_H), (const bf16*)(ws + WS_WUP), M, FF2, DM, DM, DM, FF, 128, 1};
                pg8::EpiConv E{(bf16*)(ws + WS_G), (bf16*)(ws + WS_E), LPF(P_CW), LPF(P_CB), FF, FF2};
                pg8::StaticOrder S; S.init(g.M, g.N, G, bid);
                pg8::gemm_phase<pg8::EpiConv, pg8::StaticOrder, true, true>(lds, g, S, E, tid);
            PH_END(7)
            PH_BEGIN(8) fixup_phase((const bf16*)(ws + WS_E), (bf16*)(ws + WS_G), LPF(P_CW), LPF(P_CB), tid, G, bid); PH_END(8)
        }
    }
    PH_BEGIN(10) float* outp = (float*)ldptr(lds, P_OUT);
        post_phase<false>((const bf16*)(ws + WS_Y2), (const void*)(ws + WS_X1), outp, LPF(P_FPOST), (const float*)(ws + WS_MOD), MOD_GF, nullptr, 0, 0, nullptr, lane, wave, G, bid); PH_END(10)
#undef PH_BEGIN
#undef PH_END
}

#ifndef MK_ONE_LAUNCH
#define MK_ONE_LAUNCH 1
#endif
extern "C" void kernel_launch(void* const* d_in, const int* in_sizes, int n_in, void* d_out, int out_size, void* d_ws, size_t ws_size, hipStream_t stream) {
    static int grid = 0;
    if (grid == 0) {
        if (n_in != 25 || in_sizes[0] != M * DM || out_size != M * DM || ws_size < WS_END) {
            fprintf(stderr, "kernel_launch: shape mismatch: n_in %d in0 %d out %d ws %zu (need >= %zu)\n", n_in, n_in > 0 ? in_sizes[0] : -1, out_size, ws_size, (size_t)WS_END); grid = -1; return; }
        int dev = 0, cus = 0;
        if (hipGetDevice(&dev) != hipSuccess || hipDeviceGetAttribute(&cus, hipDeviceAttributeMultiprocessorCount, dev) != hipSuccess) { grid = -1; return; }
        if (hipFuncSetAttribute((const void*)fwd, hipFuncAttributeMaxDynamicSharedMemorySize, LDS_BYTES) != hipSuccess) { fprintf(stderr, "kernel_launch: hipFuncSetAttribute failed\n"); grid = -1; return; }
        (void)hipGetLastError();
        grid = cus;
    }
    if (grid < 0) return;
    if (hipMemsetAsync((char*)d_ws + WS_CTL, 0, CTL_ZERO_BYTES, stream) != hipSuccess) { fprintf(stderr, "kernel_launch: memset failed\n"); return; }
    Args a{};
    for (int i = 0; i < 25; ++i) a.in[i] = d_in[i];
    a.out = (float*)d_out; a.ws = (unsigned char*)d_ws;
#if MK_ONE_LAUNCH
    a.ph_lo = 0; a.ph_hi = NPH;
    hipLaunchKernelGGL(fwd, dim3(grid), dim3(NTHREADS), LDS_BYTES, stream, a);
#else
    for (int p = 0; p < NPH; ++p) { a.ph_lo = p; a.ph_hi = p + 1; hipLaunchKernelGGL(fwd, dim3(grid), dim3(NTHREADS), LDS_BYTES, stream, a); }
#endif
    const hipError_t le = hipPeekAtLastError();
    if (le != hipSuccess) fprintf(stderr, "kernel_launch: launch failed: %s\n", hipGetErrorName(le));
}
```

```cpp
#include <hip/hip_runtime.h>
#include <cstdio>
#include <cstdint>
namespace pg8 {
#define PG8_LAS __attribute__((address_space(3)))
typedef unsigned short bf16_t;
typedef short bf16x8 __attribute__((ext_vector_type(8)));
typedef float f32x4 __attribute__((ext_vector_type(4)));
typedef unsigned u32x2 __attribute__((ext_vector_type(2)));
typedef unsigned u32x4 __attribute__((ext_vector_type(4)));
constexpr int BM = 256, BK = 64, HALF = 128, HTB = HALF * BK * 2  , STAGE_BYTES = 8 * HTB, NXCD = 8, WGM = 8;

__host__ __device__ __forceinline__ int lds_byte(int r, int c) { const int st = (r >> 4) * 2 + (c >> 5), rr = r & 15, cc = c & 31, ob = rr * 64 + cc * 2; return st * 1024 + (ob ^ (((ob >> 9) & 1) << 5)); }
__host__ __device__ __forceinline__ void stage_rc(int b, int& R, int& C) { const int st = b / 1024, sb = b % 1024, swz = sb ^ (((sb >> 9) & 1) << 5); R = (st >> 1) * 16 + swz / 64; C = (st & 1) * 32 + (swz % 64) / 2; }
__host__ __device__ __forceinline__ int perm32(int rho) { const int n = rho >> 4, i = rho & 15; return 8 * (i >> 2) + 4 * n + (i & 3); }

struct Unit { int pm, pn; };
struct Gemm { const bf16_t* A; const bf16_t* Bt; int M, N, K, lda, ldb, hsb, tsb, aperm; };

struct StaticOrder {
    int nM, nN, nwg, G, c;
    __host__ __device__ void init(int M, int N, int G_, int c_) { nM = M / BM; nN = N / BM; nwg = nM * nN; G = G_; c = c_; }
    __host__ __device__ bool next(int i, Unit& u) const {
        const long L = (long)i * G + c; if (L >= nwg) return false;
        int wgid = (int)L; { const int q = nwg / NXCD, r = nwg % NXCD, xcd = wgid % NXCD, off = wgid / NXCD; wgid = (xcd < r ? xcd * (q + 1) : r * (q + 1) + (xcd - r) * q) + off; }
        const int nig = WGM * nN, gid = wgid / nig, fm = gid * WGM, gsz = (nM - fm) < WGM ? (nM - fm) : WGM;
        u.pm = fm + ((wgid % nig) % gsz); u.pn = (wgid % nig) / gsz; return true;
    }
    __device__ __forceinline__ void a_ready(const Unit&) const {}
    __device__ __forceinline__ void done(const Unit&) const {}
};


struct ListOrder {
    int base, cnt, nN;
    __host__ __device__ bool next(int i, Unit& u) const { if (i >= cnt) return false; const int id = base + i; u.pm = id / nN; u.pn = id % nN; return true; }
    __device__ __forceinline__ void a_ready(const Unit&) const {}
    __device__ __forceinline__ void done(const Unit&) const {}
};

__device__ __forceinline__ unsigned cvt_pk_bf16(float lo, float hi) { unsigned r; asm volatile("v_cvt_pk_bf16_f32 %0, %1, %2" : "=v"(r) : "v"(lo), "v"(hi)); return r; }

struct EpiF32 {
    static constexpr bool PERM = false, AFTER_DRAIN = false;
    float* C; int ldc;
    __device__ __forceinline__ void operator()(const f32x4 (&acc)[2][2][4][2], const Unit& u, int wr, int wc, int fr, int fq) const {
        const int row0 = u.pm * BM + wr * 64 + fr, col0 = u.pn * BM + wc * 32 + 4 * fq;
#pragma unroll
        for (int ai = 0; ai < 2; ++ai)
#pragma unroll
            for (int m = 0; m < 4; ++m) { float* rowp = C + (size_t)(row0 + ai * HALF + m * 16) * ldc + col0;
#pragma unroll
                for (int bj = 0; bj < 2; ++bj)
#pragma unroll
                    for (int n = 0; n < 2; ++n) *(f32x4*)(rowp + bj * HALF + n * 16) = acc[ai][bj][m][n]; }
    }
};
struct EpiBf16 {
    static constexpr bool PERM = true, AFTER_DRAIN = false;
    bf16_t* O; int ldc;
    __device__ __forceinline__ void operator()(const f32x4 (&acc)[2][2][4][2], const Unit& u, int wr, int wc, int fr, int fq) const {
        const int row0 = u.pm * BM + wr * 64 + fr; const int col0 = u.pn * BM + wc * 32 + 8 * fq;
#pragma unroll
        for (int ai = 0; ai < 2; ++ai)
#pragma unroll
            for (int m = 0; m < 4; ++m) { bf16_t* rowp = O + (size_t)(row0 + ai * HALF + m * 16) * ldc + col0;
#pragma unroll
                for (int bj = 0; bj < 2; ++bj) { const f32x4 v0 = acc[ai][bj][m][0], v1 = acc[ai][bj][m][1];
                    u32x4 w; w.x = cvt_pk_bf16(v0[0], v0[1]); w.y = cvt_pk_bf16(v0[2], v0[3]); w.z = cvt_pk_bf16(v1[0], v1[1]); w.w = cvt_pk_bf16(v1[2], v1[3]);
                    *(u32x4*)(rowp + bj * HALF) = w; } }
    }
};

struct EpiX {
    static constexpr bool PERM = true, AFTER_DRAIN = false;
    bf16_t* O; int ldc; int mode; float* ssq_q; float* ssq_kv; const float* COS; const float* SIN; float qscale;
    __device__ __forceinline__ void operator()(const f32x4 (&acc)[2][2][4][2], const Unit& u, int wr, int wc, int fr, int fq) const {
        const int row0 = u.pm * BM + wr * 64 + fr; const int col0 = u.pn * BM + wc * 32 + 8 * fq;
        const bool do_ssq = (mode == 0) && (u.pn <= 2);
#pragma unroll
        for (int ai = 0; ai < 2; ++ai)
#pragma unroll
            for (int m = 0; m < 4; ++m) { const int row = row0 + ai * HALF + m * 16; bf16_t* rowp = O + (size_t)row * ldc + col0;
                float sc = 1.0f;
                if (mode == 1) sc = rsqrtf(ssq_q[row] * (1.0f / 512.0f) + 1e-6f) * qscale; else if (mode == 2) sc = rsqrtf(ssq_kv[row] * (1.0f / 256.0f) + 1e-6f);
                float ss = 0.f;
#pragma unroll
                for (int bj = 0; bj < 2; ++bj) { f32x4 v0 = acc[ai][bj][m][0] * sc, v1 = acc[ai][bj][m][1] * sc;
                    const int span = u.pn * BM + bj * HALF + wc * 32;
                    int roff = -1;
                    if (mode == 0) { if (span == 768 || span == 800) roff = span - 768; }
                    else if (mode == 1) { const int d = span % 192; if (d >= 128) roff = d - 128; }
                    if (roff >= 0) { const int ib = (roff >> 1) + 4 * fq;
                        const f32x4 cs = *(const f32x4*)(COS + (size_t)row * 32 + ib), sn = *(const f32x4*)(SIN + (size_t)row * 32 + ib);
                        f32x4 w0, w1;
                        w0[0] = v0[0] * cs[0] - v0[1] * sn[0]; w0[1] = v0[0] * sn[0] + v0[1] * cs[0]; w0[2] = v0[2] * cs[1] - v0[3] * sn[1]; w0[3] = v0[2] * sn[1] + v0[3] * cs[1];
                        w1[0] = v1[0] * cs[2] - v1[1] * sn[2]; w1[1] = v1[0] * sn[2] + v1[1] * cs[2]; w1[2] = v1[2] * cs[3] - v1[3] * sn[3]; w1[3] = v1[2] * sn[3] + v1[3] * cs[3];
                        v0 = w0; v1 = w1; }
                    if (do_ssq) ss += ((v0[0] * v0[0] + v0[1] * v0[1]) + (v0[2] * v0[2] + v0[3] * v0[3])) + ((v1[0] * v1[0] + v1[1] * v1[1]) + (v1[2] * v1[2] + v1[3] * v1[3]));
                    u32x4 w; w.x = cvt_pk_bf16(v0[0], v0[1]); w.y = cvt_pk_bf16(v0[2], v0[3]); w.z = cvt_pk_bf16(v1[0], v1[1]); w.w = cvt_pk_bf16(v1[2], v1[3]);
                    *(u32x4*)(rowp + bj * HALF) = w; }
                if (do_ssq) { ss += __shfl_xor(ss, 16); ss += __shfl_xor(ss, 32);
                    if (fq == 0) atomicAdd((u.pn < 2 ? ssq_q : ssq_kv) + row, ss); }
            }
    }
};

struct EpiConv {
    static constexpr bool PERM = true, AFTER_DRAIN = false;
    bf16_t* G; bf16_t* E; const float* cw; const float* cb; int ff, ff2;
    template <int CTRL> static __device__ __forceinline__ float dpp(float x) { return __builtin_bit_cast(float, __builtin_amdgcn_update_dpp(0, __builtin_bit_cast(int, x), CTRL, 0xf, 0xf, true)); }
    static __device__ __forceinline__ float gelu(float x) { const float t = x * x, u = __builtin_fmaf(t, -0.10294324f, -2.3022082f); return x * __builtin_amdgcn_rcpf(1.0f + __builtin_amdgcn_exp2f(x * u)); }
    __device__ __forceinline__ void operator()(const f32x4 (&acc)[2][2][4][2], const Unit& u, int wr, int wc, int fr, int fq) const {
        const int fl = wc * 32 + 8 * fq, f0 = u.pn * HALF + fl;
        constexpr int SHR1 = 0x111, SHL1 = 0x101;
#pragma unroll
        for (int n = 0; n < 2; ++n) {
            const int f = f0 + 4 * n;
            const f32x4 g0 = *(const f32x4*)(cw + f), g1 = *(const f32x4*)(cw + ff2 + f), g2 = *(const f32x4*)(cw + 2 * ff2 + f), gb = *(const f32x4*)(cb + f);
            const f32x4 v0 = *(const f32x4*)(cw + ff + f), v1 = *(const f32x4*)(cw + ff2 + ff + f), v2 = *(const f32x4*)(cw + 2 * ff2 + ff + f), vb = *(const f32x4*)(cb + ff + f);
#pragma unroll
            for (int ai = 0; ai < 2; ++ai) {
                const int grp = u.pm * 4 + ai * 2 + wr;
#pragma unroll
                for (int m = 0; m < 4; ++m) { const int row = u.pm * BM + ai * HALF + wr * 64 + 4 * fr + m;
                    const f32x4 a = acc[ai][0][m][n], b = acc[ai][1][m][n];
                    const f32x4 ap = acc[ai][0][m > 0 ? m - 1 : 3][n], bp = acc[ai][1][m > 0 ? m - 1 : 3][n];
                    const f32x4 an = acc[ai][0][m < 3 ? m + 1 : 0][n], bn = acc[ai][1][m < 3 ? m + 1 : 0][n];
                    float og[4];
#pragma unroll
                    for (int c = 0; c < 4; ++c) {
                        float ga = __builtin_fmaf(g1[c], a[c], gb[c]), va = __builtin_fmaf(v1[c], b[c], vb[c]);
                        ga = __builtin_fmaf(g0[c], m > 0 ? ap[c] : dpp<SHR1>(ap[c]), ga); va = __builtin_fmaf(v0[c], m > 0 ? bp[c] : dpp<SHR1>(bp[c]), va);
                        ga = __builtin_fmaf(g2[c], m < 3 ? an[c] : dpp<SHL1>(an[c]), ga); va = __builtin_fmaf(v2[c], m < 3 ? bn[c] : dpp<SHL1>(bn[c]), va);
                        og[c] = gelu(ga) * va; }
                    uint2 o2; o2.x = cvt_pk_bf16(og[0], og[1]); o2.y = cvt_pk_bf16(og[2], og[3]);
                    *(uint2*)(G + (size_t)row * ff + f) = o2;
                    if ((m < 2 && fr == 0) || (m >= 2 && fr == 15)) {
                        bf16_t* ep = E + ((size_t)(u.pn * 256 + grp) * 4 + m) * 256 + fl + 4 * n;
                        uint2 eg; eg.x = cvt_pk_bf16(a[0], a[1]); eg.y = cvt_pk_bf16(a[2], a[3]); uint2 ev; ev.x = cvt_pk_bf16(b[0], b[1]); ev.y = cvt_pk_bf16(b[2], b[3]);
                        *(uint2*)ep = eg; *(uint2*)(ep + HALF) = ev; }
                }
            }
        }
    }
};
template <class Epi, class Sched, bool ALIGN_EPI = false, bool SP2 = false>
__device__ __forceinline__ void gemm_phase(PG8_LAS unsigned char* lds, const Gemm g, const Sched& S, const Epi& E, const int tid) {
    const int  wid = __builtin_amdgcn_readfirstlane(tid >> 6), lane = tid & 63, wr = wid >> 2, wc = wid & 3, fr = lane & 15, fq = lane >> 4;
    const int K = g.K, nt = K / BK;
    unsigned voffA[2], voffB[2];
#pragma unroll
    for (int i = 0; i < 2; ++i) { int R, C; stage_rc(tid * 16 + i * 8192, R, C); const int Rb = Epi::PERM ? ((R & ~31) + perm32(R & 31)) : R;
        const int Ra = g.aperm ? ((R & ~63) + 4 * (R & 15) + ((R >> 4) & 3)) : R;
        voffA[i] = (unsigned)(Ra * g.lda + C) * 2u; voffB[i] = (unsigned)(Rb * g.ldb + C) * 2u; }
    const __amdgpu_buffer_rsrc_t srdA = __builtin_amdgcn_make_buffer_rsrc((void*)g.A, 0, -1, 0x00020000), srdB = __builtin_amdgcn_make_buffer_rsrc((void*)g.Bt, 0, -1, 0x00020000);
    const unsigned kstep = (unsigned)(BK * 2);
    const unsigned hsA = (unsigned)HALF * g.lda * 2, hsB = (unsigned)g.hsb * g.ldb * 2;
    const unsigned tsA = 2 * hsA, tsB = (unsigned)g.tsb * g.ldb * 2;
    const unsigned ldsw = (unsigned)wid * 1024u;
    const int aoff = lds_byte(wr * 64 + fr, fq * 8), boff = lds_byte(wc * 32 + fr, fq * 8);
#define PG8_SA(b, h) (((b) * 2 + (h)) * HTB)
#define PG8_SB(b, h) ((4 + (b) * 2 + (h)) * HTB)
#define PG8_SRD_voffA srdA
#define PG8_SRD_voffB srdB
#define PG8_STAGE(bufoff, soff, voff) do { _Pragma("unroll") for (int _i = 0; _i < 2; ++_i) \
        __builtin_amdgcn_raw_ptr_buffer_load_lds(PG8_SRD_##voff, (PG8_LAS void*)(lds + (bufoff) + ldsw + _i * 8192), 16, (voff)[_i], (soff), 0, 0); } while (0)
#define PG8_LDA(dst, b, h) do { _Pragma("unroll") for (int m = 0; m < 4; ++m) _Pragma("unroll") for (int k = 0; k < 2; ++k) dst[m][k] = *(const PG8_LAS bf16x8*)(lds + PG8_SA(b, h) + aoff + m * 2048 + k * 1024); } while (0)
#define PG8_LDB(dst, b, h) do { _Pragma("unroll") for (int n = 0; n < 2; ++n) _Pragma("unroll") for (int k = 0; k < 2; ++k) dst[n][k] = *(const PG8_LAS bf16x8*)(lds + PG8_SB(b, h) + boff + n * 2048 + k * 1024); } while (0)
#define PG8_MMA(ai, bj, At, Bt) do { __builtin_amdgcn_s_setprio(1); _Pragma("unroll") for (int m = 0; m < 4; ++m) _Pragma("unroll") for (int n = 0; n < 2; ++n) _Pragma("unroll") for (int k = 0; k < 2; ++k) \
        acc[ai][bj][m][n] = __builtin_amdgcn_mfma_f32_16x16x32_bf16(Bt[n][k], At[m][k], acc[ai][bj][m][n], 0, 0, 0); __builtin_amdgcn_s_setprio(0); } while (0)
#define PG8_WAIT_V(n) asm volatile("s_waitcnt vmcnt(" #n ")" ::: "memory")
#define PG8_WAIT_L(n) asm volatile("s_waitcnt lgkmcnt(" #n ")" ::: "memory")
#define PG8_BAR __builtin_amdgcn_s_barrier()
#define PG8_SCHED __builtin_amdgcn_sched_barrier(0)
    Unit cur, nxt; int ui = 0;
    if (!S.next(0, cur)) return;
    f32x4 acc[2][2][4][2];
#pragma unroll
    for (int a = 0; a < 2; ++a)
#pragma unroll
        for (int b = 0; b < 2; ++b)
#pragma unroll
            for (int m = 0; m < 4; ++m)
#pragma unroll
                for (int n = 0; n < 2; ++n) acc[a][b][m][n] = (f32x4){0.f, 0.f, 0.f, 0.f};
    bf16x8 At[4][2], B0[2][2], B1[2][2];
    unsigned cA = (unsigned)cur.pm * tsA, cB = (unsigned)cur.pn * tsB;
    S.a_ready(cur);
    if constexpr (SP2) {
        PG8_STAGE(PG8_SB(0, 0), cB, voffB); PG8_STAGE(PG8_SB(0, 1), cB + hsB, voffB); PG8_STAGE(PG8_SA(0, 0), cA, voffA); PG8_STAGE(PG8_SA(0, 1), cA + hsA, voffA);
        if (wr == 1) PG8_BAR;
        PG8_WAIT_V(2); PG8_BAR;
        PG8_STAGE(PG8_SB(1, 0), cB + kstep, voffB); PG8_STAGE(PG8_SA(1, 0), cA + kstep, voffA); PG8_STAGE(PG8_SB(1, 1), cB + hsB + kstep, voffB);
        PG8_WAIT_V(6); PG8_BAR;
    } else {
        PG8_STAGE(PG8_SB(0, 0), cB, voffB); PG8_STAGE(PG8_SA(0, 0), cA, voffA); PG8_STAGE(PG8_SB(0, 1), cB + hsB, voffB); PG8_STAGE(PG8_SA(0, 1), cA + hsA, voffA);
        if (wr == 1) PG8_BAR;
        PG8_WAIT_V(4); PG8_BAR;
        PG8_STAGE(PG8_SB(1, 0), cB + kstep, voffB); PG8_STAGE(PG8_SA(1, 0), cA + kstep, voffA); PG8_STAGE(PG8_SB(1, 1), cB + hsB + kstep, voffB);
        PG8_WAIT_V(6); PG8_BAR;
    }
    for (;;) {
        const bool has_next = S.next(ui + 1, nxt);
        const unsigned nA = has_next ? (unsigned)nxt.pm * tsA : cA, nB = has_next ? (unsigned)nxt.pn * tsB : cB;
        for (int t = 0; t < nt; t += 2) {
            const bool last = (t == nt - 2);
            const unsigned a1 = cA + (unsigned)(t + 1) * kstep;
            const unsigned a2 = last ? nA : cA + (unsigned)(t + 2) * kstep, b2 = last ? nB : cB + (unsigned)(t + 2) * kstep;
            const unsigned a3 = a2 + kstep, b3 = b2 + kstep;
            if (last && has_next) S.a_ready(nxt);
            if constexpr (SP2) {
            PG8_LDB(B0, 0, 0); PG8_LDB(B1, 0, 1); PG8_SCHED; PG8_LDA(At, 0, 0); PG8_STAGE(PG8_SA(1, 1), a1 + hsA, voffA);
            PG8_WAIT_V(8); PG8_WAIT_L(0); PG8_BAR; PG8_MMA(0, 0, At, B0); PG8_MMA(0, 1, At, B1); PG8_BAR; PG8_SCHED;
            PG8_LDA(At, 0, 1); PG8_STAGE(PG8_SB(0, 0), b2, voffB); PG8_STAGE(PG8_SB(0, 1), b2 + hsB, voffB); PG8_STAGE(PG8_SA(0, 0), a2, voffA);
            PG8_WAIT_V(8); PG8_WAIT_L(0); PG8_BAR; PG8_MMA(1, 0, At, B0); PG8_MMA(1, 1, At, B1); PG8_BAR; PG8_SCHED;
            PG8_LDB(B0, 1, 0); PG8_LDB(B1, 1, 1); PG8_SCHED; PG8_LDA(At, 1, 0); PG8_STAGE(PG8_SA(0, 1), a2 + hsA, voffA);
            PG8_WAIT_V(8); PG8_WAIT_L(0); PG8_BAR; PG8_MMA(0, 0, At, B0); PG8_MMA(0, 1, At, B1); PG8_BAR; PG8_SCHED;
            PG8_LDA(At, 1, 1); PG8_STAGE(PG8_SB(1, 0), b3, voffB); PG8_STAGE(PG8_SB(1, 1), b3 + hsB, voffB); PG8_STAGE(PG8_SA(1, 0), a3, voffA);
            PG8_WAIT_V(8); PG8_WAIT_L(0); PG8_BAR; PG8_MMA(1, 0, At, B0); PG8_MMA(1, 1, At, B1); PG8_BAR; PG8_SCHED;
            } else {
            PG8_LDB(B0, 0, 0); PG8_SCHED; PG8_LDA(At, 0, 0); PG8_STAGE(PG8_SA(1, 1), a1 + hsA, voffA);
            PG8_WAIT_L(8); PG8_BAR; PG8_WAIT_L(0); PG8_MMA(0, 0, At, B0); PG8_BAR; PG8_SCHED;
            PG8_LDB(B1, 0, 1); PG8_STAGE(PG8_SB(0, 0), b2, voffB);
            PG8_BAR; PG8_WAIT_L(0); PG8_MMA(0, 1, At, B1); PG8_BAR;
            PG8_LDA(At, 0, 1); PG8_STAGE(PG8_SA(0, 0), a2, voffA);
            PG8_BAR; PG8_WAIT_L(0); PG8_MMA(1, 0, At, B0); PG8_BAR; PG8_SCHED;
            PG8_STAGE(PG8_SB(0, 1), b2 + hsB, voffB);
            PG8_WAIT_V(6); PG8_BAR; PG8_MMA(1, 1, At, B1); PG8_BAR;
            PG8_LDB(B0, 1, 0); PG8_SCHED; PG8_LDA(At, 1, 0); PG8_STAGE(PG8_SA(0, 1), a2 + hsA, voffA);
            PG8_WAIT_L(8); PG8_BAR; PG8_WAIT_L(0); PG8_MMA(0, 0, At, B0); PG8_BAR; PG8_SCHED;
            PG8_LDB(B1, 1, 1); PG8_STAGE(PG8_SB(1, 0), b3, voffB);
            PG8_BAR; PG8_WAIT_L(0); PG8_MMA(0, 1, At, B1); PG8_BAR;
            PG8_LDA(At, 1, 1); PG8_STAGE(PG8_SA(1, 0), a3, voffA);
            PG8_BAR; PG8_WAIT_L(0); PG8_MMA(1, 0, At, B0); PG8_BAR; PG8_SCHED;
            PG8_STAGE(PG8_SB(1, 1), b3 + hsB, voffB);
            PG8_WAIT_V(6); PG8_BAR; PG8_MMA(1, 1, At, B1); PG8_BAR;
            }
        }
        if constexpr (ALIGN_EPI) { if (wr == 0) PG8_BAR; }
        if constexpr (!Epi::AFTER_DRAIN) { E(acc, cur, wr, wc, fr, fq); S.done(cur); }
        if (!has_next) break;
#pragma unroll
        for (int a = 0; a < 2; ++a)
#pragma unroll
            for (int b = 0; b < 2; ++b)
#pragma unroll
                for (int m = 0; m < 4; ++m)
#pragma unroll
                    for (int n = 0; n < 2; ++n) acc[a][b][m][n] = (f32x4){0.f, 0.f, 0.f, 0.f};
        cur = nxt; cA = nA; cB = nB; ++ui;
        if constexpr (ALIGN_EPI) { if (wr == 1) PG8_BAR; }
    }
    PG8_WAIT_V(0);
    if constexpr (!ALIGN_EPI) { if (wr == 0) PG8_BAR; }
    PG8_BAR;
    if constexpr (Epi::AFTER_DRAIN) { E.fused(acc, cur, wr, wc, fr, fq, lds, wid, lane); S.done(cur); }
#undef PG8_SA
#undef PG8_SB
#undef PG8_STAGE
#undef PG8_SRD_voffA
#undef PG8_SRD_voffB
#undef PG8_LDA
#undef PG8_LDB
#undef PG8_MMA
#undef PG8_WAIT_V
#undef PG8_WAIT_L
#undef PG8_BAR
#undef PG8_SCHED
}
}
#define GAS __attribute__((address_space(1)))
#define LAS __attribute__((address_space(3)))
typedef unsigned short bf16;
typedef unsigned v4u __attribute__((ext_vector_type(4)));
typedef float f32x4 __attribute__((ext_vector_type(4)));
typedef short bf16x8 __attribute__((ext_vector_type(8)));
typedef GAS unsigned gu32;
typedef GAS unsigned long long gu64;
#define RLX_AGENT __ATOMIC_RELAXED, __HIP_MEMORY_SCOPE_AGENT
#define LDS_WAIT() asm volatile("s_waitcnt lgkmcnt(0)" ::: "memory")
#define VM_WAIT() asm volatile("s_waitcnt vmcnt(0)" ::: "memory")
__device__ __forceinline__ unsigned long long rt() { return __builtin_amdgcn_s_memrealtime(); }
__device__ __forceinline__ unsigned f2bf(float f) { unsigned u = __builtin_bit_cast(unsigned, f); return (u + 0x7fffu + ((u >> 16) & 1u)) >> 16; }
__device__ __forceinline__ unsigned pk2(float lo, float hi) { return f2bf(lo) | (f2bf(hi) << 16); }

#define XB_TMO      128
#define XB_XCNT(j)  (256  + 64 * (j))
#define XB_XSUB(j)  (1280 + 64 * (j))
#define XB_XGEN(j)  (2304 + 64 * (j))
#define XB_TOP      3328
#define XB_TOPGEN   3392
#define XCD_BAR_WORDS 3456
#define XB_SPIN_CAP (1u << 18)

__device__ __forceinline__ unsigned xb_ld(unsigned* p)              { return __hip_atomic_load(p, __ATOMIC_RELAXED, __HIP_MEMORY_SCOPE_AGENT); }
__device__ __forceinline__ unsigned xb_add(unsigned* p, unsigned v) { return __hip_atomic_fetch_add(p, v, __ATOMIC_RELAXED, __HIP_MEMORY_SCOPE_AGENT); }
__device__ __forceinline__ unsigned xb_xcc_id() { return (unsigned)__builtin_amdgcn_s_getreg((3 << 11) | 20) & 0xFu; }
#define XB_SPIN(cond, bar) do { unsigned _sp = 0; while (cond) { __builtin_amdgcn_s_sleep(1); \
    if ((++_sp & 255u) == 0u) { if (xb_ld(&(bar)[XB_TMO])) break; if (_sp > XB_SPIN_CAP) { atomicAdd(&(bar)[XB_TMO], 1u); break; } } } } while (0)

struct XcdBarrier {
    unsigned* bar; unsigned x;
    volatile LAS unsigned* st;
};

__device__ __forceinline__ XcdBarrier xcd_barrier_post(unsigned* bar, volatile LAS unsigned* st, int tid) {
    XcdBarrier b; b.bar = bar; b.x = xb_xcc_id(); b.st = st;
    if (tid == 0) (void)xb_add(&bar[XB_XCNT(b.x)], 1u);
    return b;
}
__device__ __forceinline__ void xcd_barrier_complete(unsigned* bar, unsigned x, unsigned& nloc, unsigned& nx) {
    const unsigned G = gridDim.x * gridDim.y * gridDim.z;
    unsigned sum, cnt, mine, sp = 0u;
    for (;;) {
        sum = 0u; cnt = 0u; mine = 0u;
#pragma unroll
        for (unsigned j = 0; j < 16; ++j) { const unsigned c = xb_ld(&bar[XB_XCNT(j)]); sum += c; cnt += (c > 0u) ? 1u : 0u; mine = (j == x) ? c : mine; }
        if (sum == G) break;
        __builtin_amdgcn_s_sleep(1);
        if ((++sp & 255u) == 0u) { if (xb_ld(&bar[XB_TMO])) break; if (sp > XB_SPIN_CAP) { atomicAdd(&bar[XB_TMO], 1u); break; } }
    }
    nloc = mine > 0u ? mine : 1u; nx = cnt > 0u ? cnt : 1u;
}

__device__ __forceinline__ void xcd_barrier(const XcdBarrier& b, int tid) {
    asm volatile("s_waitcnt vmcnt(0)" ::: "memory");
    __syncthreads();
    if (tid == 0) {
        unsigned* bar = b.bar;
        __builtin_amdgcn_s_waitcnt(0);
        unsigned nloc = b.st[0], nx = b.st[1];
        if (nloc == 0u) { xcd_barrier_complete(bar, b.x, nloc, nx); b.st[0] = nloc; b.st[1] = nx; }
        const unsigned old = xb_add(&bar[XB_XSUB(b.x)], 1u);
        const unsigned gen = old / nloc;
        if (old + 1u == (gen + 1u) * nloc) {
            __builtin_amdgcn_fence(__ATOMIC_RELEASE, "agent");
            asm volatile("s_waitcnt vmcnt(0)" ::: "memory");
            const unsigned og = xb_add(&bar[XB_TOP], 1u);
            const unsigned tg = og / nx;
            if (og + 1u == (tg + 1u) * nx) xb_add(&bar[XB_TOPGEN], 1u);
            else XB_SPIN(xb_ld(&bar[XB_TOPGEN]) == tg, bar);
            __builtin_amdgcn_fence(__ATOMIC_ACQUIRE, "agent");
            xb_add(&bar[XB_XGEN(b.x)], 1u);
            asm volatile("s_waitcnt vmcnt(0)" ::: "memory");
        } else {
            XB_SPIN(xb_ld(&bar[XB_XGEN(b.x)]) == gen, bar);
            __builtin_amdgcn_fence(__ATOMIC_ACQUIRE, "agent");
            asm volatile("s_waitcnt vmcnt(0)" ::: "memory");
        }
    }
    __syncthreads();
}

constexpr int NWAVES = 8, NTHREADS = 512;
constexpr int BATCH = 8, SEQ = 2048, DM = 2048, M = BATCH * SEQ;
constexpr int INW = 3904, INWP = 4096;
constexpr int QW = 1536, KVW = 2048, FF = 5632, FF2 = 11264, NMOD = 12288;
constexpr int C_QLAT = 0, C_KVLAT = 512, C_KROPE = 768, C_DQ = 832, C_DK = 1856, C_DV = 2880;
constexpr int MOD_SHA = 0, MOD_SCA = 2048, MOD_GA = 4096, MOD_SHF = 6144, MOD_SCF = 8192, MOD_GF = 10240;
constexpr float EPS = 1e-6f, MLA_SCALE = 0.07216878364870322f, DIFF_SCALE = 0.125f, LAMBDA_INIT = 0.2f;
constexpr int UCH = 4096, NUCH = M / UCH;

constexpr size_t MiB = 1u << 20;
constexpr size_t WS_CTL = 0, CTL_ZERO_BYTES = 1 * MiB, WS_MOD = 512 * 1024, WS_SSQQ = 128 * 1024, WS_SSQKV = 192 * 1024;
constexpr int TKF_OFF = 1024;
constexpr size_t WS_COS = 2 * MiB, WS_SIN = 4 * MiB, WS_TK = 6 * MiB;
constexpr size_t WS_WIN = 8 * MiB, WS_WUQ = 24 * MiB, WS_WUKV = 26 * MiB, WS_WO = 28 * MiB, WS_WUP = 36 * MiB, WS_WDN = 80 * MiB;
constexpr size_t WS_H = 104 * MiB;
constexpr size_t WS_PROJ = 168 * MiB, WS_Q = 296 * MiB, WS_KV = 344 * MiB, WS_AO = 408 * MiB;
constexpr size_t WS_Y = 168 * MiB;
constexpr size_t WS_G = 168 * MiB;
constexpr size_t WS_E = 344 * MiB;
constexpr size_t WS_Y2 = 344 * MiB;
constexpr size_t WS_X1 = 408 * MiB;
constexpr size_t WS_END = 512 * MiB;
constexpr int CW_TMO = 0, CW_CODE = 1, CW_BAR = 4096;

constexpr int LDS_BYTES = 147456;
constexpr int LDSCTL_OFF = LDS_BYTES - 512, MISC_OFF = LDSCTL_OFF;

__device__ __forceinline__ float bf2f(unsigned short u) { return __uint_as_float((unsigned)u << 16); }
__device__ __forceinline__ float bflo(unsigned w) { return __uint_as_float(w << 16); }
__device__ __forceinline__ float bfhi(unsigned w) { return __uint_as_float(w & 0xffff0000u); }
__device__ __forceinline__ float wave_sum(float v) {
#pragma unroll
    for (int o = 1; o < 64; o <<= 1) v += __shfl_xor(v, o);
    return v;
}
__device__ __forceinline__ float wave_max(float v) {
#pragma unroll
    for (int o = 1; o < 64; o <<= 1) v = fmaxf(v, __shfl_xor(v, o));
    return v;
}
__device__ __forceinline__ int t5_bucket(int rel) {
    const int ret = rel > 0 ? 16 : 0; const int n = rel < 0 ? -rel : rel; const float nf = (float)(n > 1 ? n : 1);
    int large = 8 + (int)(logf(nf / 8.0f) / 2.772588722239781f * 8.0f);
    large = large < 15 ? large : 15;
    return ret + (n < 8 ? n : large);
}
__device__ __forceinline__ float gelu_tanh(float x) {
    const float z2 = 1.5957691216057308f * (x + 0.044715f * x * x * x);
    return x / (1.0f + __expf(-z2));
}


constexpr int PTR_OFF = LDSCTL_OFF + 128;
enum { P_X = 0, P_C, P_POS, P_RELB, P_ADAW, P_ADAB, P_APRE, P_APOST, P_WIN, P_QN, P_WUQ, P_KVN, P_WUKV, P_LQ1, P_LK1, P_LQ2, P_LK2, P_SUBLN, P_WO, P_FPRE, P_FPOST, P_WUP, P_CW, P_CB, P_WDN, P_OUT, P_WS };
__device__ __forceinline__ const void* ldptr(LAS unsigned char* lds, int i) {
    const unsigned long long v = *(volatile LAS unsigned long long*)(lds + PTR_OFF + 8 * i);
    const unsigned lo = __builtin_amdgcn_readfirstlane((unsigned)v), hi = __builtin_amdgcn_readfirstlane((unsigned)(v >> 32));
    return (const void*)(GAS const void*)(((unsigned long long)hi << 32) | lo);
}
#define LPF(i) ((const float*)ldptr(lds, (i)))
#define LPWS() ((unsigned char*)ldptr(lds, P_WS))

__device__ __forceinline__ int dst_row(int s, int map) {
    if (map == 1) { if (s >= C_KROPE && s < C_KROPE + 64) { const int d = s - C_KROPE; return C_KROPE + 2 * (d & 31) + (d >> 5); } return s; }
    if (map == 2) { const int h = s / 192, d = s % 192; if (d >= 128) return h * 192 + 128 + 2 * ((d - 128) & 31) + ((d - 128) >> 5); return s; }
    return s;
}
__device__ __forceinline__ void p0_transpose_item(const float* W, const float* sv, int K, int N, bf16* WT, LAS float* scr, int item, int lane, int map) {
    const int nblk = N / 64, kb = item / nblk, nb = item % nblk, k0 = 64 * kb, n0 = 64 * nb;
    const int lr = lane >> 4, lc = (lane & 15) * 4;
    f32x4 v[16];
#pragma unroll
    for (int i = 0; i < 16; ++i) v[i] = __builtin_nontemporal_load((const f32x4*)(W + (size_t)(k0 + 4 * i + lr) * N + n0 + lc));
#pragma unroll
    for (int i = 0; i < 16; ++i) { const int kk = 4 * i + lr; f32x4 w = v[i]; if (sv) w = w * sv[k0 + kk];
        LAS float* d = scr + kk * 65 + lc; d[0] = w[0]; d[1] = w[1]; d[2] = w[2]; d[3] = w[3]; }
    LDS_WAIT(); asm volatile("" ::: "memory");
    const int c = lane & 7;
#pragma unroll
    for (int j = 0; j < 8; ++j) { const int n = (lane >> 3) + 8 * j; const LAS float* s = scr + (8 * c) * 65 + n;
        v4u o; o.x = pk2(s[0 * 65], s[1 * 65]); o.y = pk2(s[2 * 65], s[3 * 65]); o.z = pk2(s[4 * 65], s[5 * 65]); o.w = pk2(s[6 * 65], s[7 * 65]);
        __builtin_nontemporal_store(o, (GAS v4u*)(WT + (size_t)dst_row(n0 + n, map) * K + k0 + 8 * c)); }
    LDS_WAIT(); asm volatile("" ::: "memory");
}
__device__ __forceinline__ void p0_prologue(LAS unsigned char* lds, int tid, int lane, int wave, int G, int bid) {
    { unsigned char* ws = LPWS(); float* mod = (float*)(ws + WS_MOD); const float* in_c = LPF(P_C); const float* in_adaw = LPF(P_ADAW); const float* in_adab = LPF(P_ADAB);
    for (int item = bid; item < 256; item += G) {
        const int kc = item >> 5, cc = item & 31;
        LAS float* scl = (LAS float*)lds;
        LAS float* red = (LAS float*)(lds + 8192);
        for (int e = tid; e < 2048; e += NTHREADS) { const int b = e >> 8, i = e & 255; const float cv = in_c[b * DM + 256 * kc + i]; scl[e] = cv / (1.0f + __expf(-cv)); }
        __syncthreads();
        if (tid < 384) {
            const int kg = tid / 96, ct = tid % 96;
            f32x4 acc[8];
#pragma unroll
            for (int b = 0; b < 8; ++b) acc[b] = (f32x4){0.f, 0.f, 0.f, 0.f};
            const float* wp = in_adaw + (size_t)(256 * kc + 64 * kg) * NMOD + 384 * cc + 4 * ct;
#pragma unroll 8
            for (int kk = 0; kk < 64; ++kk) {
                const f32x4 w = __builtin_nontemporal_load((const f32x4*)(wp + (size_t)kk * NMOD));
#pragma unroll
                for (int b = 0; b < 8; ++b) acc[b] += w * scl[b * 256 + 64 * kg + kk];
            }
#pragma unroll
            for (int b = 0; b < 8; ++b) *(LAS f32x4*)(red + (kg * 8 + b) * 384 + 4 * ct) = acc[b];
        }
        __syncthreads();
        for (int o = tid; o < 3072; o += NTHREADS) { const int b = o / 384, col = o % 384;
            float v = (red[(0 * 8 + b) * 384 + col] + red[(1 * 8 + b) * 384 + col]) + (red[(2 * 8 + b) * 384 + col] + red[(3 * 8 + b) * 384 + col]);
            if (kc == 0) v += in_adab[384 * cc + col];
            atomicAdd(mod + b * NMOD + 384 * cc + col, v); }
        __syncthreads();
    } }
    unsigned char* ws = LPWS();
    LAS float* scr = (LAS float*)(lds + wave * 16640);
    const int gw = bid * NWAVES + wave, NGW = G * NWAVES;
    constexpr int I_IN = (DM / 64) * (INW / 64), I_UQ = (512 / 64) * (QW / 64), I_UKV = (256 / 64) * (KVW / 64), I_O = (DM / 64) * (DM / 64), I_UP = (DM / 64) * (FF2 / 64), I_DN = (FF / 64) * (DM / 64);
    const int NITEMS = (G == 256) ? I_IN + I_UQ + I_UKV : I_IN + I_UQ + I_UKV + I_O + I_UP + I_DN;
    for (int it = gw; it < NITEMS; it += NGW) {
        int r = it;
        if (r < I_IN) { p0_transpose_item(LPF(P_WIN), nullptr, DM, INW, (bf16*)(ws + WS_WIN), scr, r, lane, 1); continue; } r -= I_IN;
        if (r < I_UQ) { p0_transpose_item(LPF(P_WUQ), LPF(P_QN), 512, QW, (bf16*)(ws + WS_WUQ), scr, r, lane, 2); continue; } r -= I_UQ;
        if (r < I_UKV) { p0_transpose_item(LPF(P_WUKV), LPF(P_KVN), 256, KVW, (bf16*)(ws + WS_WUKV), scr, r, lane, 0); continue; } r -= I_UKV;
        if (r < I_O) { p0_transpose_item(LPF(P_WO), nullptr, DM, DM, (bf16*)(ws + WS_WO), scr, r, lane, 0); continue; } r -= I_O;
        if (r < I_UP) { p0_transpose_item(LPF(P_WUP), nullptr, DM, FF2, (bf16*)(ws + WS_WUP), scr, r, lane, 0); continue; } r -= I_UP;
        p0_transpose_item(LPF(P_WDN), nullptr, FF, DM, (bf16*)(ws + WS_WDN), scr, r, lane, 0);
    }
    { v4u* z = (v4u*)(ws + WS_WIN + (size_t)INW * DM * 2); const v4u zero = {0u, 0u, 0u, 0u};
      for (int i = bid * NTHREADS + tid; i < (INWP - INW) * DM * 2 / 16; i += G * NTHREADS) z[i] = zero; }
    { float* COS = (float*)(ws + WS_COS); float* SIN = (float*)(ws + WS_SIN); const int* in_pos = (const int*)ldptr(lds, P_POS);
      for (int idx = bid * NTHREADS + tid; idx < M * 32; idx += G * NTHREADS) {
          const int m = idx >> 5, i = idx & 31;
          const float inv = 1.0f / exp2f((float)i * (13.287712379549449f / 32.0f));
          const float ang = (float)in_pos[m] * inv;
          double t = (double)ang * 0.15915494309189535; t -= rint(t);
          const float tf = (float)t;
          COS[idx] = __builtin_amdgcn_cosf(tf); SIN[idx] = __builtin_amdgcn_sinf(tf); } }
    { int* TK = (int*)(ws + WS_TK); const int* in_pos = (const int*)ldptr(lds, P_POS);
      for (int it = gw; it < BATCH * (SEQ / 64); it += NGW) { const int p = in_pos[it * 64 + lane]; int mn = p, mx = p;
#pragma unroll
          for (int of = 1; of < 64; of <<= 1) { mn = min(mn, __shfl_xor(mn, of)); mx = max(mx, __shfl_xor(mx, of)); }
          const bool cont = __all(p - lane == __builtin_amdgcn_readfirstlane(p));
          if (lane == 0) { TK[2 * it] = mn; TK[2 * it + 1] = mx; TK[TKF_OFF + it] = cont ? 1 : 0; } } }
}

__device__ __forceinline__ void prenorm_phase(const float* x, const float* wn, const float* mod, int off_sh, int off_sc, bf16* H, int lane, int wave, int G, int bid) {
    const int gw = bid * NWAVES + wave, NGW = G * NWAVES;
    const int rpw = M / NGW;
    if (rpw * NGW == M && rpw > 0 && (SEQ % rpw) == 0) {
        const int m0 = gw * rpw; const float* mb = mod + (size_t)(m0 >> 11) * NMOD;
        f32x4 cc[8], sh[8];
#pragma unroll
        for (int j = 0; j < 8; ++j) { const int col = (lane + 64 * j) * 4; cc[j] = *(const f32x4*)(wn + col) * (*(const f32x4*)(mb + off_sc + col) + 1.0f); sh[j] = *(const f32x4*)(mb + off_sh + col); }
        for (int r = 0; r < rpw; ++r) { const int m = m0 + r;
            const f32x4* xr = (const f32x4*)(x + (size_t)m * DM) + lane;
            f32x4 v[8]; float ss = 0.f;
#pragma unroll
            for (int j = 0; j < 8; ++j) { v[j] = __builtin_nontemporal_load(xr + 64 * j); ss += (v[j].x * v[j].x + v[j].y * v[j].y) + (v[j].z * v[j].z + v[j].w * v[j].w); }
            const float rstd = rsqrtf(wave_sum(ss) * (1.0f / DM) + EPS);
#pragma unroll
            for (int j = 0; j < 8; ++j) { const int col = (lane + 64 * j) * 4;
                const f32x4 o = v[j] * rstd * cc[j] + sh[j];
                uint2 pk; pk.x = pk2(o.x, o.y); pk.y = pk2(o.z, o.w);
                *(uint2*)(H + (size_t)m * DM + col) = pk; } }
        return;
    }
    for (int m = gw; m < M; m += NGW) {
        const f32x4* xr = (const f32x4*)(x + (size_t)m * DM) + lane;
        f32x4 v[8]; float ss = 0.f;
#pragma unroll
        for (int j = 0; j < 8; ++j) { v[j] = __builtin_nontemporal_load(xr + 64 * j); ss += (v[j].x * v[j].x + v[j].y * v[j].y) + (v[j].z * v[j].z + v[j].w * v[j].w); }
        const float rstd = rsqrtf(wave_sum(ss) * (1.0f / DM) + EPS);
        const float* mb = mod + (size_t)(m >> 11) * NMOD;
#pragma unroll
        for (int j = 0; j < 8; ++j) { const int col = (lane + 64 * j) * 4;
            const f32x4 w = *(const f32x4*)(wn + col), sh = *(const f32x4*)(mb + off_sh + col), sc = *(const f32x4*)(mb + off_sc + col);
            const f32x4 o = v[j] * rstd * w * (sc + 1.0f) + sh;
            uint2 pk; pk.x = pk2(o.x, o.y); pk.y = pk2(o.z, o.w);
            *(uint2*)(H + (size_t)m * DM + col) = pk; }
    }
}
template <bool NEXT>
__device__ __forceinline__ void post_phase(const bf16* Y, const void* xin_, void* xout_, const float* wpost, const float* mod, int off_g,
                                           const float* wn2, int off_sh, int off_sc, bf16* Hn, int lane, int wave, int G, int bid) {
    const int gw = bid * NWAVES + wave, NGW = G * NWAVES;
    const int rpw = M / NGW;
    if (rpw * NGW == M && rpw > 0 && (SEQ % rpw) == 0) {
        const int m0 = gw * rpw; const float* mb = mod + (size_t)(m0 >> 11) * NMOD;
        f32x4 gwv[8], c2[8], s2[8];
#pragma unroll
        for (int j = 0; j < 8; ++j) { const int col = (lane + 64 * j) * 4; gwv[j] = *(const f32x4*)(wpost + col) * *(const f32x4*)(mb + off_g + col);
            if constexpr (NEXT) { c2[j] = *(const f32x4*)(wn2 + col) * (*(const f32x4*)(mb + off_sc + col) + 1.0f); s2[j] = *(const f32x4*)(mb + off_sh + col); } }
        for (int r = 0; r < rpw; ++r) { const int m = m0 + r;
            const uint2* yr = (const uint2*)(Y + (size_t)m * DM) + lane;
            const f32x4* xr = (const f32x4*)((const float*)xin_ + (size_t)m * DM) + lane;
            const uint2* xb = (const uint2*)((const bf16*)xin_ + (size_t)m * DM) + lane;
            f32x4 v[8]; float ss = 0.f;
            unsigned long long yq[8]; f32x4 xf[8]; unsigned long long xq[8];
#pragma unroll
            for (int j = 0; j < 8; ++j) yq[j] = __builtin_nontemporal_load((const unsigned long long*)(yr + 64 * j));
#pragma unroll
            for (int j = 0; j < 8; ++j) { if constexpr (NEXT) xf[j] = __builtin_nontemporal_load(xr + 64 * j); else xq[j] = __builtin_nontemporal_load((const unsigned long long*)(xb + 64 * j)); }
#pragma unroll
            for (int j = 0; j < 8; ++j) { const unsigned y0 = (unsigned)yq[j], y1 = (unsigned)(yq[j] >> 32);
                v[j] = (f32x4){bflo(y0), bfhi(y0), bflo(y1), bfhi(y1)}; ss += (v[j].x * v[j].x + v[j].y * v[j].y) + (v[j].z * v[j].z + v[j].w * v[j].w); }
            const float rstd = rsqrtf(wave_sum(ss) * (1.0f / DM) + EPS);
            float ss2 = 0.f;
#pragma unroll
            for (int j = 0; j < 8; ++j) { const int col = (lane + 64 * j) * 4;
                f32x4 xv;
                if constexpr (NEXT) xv = xf[j];
                else { const unsigned x0 = (unsigned)xq[j], x1 = (unsigned)(xq[j] >> 32); xv = (f32x4){bflo(x0), bfhi(x0), bflo(x1), bfhi(x1)}; }
                const f32x4 o = xv + gwv[j] * (v[j] * rstd);
                v[j] = o; ss2 += (o.x * o.x + o.y * o.y) + (o.z * o.z + o.w * o.w);
                if constexpr (NEXT) { uint2 pk; pk.x = pk2(o.x, o.y); pk.y = pk2(o.z, o.w); *(uint2*)((bf16*)xout_ + (size_t)m * DM + col) = pk; }
                else *(f32x4*)((float*)xout_ + (size_t)m * DM + col) = o; }
            if constexpr (NEXT) {
                const float rstd2 = rsqrtf(wave_sum(ss2) * (1.0f / DM) + EPS);
#pragma unroll
                for (int j = 0; j < 8; ++j) { const int col = (lane + 64 * j) * 4;
                    const f32x4 o = v[j] * rstd2 * c2[j] + s2[j];
                    uint2 pk; pk.x = pk2(o.x, o.y); pk.y = pk2(o.z, o.w);
                    *(uint2*)(Hn + (size_t)m * DM + col) = pk; }
            } }
        return;
    }
    for (int m = gw; m < M; m += NGW) {
        const uint2* yr = (const uint2*)(Y + (size_t)m * DM) + lane;
        const f32x4* xr = (const f32x4*)((const float*)xin_ + (size_t)m * DM) + lane;
        const uint2* xb = (const uint2*)((const bf16*)xin_ + (size_t)m * DM) + lane;
        f32x4 v[8]; float ss = 0.f;
#pragma unroll
        for (int j = 0; j < 8; ++j) { const unsigned long long yq_ = __builtin_nontemporal_load((const unsigned long long*)(yr + 64 * j)); uint2 yw; yw.x = (unsigned)yq_; yw.y = (unsigned)(yq_ >> 32); v[j] = (f32x4){bflo(yw.x), bfhi(yw.x), bflo(yw.y), bfhi(yw.y)}; ss += (v[j].x * v[j].x + v[j].y * v[j].y) + (v[j].z * v[j].z + v[j].w * v[j].w); }
        const float rstd = rsqrtf(wave_sum(ss) * (1.0f / DM) + EPS);
        const float* mb = mod + (size_t)(m >> 11) * NMOD;
        float ss2 = 0.f;
#pragma unroll
        for (int j = 0; j < 8; ++j) { const int col = (lane + 64 * j) * 4;
            const f32x4 w = *(const f32x4*)(wpost + col), g = *(const f32x4*)(mb + off_g + col);
            f32x4 xv;
            if constexpr (NEXT) xv = __builtin_nontemporal_load(xr + 64 * j);
            else { const unsigned long long xq_ = __builtin_nontemporal_load((const unsigned long long*)(xb + 64 * j)); const unsigned x0 = (unsigned)xq_, x1 = (unsigned)(xq_ >> 32); xv = (f32x4){bflo(x0), bfhi(x0), bflo(x1), bfhi(x1)}; }
            const f32x4 o = xv + g * (v[j] * rstd * w);
            v[j] = o; ss2 += (o.x * o.x + o.y * o.y) + (o.z * o.z + o.w * o.w);
            if constexpr (NEXT) { uint2 pk; pk.x = pk2(o.x, o.y); pk.y = pk2(o.z, o.w); *(uint2*)((bf16*)xout_ + (size_t)m * DM + col) = pk; }
            else *(f32x4*)((float*)xout_ + (size_t)m * DM + col) = o; }
        if (NEXT) {
            const float rstd2 = rsqrtf(wave_sum(ss2) * (1.0f / DM) + EPS);
#pragma unroll
            for (int j = 0; j < 8; ++j) { const int col = (lane + 64 * j) * 4;
                const f32x4 w = *(const f32x4*)(wn2 + col), sh = *(const f32x4*)(mb + off_sh + col), sc = *(const f32x4*)(mb + off_sc + col);
                const f32x4 o = v[j] * rstd2 * w * (sc + 1.0f) + sh;
                uint2 pk; pk.x = pk2(o.x, o.y); pk.y = pk2(o.z, o.w);
                *(uint2*)(Hn + (size_t)m * DM + col) = pk; }
        }
    }
}
__device__ __forceinline__ void fixup_phase(const bf16* E, bf16* Gb, const float* cw, const float* cb, int tid, int G, int bid) {
    constexpr int NPN = FF / 128;
    for (int idx = bid * NTHREADS + tid; idx < 256 * NPN * 16; idx += G * NTHREADS) {
        const int g = idx / (NPN * 16), rem = idx % (NPN * 16), pn = rem >> 4, fl = (rem & 15) * 8;
        if ((g & 31) == 0) continue;
        const bf16* ea = E + ((size_t)(pn * 256 + g - 1) * 4 + 2) * 256 + fl; const bf16* ec = E + ((size_t)(pn * 256 + g) * 4) * 256 + fl;
        const v4u ga = *(const v4u*)ea, gbv = *(const v4u*)(ea + 256), gc = *(const v4u*)ec, gd = *(const v4u*)(ec + 256);
        const v4u va = *(const v4u*)(ea + 128), vbv = *(const v4u*)(ea + 256 + 128), vc = *(const v4u*)(ec + 128), vd = *(const v4u*)(ec + 256 + 128);
        const int f8 = pn * 128 + fl;
        f32x4 pw[8][2];
#pragma unroll
        for (int hq = 0; hq < 2; ++hq) { const int fo = f8 + 4 * hq;
            pw[0][hq] = *(const f32x4*)(cw + fo); pw[1][hq] = *(const f32x4*)(cw + FF2 + fo); pw[2][hq] = *(const f32x4*)(cw + 2 * FF2 + fo); pw[3][hq] = *(const f32x4*)(cb + fo);
            pw[4][hq] = *(const f32x4*)(cw + FF + fo); pw[5][hq] = *(const f32x4*)(cw + FF2 + FF + fo); pw[6][hq] = *(const f32x4*)(cw + 2 * FF2 + FF + fo); pw[7][hq] = *(const f32x4*)(cb + FF + fo); }
        unsigned o0[4], o1[4];
#pragma unroll
        for (int q = 0; q < 4; ++q) {
            float r0[2], r1[2];
#pragma unroll
            for (int hh = 0; hh < 2; ++hh) { const int e = 2 * q + hh, eh = e >> 2, ec4 = e & 3;
                const float a = hh ? bfhi(ga[q]) : bflo(ga[q]), b = hh ? bfhi(gbv[q]) : bflo(gbv[q]), c = hh ? bfhi(gc[q]) : bflo(gc[q]), d = hh ? bfhi(gd[q]) : bflo(gd[q]);
                const float xa = hh ? bfhi(va[q]) : bflo(va[q]), xb = hh ? bfhi(vbv[q]) : bflo(vbv[q]), xc = hh ? bfhi(vc[q]) : bflo(vc[q]), xd = hh ? bfhi(vd[q]) : bflo(vd[q]);
                const float w0 = pw[0][eh][ec4], w1 = pw[1][eh][ec4], w2 = pw[2][eh][ec4], wb = pw[3][eh][ec4], y0 = pw[4][eh][ec4], y1 = pw[5][eh][ec4], y2 = pw[6][eh][ec4], yb = pw[7][eh][ec4];
                r0[hh] = gelu_tanh(wb + w0 * a + w1 * b + w2 * c) * (yb + y0 * xa + y1 * xb + y2 * xc);
                r1[hh] = gelu_tanh(wb + w0 * b + w1 * c + w2 * d) * (yb + y0 * xb + y1 * xc + y2 * xd); }
            o0[q] = pk2(r0[0], r0[1]); o1[q] = pk2(r1[0], r1[1]); }
        const v4u w0 = {o0[0], o0[1], o0[2], o0[3]}, w1 = {o1[0], o1[1], o1[2], o1[3]};
        *(v4u*)(Gb + (size_t)(64 * g - 1) * FF + pn * 128 + fl) = w0; *(v4u*)(Gb + (size_t)(64 * g) * FF + pn * 128 + fl) = w1;
    }
}


namespace att {
typedef short bf16x8 __attribute__((ext_vector_type(8)));
typedef short s16x4 __attribute__((ext_vector_type(4)));
typedef float f32x16 __attribute__((ext_vector_type(16)));
typedef unsigned u32x4 __attribute__((ext_vector_type(4)));
typedef LAS char* lptr;
#define KSWZ(row, colB) ((row) * 256 + ((colB) ^ (((row) & 7) << 4)))
#define KRSWZ(row, colB) ((row) * 128 + ((colB) ^ ((((row) >> 1) & 7) << 4)))
#define SBAR() __builtin_amdgcn_sched_barrier(0)
constexpr int QBLK = 32, KVBLK = 64, SHM_V = KVBLK * 128 * 2, SHM_K = KVBLK * 128 * 2, SHM_KR = KVBLK * 64 * 2;
constexpr float LOG2E = 1.4426950408889634f;
constexpr float THRL = 8.0f * LOG2E;
__device__ __forceinline__ int crow(int r, int hi) { return (r & 3) + 8 * (r >> 2) + 4 * hi; }
__device__ __forceinline__ unsigned cvtpk(float lo, float hi) { unsigned r; asm volatile("v_cvt_pk_bf16_f32 %0, %1, %2" : "=v"(r) : "v"(lo), "v"(hi)); return r; }
__device__ __forceinline__ bf16x8 ld8(const bf16* p) { return *reinterpret_cast<const bf16x8*>(p); }

template <bool EXPALL = false>
__device__ __forceinline__ void partialSM(f32x16& p0, f32x16& p1, float C, float bl, float& m_reg, float& alpha) {
    float pmax = p0[0];
#pragma unroll
    for (int r = 1; r < 16; ++r) pmax = fmaxf(pmax, p0[r]);
#pragma unroll
    for (int r = 0; r < 16; ++r) pmax = fmaxf(pmax, p1[r]);
    { auto rr = __builtin_amdgcn_permlane32_swap(__float_as_uint(pmax), __float_as_uint(pmax), false, false);
      pmax = fmaxf(__uint_as_float(rr[0]), __uint_as_float(rr[1])); }
    const float tmax = fmaf(pmax, C, bl);
    float mn;
    if (__builtin_expect(__all(tmax - m_reg <= THRL), 1)) { mn = m_reg; alpha = 1.f; }
    else { mn = fmaxf(m_reg, tmax); alpha = __builtin_amdgcn_exp2f(m_reg - mn); m_reg = mn; }
    const float off = bl - mn;
#pragma unroll
    for (int r = 0; r < 16; ++r) p0[r] = fmaf(p0[r], C, off);
#pragma unroll
    for (int r = 0; r < 16; ++r) p1[r] = fmaf(p1[r], C, off);
#pragma unroll
    for (int r = 0; r < 16; ++r) p0[r] = __builtin_amdgcn_exp2f(p0[r]);
    if (EXPALL) {
#pragma unroll
        for (int r = 0; r < 16; ++r) p1[r] = __builtin_amdgcn_exp2f(p1[r]); }
}
__device__ __forceinline__ void lut_adjust(f32x16& p0, f32x16& p1, const LAS float* lutx, const LAS int* kp, int qp, int hi) {
#pragma unroll
    for (int r = 0; r < 16; ++r) { const int key = crow(r, hi);
        int d0 = kp[key] - qp, d1 = kp[key + 32] - qp;
        d0 = d0 < -128 ? -128 : (d0 > 128 ? 128 : d0); d1 = d1 < -128 ? -128 : (d1 > 128 ? 128 : d1);
        p0[r] += lutx[d0 + 256]; p1[r] += lutx[d1 + 256]; }
}
__device__ __forceinline__ void lut_adjust_fast(f32x16& p0, f32x16& p1, const LAS float* lutx, int kp0, int qp, int hi) {
    const LAS float* bp = lutx + (kp0 - qp + 256 + 4 * hi);
#pragma unroll
    for (int r = 0; r < 16; ++r) { const int off = (r & 3) + 8 * (r >> 2); p0[r] += bp[off]; p1[r] += bp[off + 32]; }
}
template <bool EXPDONE = false>
__device__ __forceinline__ void finishSM(f32x16& p0, f32x16& p1, float alpha, float& l_reg, bf16x8& pa0, bf16x8& pa1, bf16x8& pa2, bf16x8& pa3) {
    if (!EXPDONE) {
#pragma unroll
        for (int r = 0; r < 16; ++r) p1[r] = __builtin_amdgcn_exp2f(p1[r]); }
    float ps = 0;
#pragma unroll
    for (int r = 0; r < 16; ++r) ps += p0[r];
#pragma unroll
    for (int r = 0; r < 16; ++r) ps += p1[r];
    { auto rr = __builtin_amdgcn_permlane32_swap(__float_as_uint(ps), __float_as_uint(ps), false, false);
      ps = __uint_as_float(rr[0]) + __uint_as_float(rr[1]); }
    l_reg = l_reg * alpha + ps;
#define PK4(P, BASE, OUT) do { u32x4 w = {cvtpk(P[BASE + 0], P[BASE + 1]), cvtpk(P[BASE + 2], P[BASE + 3]), cvtpk(P[BASE + 4], P[BASE + 5]), cvtpk(P[BASE + 6], P[BASE + 7])}; \
    OUT = *reinterpret_cast<bf16x8*>(&w); } while (0)
    PK4(p0, 0, pa0); PK4(p0, 8, pa1); PK4(p1, 0, pa2); PK4(p1, 8, pa3);
#undef PK4
}
__device__ __forceinline__ int v_st(int k, int c) { const int kk = (k & ~0xC) | ((k & 4) << 1) | ((k & 8) >> 1); return ((kk >> 3) * 4 + (c >> 5)) * 512 + ((kk & 7) * 32 + (c & 31)) * 2; }
__device__ __forceinline__ int v_rd_base(int lane) { return ((lane & 3) << 3) | (((lane >> 2) & 3) << 6) | (((lane >> 4) & 1) << 5) | (((lane >> 5) & 1) << 8); }
constexpr int v_rd_off(int d0, int ks, int half) { return d0 * 512 + ks * 4096 + half * 2048; }
template <int OFF> __device__ __forceinline__ s16x4 tr_read(int vb) {
    s16x4 r; asm volatile("ds_read_b64_tr_b16 %0, %1 offset:%2" : "=&v"(r) : "v"(vb), "i"(OFF) : "memory"); return r;
}
template <int D0, bool PRIO = true> __device__ __forceinline__ void pv_one(f32x16& od, int vb, bf16x8 pa0, bf16x8 pa1, bf16x8 pa2, bf16x8 pa3) {
    const s16x4 l0 = tr_read<v_rd_off(D0, 0, 0)>(vb), h0 = tr_read<v_rd_off(D0, 0, 1)>(vb), l1 = tr_read<v_rd_off(D0, 1, 0)>(vb), h1 = tr_read<v_rd_off(D0, 1, 1)>(vb);
    const s16x4 l2 = tr_read<v_rd_off(D0, 2, 0)>(vb), h2 = tr_read<v_rd_off(D0, 2, 1)>(vb), l3 = tr_read<v_rd_off(D0, 3, 0)>(vb), h3 = tr_read<v_rd_off(D0, 3, 1)>(vb);
    asm volatile("s_waitcnt lgkmcnt(0)" ::: "memory"); SBAR();
    if (PRIO) __builtin_amdgcn_s_setprio(1);
#define PK(L, H) (bf16x8){L[0], L[1], L[2], L[3], H[0], H[1], H[2], H[3]}
    od = __builtin_amdgcn_mfma_f32_32x32x16_bf16(pa0, PK(l0, h0), od, 0, 0, 0);
    od = __builtin_amdgcn_mfma_f32_32x32x16_bf16(pa1, PK(l1, h1), od, 0, 0, 0);
    od = __builtin_amdgcn_mfma_f32_32x32x16_bf16(pa2, PK(l2, h2), od, 0, 0, 0);
    od = __builtin_amdgcn_mfma_f32_32x32x16_bf16(pa3, PK(l3, h3), od, 0, 0, 0);
    if (PRIO) __builtin_amdgcn_s_setprio(0);
#undef PK
}
template <bool PRIO = true> __device__ __forceinline__ void pv_d0(f32x16* o, int vb, bf16x8 pa0, bf16x8 pa1, bf16x8 pa2, bf16x8 pa3) {
    pv_one<0, PRIO>(o[0], vb, pa0, pa1, pa2, pa3); pv_one<1, PRIO>(o[1], vb, pa0, pa1, pa2, pa3); pv_one<2, PRIO>(o[2], vb, pa0, pa1, pa2, pa3); pv_one<3, PRIO>(o[3], vb, pa0, pa1, pa2, pa3);
}
#ifndef DF_PRIO
#define DF_PRIO false
#endif
#ifndef ML_PRIO
#define ML_PRIO true
#endif
struct KAddr { int kb[4]; int krb[4]; };
__device__ __forceinline__ KAddr make_kaddr(int r32, int hi) {
    KAddr a; const int y = (hi * 16) ^ ((r32 & 7) << 4), y2 = (hi * 16) ^ (((r32 >> 1) & 7) << 4);
#pragma unroll
    for (int j = 0; j < 4; ++j) { a.kb[j] = r32 * 256 + ((j * 32) ^ y); a.krb[j] = r32 * 128 + ((j * 32) ^ y2); }
    return a;
}
template <int ND0, int NR, bool PRIO = true>
__device__ __forceinline__ void qkt(f32x16& p0, f32x16& p1, lptr Ks, lptr KRs, lptr QRs, const bf16x8* qr, int d0b, const KAddr& ka, const f32x16& cinit) {
    if (PRIO) __builtin_amdgcn_s_setprio(1);
#pragma unroll
    for (int d0 = 0; d0 < ND0; ++d0) {
        const bf16x8 b0 = *reinterpret_cast<const LAS bf16x8*>(Ks + ka.kb[d0 & 3] + ((d0b + d0) >> 2) * 128);
        const bf16x8 b1 = *reinterpret_cast<const LAS bf16x8*>(Ks + ka.kb[d0 & 3] + ((d0b + d0) >> 2) * 128 + 32 * 256);
        if (d0 == 0) { p0 = __builtin_amdgcn_mfma_f32_32x32x16_bf16(b0, qr[d0], cinit, 0, 0, 0); p1 = __builtin_amdgcn_mfma_f32_32x32x16_bf16(b1, qr[d0], cinit, 0, 0, 0); }
        else { p0 = __builtin_amdgcn_mfma_f32_32x32x16_bf16(b0, qr[d0], p0, 0, 0, 0); p1 = __builtin_amdgcn_mfma_f32_32x32x16_bf16(b1, qr[d0], p1, 0, 0, 0); } }
#pragma unroll
    for (int d0 = 0; d0 < NR; ++d0) {
        const bf16x8 b0 = *reinterpret_cast<const LAS bf16x8*>(KRs + ka.krb[d0]);
        const bf16x8 b1 = *reinterpret_cast<const LAS bf16x8*>(KRs + ka.krb[d0] + 32 * 128);
        p0 = __builtin_amdgcn_mfma_f32_32x32x16_bf16(b0, qr[ND0 + d0], p0, 0, 0, 0);
        p1 = __builtin_amdgcn_mfma_f32_32x32x16_bf16(b1, qr[ND0 + d0], p1, 0, 0, 0); }
    if (PRIO) __builtin_amdgcn_s_setprio(0);
}
template <bool EXPALL, bool FIRST>
__device__ __forceinline__ void partialSMn(f32x16& p0, f32x16& p1, float& m_reg, float& alpha) {
    float pmax = p0[0];
#pragma unroll
    for (int r = 1; r < 16; ++r) pmax = fmaxf(pmax, p0[r]);
#pragma unroll
    for (int r = 0; r < 16; ++r) pmax = fmaxf(pmax, p1[r]);
    { auto rr = __builtin_amdgcn_permlane32_swap(__float_as_uint(pmax), __float_as_uint(pmax), false, false);
      pmax = fmaxf(__uint_as_float(rr[0]), __uint_as_float(rr[1])); }
    alpha = 1.f;
    if (FIRST) { m_reg = pmax; alpha = 0.f;
#pragma unroll
        for (int r = 0; r < 16; ++r) { p0[r] -= pmax; p1[r] -= pmax; } }
    else if (__builtin_expect(!__all(pmax <= THRL), 0)) { const float delta = fmaxf(pmax, 0.f); m_reg += delta; alpha = __builtin_amdgcn_exp2f(-delta);
#pragma unroll
        for (int r = 0; r < 16; ++r) { p0[r] -= delta; p1[r] -= delta; } }
#pragma unroll
    for (int r = 0; r < 16; ++r) p0[r] = __builtin_amdgcn_exp2f(p0[r]);
    if (EXPALL) {
#pragma unroll
        for (int r = 0; r < 16; ++r) p1[r] = __builtin_amdgcn_exp2f(p1[r]); }
}
__device__ __forceinline__ bf16x8 scale_frag(bf16x8 q, float c) {
    const u32x4 w = __builtin_bit_cast(u32x4, q); u32x4 o;
#pragma unroll
    for (int i = 0; i < 4; ++i) o[i] = cvtpk(__uint_as_float(w[i] << 16) * c, __uint_as_float(w[i] & 0xffff0000u) * c);
    return __builtin_bit_cast(bf16x8, o);
}
#define SETNEG(BL) do { const float nv_ = (BL) - m_reg; if (__any(nv_ != negv)) { negv = nv_; _Pragma("unroll") for (int r = 0; r < 16; ++r) negm[r] = nv_; asm volatile("" : "+v"(negm)); } } while (0)

__device__ __forceinline__ void glds16(const bf16* g, lptr l) { __builtin_amdgcn_global_load_lds((const unsigned*)g, (LAS unsigned*)l, 16, 0, 0); }
#define WAITV(n) asm volatile("s_waitcnt vmcnt(" #n ")" ::: "memory")
#define ABAR() do { asm volatile("s_waitcnt lgkmcnt(0)" ::: "memory"); __builtin_amdgcn_s_barrier(); asm volatile("" ::: "memory"); } while (0)
__device__ __forceinline__ long ksrc_off(int p, int lane, int stride) { const int row = 4 * p + (lane >> 4), c = (lane & 15) ^ (row & 7); return (long)row * stride + c * 8; }
__device__ __forceinline__ long krsrc_off(int p, int lane, int stride) { const int row = 8 * p + (lane >> 3), c = (lane & 7) ^ ((row >> 1) & 7); return (long)row * stride + c * 8; }
__device__ __forceinline__ long vsrc_off(int p, int lane, int stride) { const int st = 2 * p + (lane >> 5), kk = (st >> 2) * 8 + ((lane & 31) >> 2);
    const int k = kk, col = (st & 3) * 32 + (lane & 3) * 8; return (long)k * stride + col; }
#define RESC(a) do { if (__any((a) < 1.f)) { if (hi == 0) al_l[r32] = (a); asm volatile("s_waitcnt lgkmcnt(0)" ::: "memory"); \
    _Pragma("unroll") for (int d = 0; d < 4; ++d) _Pragma("unroll") for (int r = 0; r < 16; ++r) o[d][r] *= al_l[crow(r, hi)]; } } while (0)

constexpr int ML_SLOT = SHM_K + SHM_V + SHM_KR, ML_NS = 3, ML_WS = ML_NS * ML_SLOT, MLA_LDS = ML_WS + 8 * 64 * 4;
__device__ __forceinline__ void mla_unit(const bf16* __restrict__ Qb, const bf16* __restrict__ KNh, const bf16* __restrict__ KRb, bf16* __restrict__ Ob, lptr lds, int tid) {
    constexpr float C = MLA_SCALE * LOG2E;
    const int wid = __builtin_amdgcn_readfirstlane(tid >> 6), lane = tid & 63, r32 = lane & 31, hi = lane >> 5;
    LAS float* ws = (LAS float*)(lds + ML_WS) + wid * 64; LAS float* li_l = ws; LAS float* al_l = ws + 32;
    float m_reg = -1e30f, l_reg = 0; f32x16 o[4] = {}; bf16x8 qr[12]; const f32x16 zero16 = {};
    const bf16* Qw = Qb + (long)(wid * QBLK + r32) * QW + hi * 8;
#pragma unroll
    for (int d0 = 0; d0 < 12; ++d0) qr[d0] = ld8(Qw + d0 * 16);
    const KAddr ka = make_kaddr(r32, hi);
    const bf16* Vh = KNh + 128;
    const int vb0 = (int)(unsigned)(uintptr_t)lds + SHM_K + v_rd_base(lane);
    const long ko0 = ksrc_off(2 * wid, lane, KVW), ko1 = ksrc_off(2 * wid + 1, lane, KVW), vo0 = vsrc_off(2 * wid, lane, KVW), vo1 = vsrc_off(2 * wid + 1, lane, KVW), ro0 = krsrc_off(wid, lane, INWP);
    lptr dK = lds + wid * 2048, dV = lds + SHM_K + wid * 2048, dR = lds + SHM_K + SHM_V + wid * 1024;
#define DMA(t, so) do { const long kr_ = (long)(t) * KVBLK; const bf16* kp_ = KNh + kr_ * KVW; const bf16* vp_ = Vh + kr_ * KVW; const bf16* rp_ = KRb + kr_ * INWP; \
    glds16(kp_ + ko0, dK + (so)); glds16(kp_ + ko1, dK + (so) + 1024); glds16(vp_ + vo0, dV + (so)); glds16(vp_ + vo1, dV + (so) + 1024); glds16(rp_ + ro0, dR + (so)); } while (0)
#define ROT3() do { const int t_ = sp; sp = sc; sc = sn; sn = t_; } while (0)
    f32x16 pA0, pA1, pB0, pB1; float alA, alB; bf16x8 pa0, pa1, pa2, pa3; constexpr int NT = SEQ / KVBLK;
    int sp = 0, sc = 0, sn = ML_SLOT;
    DMA(0, 0); DMA(1, ML_SLOT); WAITV(5); ABAR();
    qkt<8, 4, ML_PRIO>(pA0, pA1, lds, lds + SHM_K + SHM_V, lds, qr, 0, ka, zero16); partialSM(pA0, pA1, C, 0.f, m_reg, alA);
    WAITV(0); ABAR();
    sp = 0; sc = ML_SLOT; sn = 2 * ML_SLOT;
    for (int j = 1; j + 1 < NT; j += 2) {
        DMA(j + 1, sn);
        SBAR(); qkt<8, 4, ML_PRIO>(pB0, pB1, lds + sc, lds + sc + SHM_K + SHM_V, lds, qr, 0, ka, zero16);
        finishSM(pA0, pA1, alA, l_reg, pa0, pa1, pa2, pa3); SBAR();
        pv_d0<ML_PRIO>(o, vb0 + sp, pa0, pa1, pa2, pa3); partialSM(pB0, pB1, C, 0.f, m_reg, alB);
        WAITV(0); ABAR(); RESC(alB); ROT3();
        if (j + 2 < NT) DMA(j + 2, sn);
        SBAR(); qkt<8, 4, ML_PRIO>(pA0, pA1, lds + sc, lds + sc + SHM_K + SHM_V, lds, qr, 0, ka, zero16);
        finishSM(pB0, pB1, alB, l_reg, pa0, pa1, pa2, pa3); SBAR();
        pv_d0<ML_PRIO>(o, vb0 + sp, pa0, pa1, pa2, pa3); partialSM(pA0, pA1, C, 0.f, m_reg, alA);
        WAITV(0); ABAR(); RESC(alA); ROT3();
    }
    SBAR(); qkt<8, 4, ML_PRIO>(pB0, pB1, lds + sc, lds + sc + SHM_K + SHM_V, lds, qr, 0, ka, zero16);
    finishSM(pA0, pA1, alA, l_reg, pa0, pa1, pa2, pa3); SBAR();
    pv_d0<ML_PRIO>(o, vb0 + sp, pa0, pa1, pa2, pa3); partialSM(pB0, pB1, C, 0.f, m_reg, alB);
    RESC(alB);
    finishSM(pB0, pB1, alB, l_reg, pa0, pa1, pa2, pa3); SBAR();
    pv_d0<ML_PRIO>(o, vb0 + sc, pa0, pa1, pa2, pa3);
    if (hi == 0) li_l[r32] = l_reg; asm volatile("s_waitcnt lgkmcnt(0)" ::: "memory");
    float rli[16];
#pragma unroll
    for (int r = 0; r < 16; ++r) rli[r] = __builtin_amdgcn_rcpf(li_l[crow(r, hi)]);
    bf16* Ow = Ob + (long)(wid * QBLK) * DM;
#pragma unroll
    for (int r = 0; r < 16; ++r) { const int orow = crow(r, hi);
#pragma unroll
        for (int d0 = 0; d0 < 4; ++d0) Ow[(long)orow * DM + d0 * 32 + r32] = (bf16)f2bf(o[d0][r] * rli[r]); }
    ABAR();
#undef DMA
#undef ROT3
}

typedef float cv_f32x2 __attribute__((ext_vector_type(2)));
typedef __bf16 cv_bf16x2 __attribute__((ext_vector_type(2)));
__device__ __forceinline__ unsigned cv_pk(float lo, float hi) { const cv_f32x2 v = {lo, hi}; const cv_bf16x2 r = __builtin_convertvector(v, cv_bf16x2); return __builtin_bit_cast(unsigned, r); }
struct CvStream { bool on; const float* src; unsigned char* dst; unsigned sN4  , K2  , so_src, so_dst; int nsteps  ; };
constexpr int DF_SLOT = SHM_K + SHM_V, DF_NS = 4, DF_WS = DF_NS * DF_SLOT, DF_LUT = DF_WS + 8 * 64 * 4, DF_TK = DF_LUT + 512 * 4, DF_KPOS = DF_TK + 96 * 4, DF_LDS = DF_KPOS + SEQ * 4;
__device__ __forceinline__ void diff_unit(const bf16* __restrict__ Qb  , const bf16* __restrict__ Kh  ,
                                          const bf16* __restrict__ Vh  , const int* __restrict__ qposp  ,
                                          const int* __restrict__ kposp  , const int* __restrict__ tk  , const int* __restrict__ tkf  ,
                                          const float* __restrict__ relb_h  , const float* __restrict__ subln, float lam, bf16* __restrict__ Ob  , lptr lds, int tid, const CvStream cv) {
    constexpr float C = DIFF_SCALE * LOG2E;
    const int wid = __builtin_amdgcn_readfirstlane(tid >> 6), lane = tid & 63, r32 = lane & 31, hi = lane >> 5;
    const int comp = wid >> 2, wq = wid & 3;
    LAS float* ws = (LAS float*)(lds + DF_WS) + wid * 64; LAS float* li_l = ws; LAS float* al_l = ws + 32;
    LAS int* kpos_l = (LAS int*)(lds + DF_KPOS); LAS float* lut = (LAS float*)(lds + DF_LUT); LAS int* tkl = (LAS int*)(lds + DF_TK);
    const long ko0 = ksrc_off(2 * wid, lane, INWP), ko1 = ksrc_off(2 * wid + 1, lane, INWP), vo0 = vsrc_off(2 * wid, lane, INWP), vo1 = vsrc_off(2 * wid + 1, lane, INWP);
    lptr dK = lds + wid * 2048, dV = lds + SHM_K + wid * 2048;
#define DMA(t, so) do { const long kr_ = (long)(t) * KVBLK * INWP; const bf16* kp_ = Kh + kr_; const bf16* vp_ = Vh + kr_; \
    glds16(kp_ + ko0, dK + (so)); glds16(kp_ + ko1, dK + (so) + 1024); glds16(vp_ + vo0, dV + (so)); glds16(vp_ + vo1, dV + (so) + 1024); } while (0)
    DMA(0, 0); DMA(1, DF_SLOT);
    const bool cv_on = cv.on;
    const __amdgpu_buffer_rsrc_t cv_rs = __builtin_amdgcn_make_buffer_rsrc((void*)cv.src, 0, -1, 0x00020000), cv_rd = __builtin_amdgcn_make_buffer_rsrc((void*)cv.dst, 0, -1, 0x00020000);
    unsigned cv_ss = cv.so_src, cv_sd = cv.so_dst; const unsigned cv_n4 = cv.sN4;
    const int cv_vs = (lane >> 4) * 4 * (int)cv.sN4 + (lane & 15) * 16, cv_vd = (lane & 15) * 4 * (int)cv.K2 + (lane >> 4) * 8; int cv_left = cv.nsteps;
    u32x4 cv0 = {}, cv1 = {}, cv2 = {}, cv3 = {};
#define CV_LOAD() do { if (cv_on && cv_left > 0) { cv0 = __builtin_amdgcn_raw_buffer_load_b128(cv_rs, cv_vs, cv_ss, 2); cv1 = __builtin_amdgcn_raw_buffer_load_b128(cv_rs, cv_vs, cv_ss + cv_n4, 2); \
      cv2 = __builtin_amdgcn_raw_buffer_load_b128(cv_rs, cv_vs, cv_ss + 2 * cv_n4, 2); cv3 = __builtin_amdgcn_raw_buffer_load_b128(cv_rs, cv_vs, cv_ss + 3 * cv_n4, 2); cv_ss += 16 * cv_n4; } } while (0)
#define CV_ST1(J_, C_) do { pg8::u32x2 o_; o_.x = cv_pk(cvf0_.C_, cvf1_.C_); o_.y = cv_pk(cvf2_.C_, cvf3_.C_); \
      __builtin_amdgcn_raw_buffer_store_b64(o_, cv_rd, cv_vd, cv_sd + (J_) * cv.K2, 0); } while (0)
#define CV_STORE() do { if (cv_on && cv_left > 0) {   \
      const f32x4 cvf0_ = __builtin_bit_cast(f32x4, cv0), cvf1_ = __builtin_bit_cast(f32x4, cv1), cvf2_ = __builtin_bit_cast(f32x4, cv2), cvf3_ = __builtin_bit_cast(f32x4, cv3); \
      CV_ST1(0, x); CV_ST1(1, y); CV_ST1(2, z); CV_ST1(3, w); cv_sd += 32; --cv_left; } } while (0)
    const int ld_ = tid - 256;
    const float lutv = relb_h[t5_bucket(ld_ < -128 ? -128 : (ld_ > 128 ? 128 : ld_)) * 8] * LOG2E;
    const int tkv = (tid >= 448) ? tk[tid - 448] : ((tid >= 416) ? tkf[tid - 416] : 0);
    const u32x4 kp4 = *(const u32x4*)(kposp + tid * 4);
    const int qp = qposp[wq * QBLK + r32];
    float m_reg = 0.f, l_reg = 0; f32x16 o[4] = {}; bf16x8 qr[4]; f32x16 negm = {}; float negv = 0.f;
    const bf16* Qw = Qb + (long)(wq * QBLK + r32) * INWP + comp * 64 + hi * 8;
#pragma unroll
    for (int d0 = 0; d0 < 4; ++d0) qr[d0] = ld8(Qw + d0 * 16);
    lut[tid] = lutv;
    if (tid >= 448) tkl[tid - 448] = tkv; else if (tid >= 416) tkl[64 + tid - 416] = tkv;
    *(LAS u32x4*)(kpos_l + tid * 4) = kp4;
    int qmn = qp, qmx = qp;
#pragma unroll
    for (int of = 1; of < 32; of <<= 1) { qmn = min(qmn, __shfl_xor(qmn, of)); qmx = max(qmx, __shfl_xor(qmx, of)); }
    qmn = __builtin_amdgcn_readfirstlane(qmn); qmx = __builtin_amdgcn_readfirstlane(qmx);
    const bool qnarrow = (qmx - qmn < 32);
#pragma unroll
    for (int d0 = 0; d0 < 4; ++d0) qr[d0] = scale_frag(qr[d0], C);
    const KAddr ka = make_kaddr(r32, hi);
    const int vb0 = (int)(unsigned)(uintptr_t)lds + SHM_K + v_rd_base(lane);
#define TILEBIAS(t, BL, NEAR) const int kmn_##BL = tkl[2 * (t)], kmx_##BL = tkl[2 * (t) + 1]; const bool fr_##BL = (kmn_##BL - qmx >= 91), fl_##BL = (kmx_##BL - qmn <= -91); \
    const bool NEAR = !(fr_##BL || fl_##BL); const float BL = fr_##BL ? blR : (fl_##BL ? blL : 0.f)
#define ADJ(P0, P1, t, NEAR) do { if (NEAR) { if (qnarrow && tkl[64 + (t)] != 0) lut_adjust_fast(P0, P1, lut, tkl[2 * (t)], qp, hi); else lut_adjust(P0, P1, lut, kpos_l + (t) * 64, qp, hi); } } while (0)
#define SLOT(t) (((t) & 3) * DF_SLOT)
#define ENDWAIT(t) do { if ((t) + 2 < NT) WAITV(4); else WAITV(0); } while (0)
#define ENDSTEP(t) ABAR()
    f32x16 pA0, pA1, pB0, pB1; float alA, alB; bf16x8 pa0, pa1, pa2, pa3; constexpr int NT = SEQ / KVBLK;
    WAITV(0); ABAR();
    const float blR = lut[256 + 128], blL = lut[256 - 128];
    DMA(2, SLOT(2));
    { TILEBIAS(0, bl0, near0); SETNEG(bl0);
      qkt<4, 0, DF_PRIO>(pA0, pA1, lds + SLOT(0), lds, lds, qr, 4 * comp, ka, negm); ADJ(pA0, pA1, 0, near0); partialSMn<true, true>(pA0, pA1, m_reg, alA); }
    ENDWAIT(0); CV_LOAD(); ENDSTEP(0);
    for (int j = 1; j + 1 < NT; j += 2) {
        if (j + 2 < NT) DMA(j + 2, SLOT(j + 2));
        { TILEBIAS(j, blb, nearb); SETNEG(blb);
          SBAR(); qkt<4, 0, DF_PRIO>(pB0, pB1, lds + SLOT(j), lds, lds, qr, 4 * comp, ka, negm);
          finishSM<true>(pA0, pA1, alA, l_reg, pa0, pa1, pa2, pa3); SBAR();
          ADJ(pB0, pB1, j, nearb); SBAR();
          pv_d0<DF_PRIO>(o, vb0 + SLOT(j - 1), pa0, pa1, pa2, pa3); partialSMn<true, false>(pB0, pB1, m_reg, alB); }
        ENDWAIT(j); CV_STORE(); CV_LOAD(); ENDSTEP(j); RESC(alB);
        if (j + 3 < NT) DMA(j + 3, SLOT(j + 3));
        { TILEBIAS(j + 1, bla, neara); SETNEG(bla);
          SBAR(); qkt<4, 0, DF_PRIO>(pA0, pA1, lds + SLOT(j + 1), lds, lds, qr, 4 * comp, ka, negm);
          finishSM<true>(pB0, pB1, alB, l_reg, pa0, pa1, pa2, pa3); SBAR();
          ADJ(pA0, pA1, j + 1, neara); SBAR();
          pv_d0<DF_PRIO>(o, vb0 + SLOT(j), pa0, pa1, pa2, pa3); partialSMn<true, false>(pA0, pA1, m_reg, alA); }
        ENDWAIT(j + 1); CV_STORE(); CV_LOAD(); ENDSTEP(j + 1); RESC(alA);
    }
    CV_STORE(); CV_LOAD();
    { TILEBIAS(NT - 1, blz, nearz); SETNEG(blz);
      SBAR(); qkt<4, 0, DF_PRIO>(pB0, pB1, lds + SLOT(NT - 1), lds, lds, qr, 4 * comp, ka, negm);
      finishSM<true>(pA0, pA1, alA, l_reg, pa0, pa1, pa2, pa3); SBAR();
      ADJ(pB0, pB1, NT - 1, nearz); SBAR();
      pv_d0<DF_PRIO>(o, vb0 + SLOT(NT - 2), pa0, pa1, pa2, pa3); partialSMn<true, false>(pB0, pB1, m_reg, alB); }
    RESC(alB);
    finishSM<true>(pB0, pB1, alB, l_reg, pa0, pa1, pa2, pa3); SBAR();
    pv_d0<DF_PRIO>(o, vb0 + SLOT(NT - 1), pa0, pa1, pa2, pa3);
    CV_STORE();
    if (hi == 0) li_l[r32] = l_reg; asm volatile("s_waitcnt lgkmcnt(0)" ::: "memory");
    float rli[16];
#pragma unroll
    for (int r = 0; r < 16; ++r) rli[r] = __builtin_amdgcn_rcpf(li_l[crow(r, hi)]);
    ABAR();
    LAS float* X = (LAS float*)lds + (wq * 32) * 128;
    if (comp == 1) {
#pragma unroll
        for (int r = 0; r < 16; ++r) { const int orow = crow(r, hi);
#pragma unroll
            for (int d0 = 0; d0 < 4; ++d0) X[orow * 128 + d0 * 32 + r32] = o[d0][r] * rli[r] * lam; }
    }
    ABAR();
    if (comp == 0) {
        bf16* Ow = Ob + (long)(wq * QBLK) * DM;
        float sl[4];
#pragma unroll
        for (int d0 = 0; d0 < 4; ++d0) sl[d0] = subln[d0 * 32 + r32] * (1.0f - LAMBDA_INIT);
#pragma unroll
        for (int r = 0; r < 16; ++r) { const int orow = crow(r, hi);
            float v[4]; float ss = 0.f;
#pragma unroll
            for (int d0 = 0; d0 < 4; ++d0) { v[d0] = o[d0][r] * rli[r] - X[orow * 128 + d0 * 32 + r32]; ss += v[d0] * v[d0]; }
#pragma unroll
            for (int of = 1; of < 32; of <<= 1) ss += __shfl_xor(ss, of);
            const float rstd = rsqrtf(ss * (1.0f / 128.0f) + EPS);
#pragma unroll
            for (int d0 = 0; d0 < 4; ++d0) Ow[(long)orow * DM + d0 * 32 + r32] = (bf16)f2bf(v[d0] * rstd * sl[d0]); }
    }
    ABAR();
#undef DMA
#undef TILEBIAS
#undef ADJ
#undef SETNEG
#undef SLOT
#undef ENDSTEP
#undef ENDWAIT
#undef CV_LOAD
#undef CV_STORE
#undef CV_ST1
#undef RESC
#undef WAITV
#undef ABAR
}
#undef KSWZ
#undef KRSWZ
#undef SBAR
}

__device__ __forceinline__ void attn_phase(unsigned char* ws, const int* pos, const float* rel_bias, const float* subln, float lam, LAS unsigned char* lds, int tid, int G, int bid,
                                           const float* wsrc_o, const float* wsrc_up, const float* wsrc_dn) {
    const bf16* PROJ = (const bf16*)(ws + WS_PROJ); const bf16* Qb = (const bf16*)(ws + WS_Q); const bf16* KVb = (const bf16*)(ws + WS_KV); bf16* AO = (bf16*)(ws + WS_AO);
    const int* TK = (const int*)(ws + WS_TK);
    const int vcu = (G % 8 == 0) ? (bid % 8) * (G / 8) + bid / 8 : bid;
    { constexpr int NU = BATCH * 8 * (SEQ / 256); const int per = (NU + G - 1) / G;
      for (int i = 0; i < per; ++i) { const int un = vcu * per + i; if (un >= NU) break;
        int tidu = tid; asm volatile("" : "+v"(tidu));
        const int qb = un & 7, h = (un >> 3) & 7, b = un >> 6;
        const size_t m0 = (size_t)b * SEQ + qb * 256;
        att::mla_unit(Qb + m0 * QW + h * 192, KVb + (size_t)b * SEQ * KVW + h * 256, PROJ + (size_t)b * SEQ * INWP + C_KROPE, AO + m0 * DM + h * 128, (att::lptr)lds, tidu); } }
    { constexpr int NU = BATCH * 8 * (SEQ / 128); const int per = (NU + G - 1) / G;
      att::CvStream cvb; cvb.on = false; cvb.src = nullptr; cvb.dst = nullptr; cvb.sN4 = 0; cvb.K2 = 0; cvb.so_src = 0; cvb.so_dst = 0; cvb.nsteps = 0; int cv_kunit = 0;
      if (G == 256) { const int gw_ = __builtin_amdgcn_readfirstlane(tid >> 6) * G + vcu; int strip = 0, kb_ = 0, N_ = 0, K_ = 0;
        if (gw_ < 32) { strip = gw_; N_ = DM; K_ = DM; cvb.src = wsrc_o; cvb.dst = ws + WS_WO; cvb.on = true; cvb.nsteps = 32; cv_kunit = 512; }
        else if (gw_ < 208) { strip = gw_ - 32; N_ = FF2; K_ = DM; cvb.src = wsrc_up; cvb.dst = ws + WS_WUP; cvb.on = true; cvb.nsteps = 32; cv_kunit = 512; }
        else if (gw_ < 336) { const int g_ = gw_ - 208; strip = g_ >> 2; kb_ = 1408 * (g_ & 3); N_ = DM; K_ = FF; cvb.src = wsrc_dn; cvb.dst = ws + WS_WDN; cvb.on = true; cvb.nsteps = 22; cv_kunit = 352; }
        cvb.sN4 = (unsigned)N_ * 4u; cvb.K2 = (unsigned)K_ * 2u;
        cvb.so_src = ((unsigned)kb_ * (unsigned)N_ + 64u * strip) * 4u; cvb.so_dst = ((unsigned)(64 * strip) * (unsigned)K_ + (unsigned)kb_) * 2u; }
      for (int i = 0; i < per; ++i) { const int un = vcu * per + i; if (un >= NU) break;
        int tidu = tid; asm volatile("" : "+v"(tidu));
        const int qb = un & 15, h = (un >> 4) & 7, b = un >> 7;
        const size_t m0 = (size_t)b * SEQ + qb * 128;
        att::CvStream cv = cvb; cv.so_src += (unsigned)(cv_kunit * i) * cvb.sN4; cv.so_dst += (unsigned)(cv_kunit * i) * 2u;
        att::diff_unit(PROJ + m0 * INWP + C_DQ + h * 128, PROJ + (size_t)b * SEQ * INWP + C_DK + h * 128, PROJ + (size_t)b * SEQ * INWP + C_DV + h * 128,
                       pos + m0, pos + (size_t)b * SEQ, TK + b * 64, TK + TKF_OFF + b * 32, rel_bias + h, subln, lam, AO + m0 * DM + 1024 + h * 128, (att::lptr)lds, tidu, cv); } }
}

constexpr int NPH = 11;
struct Args { const void* in[25]; float* out; unsigned char* ws; int ph_lo, ph_hi; };
__global__ void __launch_bounds__(NTHREADS, 2) fwd(Args args) {
    extern __shared__ __attribute__((aligned(16))) unsigned char lds_raw[];
    LAS unsigned char* lds = (LAS unsigned char*)lds_raw;
    const int tid0 = threadIdx.x, G0 = gridDim.x;
    const int wave0 = __builtin_amdgcn_readfirstlane(tid0 >> 6);
    for (int u = tid0; u < (LDS_BYTES - LDSCTL_OFF) / 4; u += NTHREADS) ((LAS unsigned*)(lds + LDSCTL_OFF))[u] = 0u;
    __syncthreads();
    if (tid0 == 0) {
        LAS unsigned long long* pt = (LAS unsigned long long*)(lds + PTR_OFF);
#pragma unroll
        for (int i = 0; i < 25; ++i) pt[i] = (unsigned long long)args.in[i];
        pt[P_OUT] = (unsigned long long)args.out; pt[P_WS] = (unsigned long long)args.ws;
    }
    __syncthreads();
    volatile LAS unsigned* MISC = (volatile LAS unsigned*)(lds + MISC_OFF);
    const int ph_lo = args.ph_lo, ph_hi = args.ph_hi;
    XcdBarrier bar; bar.bar = nullptr; bar.x = 0; bar.st = nullptr;
    if (ph_hi - ph_lo > 1) bar = xcd_barrier_post((unsigned*)(LPWS() + WS_CTL) + CW_BAR, MISC + 8, tid0);

#define PH_BEGIN(k) if (ph_lo <= (k) && (k) < ph_hi) { int G = G0, bid = (int)blockIdx.x, wave = wave0; \
        int lane = (int)__builtin_amdgcn_mbcnt_hi(~0u, __builtin_amdgcn_mbcnt_lo(~0u, 0u)); \
        asm volatile("" : "+v"(lane)); asm volatile("" : "+s"(G)); asm volatile("" : "+s"(bid)); asm volatile("" : "+s"(wave)); \
        const int tid = wave * 64 + lane; (void)tid; (void)lane; (void)G; (void)bid; unsigned char* ws = LPWS(); (void)ws;
#define PH_END(k) if ((k) + 1 < ph_hi) xcd_barrier(bar, tid); }

    PH_BEGIN(0) p0_prologue(lds, tid, lane, wave, G, bid); PH_END(0)
    PH_BEGIN(1) prenorm_phase(LPF(P_X), LPF(P_APRE), (const float*)(ws + WS_MOD), MOD_SHA, MOD_SCA, (bf16*)(ws + WS_H), lane, wave, G, bid); PH_END(1)
    for (int q = 0; q < 3; ++q) {
        const int k = (q == 0) ? 2 : 3;
        PH_BEGIN(k)
            bf16* PROJ = (bf16*)(ws + WS_PROJ);
            pg8::Gemm g; pg8::EpiX E;
            E.qscale = 1.0f; E.ssq_q = (float*)(ws + WS_SSQQ); E.ssq_kv = (float*)(ws + WS_SSQKV); E.COS = (const float*)(ws + WS_COS); E.SIN = (const float*)(ws + WS_SIN);
            if (q == 0) { g = pg8::Gemm{(const bf16*)(ws + WS_H), (const bf16*)(ws + WS_WIN), M, INWP, DM, DM, DM, 128, 256, 0}; E.O = PROJ; E.ldc = INWP; E.mode = 0; }
            else if (q == 1) { g = pg8::Gemm{PROJ + C_QLAT, (const bf16*)(ws + WS_WUQ), M, QW, 512, INWP, 512, 128, 256, 0}; E.O = (bf16*)(ws + WS_Q); E.ldc = QW; E.mode = 1; }
            else { g = pg8::Gemm{PROJ + C_KVLAT, (const bf16*)(ws + WS_WUKV), M, KVW, 256, INWP, 256, 128, 256, 0}; E.O = (bf16*)(ws + WS_KV); E.ldc = KVW; E.mode = 2; }
            const int vcu = (G % 8 == 0) ? (bid % 8) * (G / 8) + bid / 8 : bid;
            pg8::ListOrder S;
            if (G == 256) {
                if (q == 0) S = pg8::ListOrder{4 * vcu, 4, INWP / 256};
                else if (q == 1) S = (vcu < 128) ? pg8::ListOrder{2 * vcu, 2, QW / 256} : pg8::ListOrder{256 + (vcu - 128), 1, QW / 256};
                else S = (vcu < 128) ? pg8::ListOrder{vcu, 1, KVW / 256} : pg8::ListOrder{128 + 3 * (vcu - 128), 3, KVW / 256};
            } else { const int nu = (g.M / 256) * (g.N / 256), per = (nu + G - 1) / G, b0 = vcu * per; S = pg8::ListOrder{b0, (b0 >= nu) ? 0 : ((nu - b0 < per) ? nu - b0 : per), g.N / 256}; }
            pg8::gemm_phase<pg8::EpiX, pg8::ListOrder, true, true>(lds, g, S, E, tid);
            if (q == 1) { }
            else
        PH_END(k)
        else { }
    }
    PH_BEGIN(4)
        const float s1 = wave_sum(LPF(P_LQ1)[lane] * LPF(P_LK1)[lane]), s2 = wave_sum(LPF(P_LQ2)[lane] * LPF(P_LK2)[lane]);
        const float lam = expf(s1) - expf(s2) + LAMBDA_INIT;
        attn_phase(ws, (const int*)ldptr(lds, P_POS), LPF(P_RELB), LPF(P_SUBLN), lam, lds, tid, G, bid, LPF(P_WO), LPF(P_WUP), LPF(P_WDN));
    PH_END(4)
    for (int q = 0; q < 2; ++q) {
        const int k = (q == 0) ? 5 : 9;
        PH_BEGIN(k)
            pg8::Gemm g; pg8::EpiBf16 E;
            if (q == 0) { g = pg8::Gemm{(const bf16*)(ws + WS_AO), (const bf16*)(ws + WS_WO), M, DM, DM, DM, DM, 128, 256, 0}; E = pg8::EpiBf16{(bf16*)(ws + WS_Y), DM}; }
            else { g = pg8::Gemm{(const bf16*)(ws + WS_G), (const bf16*)(ws + WS_WDN), M, DM, FF, FF, FF, 128, 256, 0}; E = pg8::EpiBf16{(bf16*)(ws + WS_Y2), DM}; }
            pg8::StaticOrder S; S.init(g.M, g.N, G, bid);
            pg8::gemm_phase<pg8::EpiBf16, pg8::StaticOrder, true, true>(lds, g, S, E, tid);
        PH_END(k)
        if (q == 0) {
            PH_BEGIN(6) post_phase<true>((const bf16*)(ws + WS_Y), LPF(P_X), (void*)(ws + WS_X1), LPF(P_APOST), (const float*)(ws + WS_MOD), MOD_GA, LPF(P_FPRE), MOD_SHF, MOD_SCF, (bf16*)(ws + WS_H), lane, wave, G, bid); PH_END(6)
            PH_BEGIN(7)
                pg8::Gemm g = pg8::Gemm{(const bf16*)(ws + WS_H), (const bf16*)(ws + WS_WUP), M, FF2, DM, DM, DM, FF, 128, 1};
                pg8::EpiConv E{(bf16*)(ws + WS_G), (bf16*)(ws + WS_E), LPF(P_CW), LPF(P_CB), FF, FF2};
                pg8::StaticOrder S; S.init(g.M, g.N, G, bid);
                pg8::gemm_phase<pg8::EpiConv, pg8::StaticOrder, true, true>(lds, g, S, E, tid);
            PH_END(7)
            PH_BEGIN(8) fixup_phase((const bf16*)(ws + WS_E), (bf16*)(ws + WS_G), LPF(P_CW), LPF(P_CB), tid, G, bid); PH_END(8)
        }
    }
    PH_BEGIN(10) float* outp = (float*)ldptr(lds, P_OUT);
        post_phase<false>((const bf16*)(ws + WS_Y2), (const void*)(ws + WS_X1), outp, LPF(P_FPOST), (const float*)(ws + WS_MOD), MOD_GF, nullptr, 0, 0, nullptr, lane, wave, G, bid); PH_END(10)
#undef PH_BEGIN
#undef PH_END
}

#ifndef MK_ONE_LAUNCH
#define MK_ONE_LAUNCH 1
#endif
extern "C" void kernel_launch(void* const* d_in, const int* in_sizes, int n_in, void* d_out, int out_size, void* d_ws, size_t ws_size, hipStream_t stream) {
    static int grid = 0;
    if (grid == 0) {
        if (n_in != 25 || in_sizes[0] != M * DM || out_size != M * DM || ws_size < WS_END) {
            fprintf(stderr, "kernel_launch: shape mismatch: n_in %d in0 %d out %d ws %zu (need >= %zu)\n", n_in, n_in > 0 ? in_sizes[0] : -1, out_size, ws_size, (size_t)WS_END); grid = -1; return; }
        int dev = 0, cus = 0;
        if (hipGetDevice(&dev) != hipSuccess || hipDeviceGetAttribute(&cus, hipDeviceAttributeMultiprocessorCount, dev) != hipSuccess) { grid = -1; return; }
        if (hipFuncSetAttribute((const void*)fwd, hipFuncAttributeMaxDynamicSharedMemorySize, LDS_BYTES) != hipSuccess) { fprintf(stderr, "kernel_launch: hipFuncSetAttribute failed\n"); grid = -1; return; }
        (void)hipGetLastError();
        grid = cus;
    }
    if (grid < 0) return;
    if (hipMemsetAsync((char*)d_ws + WS_CTL, 0, CTL_ZERO_BYTES, stream) != hipSuccess) { fprintf(stderr, "kernel_launch: memset failed\n"); return; }
    Args a{};
    for (int i = 0; i < 25; ++i) a.in[i] = d_in[i];
    a.out = (float*)d_out; a.ws = (unsigned char*)d_ws;
#if MK_ONE_LAUNCH
    a.ph_lo = 0; a.ph_hi = NPH;
    hipLaunchKernelGGL(fwd, dim3(grid), dim3(NTHREADS), LDS_BYTES, stream, a);
#else
    for (int p = 0; p < NPH; ++p) { a.ph_lo = p; a.ph_hi = p + 1; hipLaunchKernelGGL(fwd, dim3(grid), dim3(NTHREADS), LDS_BYTES, stream, a); }
#endif
    const hipError_t le = hipPeekAtLastError();
    if (le != hipSuccess) fprintf(stderr, "kernel_launch: launch failed: %s\n", hipGetErrorName(le));
}
```

```cpp
#include <hip/hip_runtime.h>
#ifndef WT_AUX
#define WT_AUX 16
#endif
#include <cstdio>
#include <cstdint>
namespace pg8 {
#define PG8_LAS __attribute__((address_space(3)))
typedef unsigned short bf16_t;
typedef short bf16x8 __attribute__((ext_vector_type(8)));
typedef float f32x4 __attribute__((ext_vector_type(4)));
typedef unsigned u32x2 __attribute__((ext_vector_type(2)));
typedef unsigned u32x4 __attribute__((ext_vector_type(4)));
constexpr int BM = 256, BK = 64, HALF = 128, HTB = HALF * BK * 2  , STAGE_BYTES = 8 * HTB, NXCD = 8, WGM = 8;

__host__ __device__ __forceinline__ int lds_byte(int r, int c) { const int st = (r >> 4) * 2 + (c >> 5), rr = r & 15, cc = c & 31, ob = rr * 64 + cc * 2; return st * 1024 + (ob ^ (((ob >> 9) & 1) << 5)); }
__host__ __device__ __forceinline__ void stage_rc(int b, int& R, int& C) { const int st = b / 1024, sb = b % 1024, swz = sb ^ (((sb >> 9) & 1) << 5); R = (st >> 1) * 16 + swz / 64; C = (st & 1) * 32 + (swz % 64) / 2; }
__host__ __device__ __forceinline__ int perm32(int rho) { const int n = rho >> 4, i = rho & 15; return 8 * (i >> 2) + 4 * n + (i & 3); }

struct Unit { int pm, pn; };
struct Gemm { const bf16_t* A; const bf16_t* Bt; int M, N, K, lda, ldb, hsb, tsb, aperm; };

struct StaticOrder {
    int nM, nN, nwg, G, c;
    __host__ __device__ void init(int M, int N, int G_, int c_) { nM = M / BM; nN = N / BM; nwg = nM * nN; G = G_; c = c_; }
    __host__ __device__ bool next(int i, Unit& u) const {
        const long L = (long)i * G + c; if (L >= nwg) return false;
        int wgid = (int)L; { const int q = nwg / NXCD, r = nwg % NXCD, xcd = wgid % NXCD, off = wgid / NXCD; wgid = (xcd < r ? xcd * (q + 1) : r * (q + 1) + (xcd - r) * q) + off; }
        const int nig = WGM * nN, gid = wgid / nig, fm = gid * WGM, gsz = (nM - fm) < WGM ? (nM - fm) : WGM;
        u.pm = fm + ((wgid % nig) % gsz); u.pn = (wgid % nig) / gsz; return true;
    }
    __device__ __forceinline__ void a_ready(const Unit&) const {}
    __device__ __forceinline__ void done(const Unit&) const {}
};


struct ListOrder {
    int base, cnt, nN;
    __host__ __device__ bool next(int i, Unit& u) const { if (i >= cnt) return false; const int id = base + i; u.pm = id / nN; u.pn = id % nN; return true; }
    __device__ __forceinline__ void a_ready(const Unit&) const {}
    __device__ __forceinline__ void done(const Unit&) const {}
};

__device__ __forceinline__ unsigned cvt_pk_bf16(float lo, float hi) { unsigned r; asm volatile("v_cvt_pk_bf16_f32 %0, %1, %2" : "=v"(r) : "v"(lo), "v"(hi)); return r; }

struct EpiF32 {
    static constexpr bool PERM = false, AFTER_DRAIN = false;
    float* C; int ldc;
    __device__ __forceinline__ void operator()(const f32x4 (&acc)[2][2][4][2], const Unit& u, int wr, int wc, int fr, int fq) const {
        const int row0 = u.pm * BM + wr * 64 + fr, col0 = u.pn * BM + wc * 32 + 4 * fq;
#pragma unroll
        for (int ai = 0; ai < 2; ++ai)
#pragma unroll
            for (int m = 0; m < 4; ++m) { float* rowp = C + (size_t)(row0 + ai * HALF + m * 16) * ldc + col0;
#pragma unroll
                for (int bj = 0; bj < 2; ++bj)
#pragma unroll
                    for (int n = 0; n < 2; ++n) *(f32x4*)(rowp + bj * HALF + n * 16) = acc[ai][bj][m][n]; }
    }
};
struct EpiBf16 {
    static constexpr bool PERM = true, AFTER_DRAIN = false;
    bf16_t* O; int ldc;
    __device__ __forceinline__ void operator()(const f32x4 (&acc)[2][2][4][2], const Unit& u, int wr, int wc, int fr, int fq) const {
        const int row0 = u.pm * BM + wr * 64 + fr; const int col0 = u.pn * BM + wc * 32 + 8 * fq;
#pragma unroll
        for (int ai = 0; ai < 2; ++ai)
#pragma unroll
            for (int m = 0; m < 4; ++m) { bf16_t* rowp = O + (size_t)(row0 + ai * HALF + m * 16) * ldc + col0;
#pragma unroll
                for (int bj = 0; bj < 2; ++bj) { const f32x4 v0 = acc[ai][bj][m][0], v1 = acc[ai][bj][m][1];
                    u32x4 w; w.x = cvt_pk_bf16(v0[0], v0[1]); w.y = cvt_pk_bf16(v0[2], v0[3]); w.z = cvt_pk_bf16(v1[0], v1[1]); w.w = cvt_pk_bf16(v1[2], v1[3]);
                    *(u32x4*)(rowp + bj * HALF) = w; } }
    }
};

struct EpiX {
    static constexpr bool PERM = true, AFTER_DRAIN = false;
    bf16_t* O; int ldc; int mode; float* ssq_q; float* ssq_kv; const float* COS; const float* SIN; float qscale;
    __device__ __forceinline__ void operator()(const f32x4 (&acc)[2][2][4][2], const Unit& u, int wr, int wc, int fr, int fq) const {
        const int row0 = u.pm * BM + wr * 64 + fr; const int col0 = u.pn * BM + wc * 32 + 8 * fq;
        const bool do_ssq = (mode == 0) && (u.pn <= 2);
#pragma unroll
        for (int ai = 0; ai < 2; ++ai)
#pragma unroll
            for (int m = 0; m < 4; ++m) { const int row = row0 + ai * HALF + m * 16; bf16_t* rowp = O + (size_t)row * ldc + col0;
                float sc = 1.0f;
                if (mode == 1) sc = rsqrtf(ssq_q[row] * (1.0f / 512.0f) + 1e-6f) * qscale; else if (mode == 2) sc = rsqrtf(ssq_kv[row] * (1.0f / 256.0f) + 1e-6f);
                float ss = 0.f;
#pragma unroll
                for (int bj = 0; bj < 2; ++bj) { f32x4 v0 = acc[ai][bj][m][0] * sc, v1 = acc[ai][bj][m][1] * sc;
                    const int span = u.pn * BM + bj * HALF + wc * 32;
                    int roff = -1;
                    if (mode == 0) { if (span == 768 || span == 800) roff = span - 768; }
                    else if (mode == 1) { const int d = span % 192; if (d >= 128) roff = d - 128; }
                    if (roff >= 0) { const int ib = (roff >> 1) + 4 * fq;
                        const f32x4 cs = *(const f32x4*)(COS + (size_t)row * 32 + ib), sn = *(const f32x4*)(SIN + (size_t)row * 32 + ib);
                        f32x4 w0, w1;
                        w0[0] = v0[0] * cs[0] - v0[1] * sn[0]; w0[1] = v0[0] * sn[0] + v0[1] * cs[0]; w0[2] = v0[2] * cs[1] - v0[3] * sn[1]; w0[3] = v0[2] * sn[1] + v0[3] * cs[1];
                        w1[0] = v1[0] * cs[2] - v1[1] * sn[2]; w1[1] = v1[0] * sn[2] + v1[1] * cs[2]; w1[2] = v1[2] * cs[3] - v1[3] * sn[3]; w1[3] = v1[2] * sn[3] + v1[3] * cs[3];
                        v0 = w0; v1 = w1; }
                    if (do_ssq) ss += ((v0[0] * v0[0] + v0[1] * v0[1]) + (v0[2] * v0[2] + v0[3] * v0[3])) + ((v1[0] * v1[0] + v1[1] * v1[1]) + (v1[2] * v1[2] + v1[3] * v1[3]));
                    u32x4 w; w.x = cvt_pk_bf16(v0[0], v0[1]); w.y = cvt_pk_bf16(v0[2], v0[3]); w.z = cvt_pk_bf16(v1[0], v1[1]); w.w = cvt_pk_bf16(v1[2], v1[3]);
                    *(u32x4*)(rowp + bj * HALF) = w; }
                if (do_ssq) { ss += __shfl_xor(ss, 16); ss += __shfl_xor(ss, 32);
                    if (fq == 0) atomicAdd((u.pn < 2 ? ssq_q : ssq_kv) + row, ss); }
            }
    }
};

struct EpiConv {
    static constexpr bool PERM = true, AFTER_DRAIN = false;
    bf16_t* G; bf16_t* E; const float* cw; const float* cb; int ff, ff2;
    template <int CTRL> static __device__ __forceinline__ float dpp(float x) { return __builtin_bit_cast(float, __builtin_amdgcn_update_dpp(0, __builtin_bit_cast(int, x), CTRL, 0xf, 0xf, true)); }
    static __device__ __forceinline__ float gelu(float x) { const float t = x * x, u = __builtin_fmaf(t, -0.10294324f, -2.3022082f); return x * __builtin_amdgcn_rcpf(1.0f + __builtin_amdgcn_exp2f(x * u)); }
    __device__ __forceinline__ void operator()(const f32x4 (&acc)[2][2][4][2], const Unit& u, int wr, int wc, int fr, int fq) const {
        const int fl = wc * 32 + 8 * fq, f0 = u.pn * HALF + fl;
        constexpr int SHR1 = 0x111, SHL1 = 0x101;
#pragma unroll
        for (int n = 0; n < 2; ++n) {
            const int f = f0 + 4 * n;
            const f32x4 g0 = *(const f32x4*)(cw + f), g1 = *(const f32x4*)(cw + ff2 + f), g2 = *(const f32x4*)(cw + 2 * ff2 + f), gb = *(const f32x4*)(cb + f);
            const f32x4 v0 = *(const f32x4*)(cw + ff + f), v1 = *(const f32x4*)(cw + ff2 + ff + f), v2 = *(const f32x4*)(cw + 2 * ff2 + ff + f), vb = *(const f32x4*)(cb + ff + f);
#pragma unroll
            for (int ai = 0; ai < 2; ++ai) {
                const int grp = u.pm * 4 + ai * 2 + wr;
#pragma unroll
                for (int m = 0; m < 4; ++m) { const int row = u.pm * BM + ai * HALF + wr * 64 + 4 * fr + m;
                    const f32x4 a = acc[ai][0][m][n], b = acc[ai][1][m][n];
                    const f32x4 ap = acc[ai][0][m > 0 ? m - 1 : 3][n], bp = acc[ai][1][m > 0 ? m - 1 : 3][n];
                    const f32x4 an = acc[ai][0][m < 3 ? m + 1 : 0][n], bn = acc[ai][1][m < 3 ? m + 1 : 0][n];
                    float og[4];
#pragma unroll
                    for (int c = 0; c < 4; ++c) {
                        float ga = __builtin_fmaf(g1[c], a[c], gb[c]), va = __builtin_fmaf(v1[c], b[c], vb[c]);
                        ga = __builtin_fmaf(g0[c], m > 0 ? ap[c] : dpp<SHR1>(ap[c]), ga); va = __builtin_fmaf(v0[c], m > 0 ? bp[c] : dpp<SHR1>(bp[c]), va);
                        ga = __builtin_fmaf(g2[c], m < 3 ? an[c] : dpp<SHL1>(an[c]), ga); va = __builtin_fmaf(v2[c], m < 3 ? bn[c] : dpp<SHL1>(bn[c]), va);
                        og[c] = gelu(ga) * va; }
                    uint2 o2; o2.x = cvt_pk_bf16(og[0], og[1]); o2.y = cvt_pk_bf16(og[2], og[3]);
                    *(uint2*)(G + (size_t)row * ff + f) = o2;
                    if ((m < 2 && fr == 0) || (m >= 2 && fr == 15)) {
                        bf16_t* ep = E + ((size_t)(u.pn * 256 + grp) * 4 + m) * 256 + fl + 4 * n;
                        uint2 eg; eg.x = cvt_pk_bf16(a[0], a[1]); eg.y = cvt_pk_bf16(a[2], a[3]); uint2 ev; ev.x = cvt_pk_bf16(b[0], b[1]); ev.y = cvt_pk_bf16(b[2], b[3]);
                        *(uint2*)ep = eg; *(uint2*)(ep + HALF) = ev; }
                }
            }
        }
    }
};
template <class Epi, class Sched, bool ALIGN_EPI = false, bool SP2 = false>
__device__ __forceinline__ void gemm_phase(PG8_LAS unsigned char* lds, const Gemm g, const Sched& S, const Epi& E, const int tid) {
    const int  wid = __builtin_amdgcn_readfirstlane(tid >> 6), lane = tid & 63, wr = wid >> 2, wc = wid & 3, fr = lane & 15, fq = lane >> 4;
    const int K = g.K, nt = K / BK;
    unsigned voffA[2], voffB[2];
#pragma unroll
    for (int i = 0; i < 2; ++i) { int R, C; stage_rc(tid * 16 + i * 8192, R, C); const int Rb = Epi::PERM ? ((R & ~31) + perm32(R & 31)) : R;
        const int Ra = g.aperm ? ((R & ~63) + 4 * (R & 15) + ((R >> 4) & 3)) : R;
        voffA[i] = (unsigned)(Ra * g.lda + C) * 2u; voffB[i] = (unsigned)(Rb * g.ldb + C) * 2u; }
    const __amdgpu_buffer_rsrc_t srdA = __builtin_amdgcn_make_buffer_rsrc((void*)g.A, 0, -1, 0x00020000), srdB = __builtin_amdgcn_make_buffer_rsrc((void*)g.Bt, 0, -1, 0x00020000);
    const unsigned kstep = (unsigned)(BK * 2);
    const unsigned hsA = (unsigned)HALF * g.lda * 2, hsB = (unsigned)g.hsb * g.ldb * 2;
    const unsigned tsA = 2 * hsA, tsB = (unsigned)g.tsb * g.ldb * 2;
    const unsigned ldsw = (unsigned)wid * 1024u;
    const int aoff = lds_byte(wr * 64 + fr, fq * 8), boff = lds_byte(wc * 32 + fr, fq * 8);
#define PG8_SA(b, h) (((b) * 2 + (h)) * HTB)
#define PG8_SB(b, h) ((4 + (b) * 2 + (h)) * HTB)
#define PG8_SRD_voffA srdA
#define PG8_SRD_voffB srdB
#define PG8_STAGE(bufoff, soff, voff) do { _Pragma("unroll") for (int _i = 0; _i < 2; ++_i) \
        __builtin_amdgcn_raw_ptr_buffer_load_lds(PG8_SRD_##voff, (PG8_LAS void*)(lds + (bufoff) + ldsw + _i * 8192), 16, (voff)[_i], (soff), 0, 0); } while (0)
#define PG8_LDA(dst, b, h) do { _Pragma("unroll") for (int m = 0; m < 4; ++m) _Pragma("unroll") for (int k = 0; k < 2; ++k) dst[m][k] = *(const PG8_LAS bf16x8*)(lds + PG8_SA(b, h) + aoff + m * 2048 + k * 1024); } while (0)
#define PG8_LDB(dst, b, h) do { _Pragma("unroll") for (int n = 0; n < 2; ++n) _Pragma("unroll") for (int k = 0; k < 2; ++k) dst[n][k] = *(const PG8_LAS bf16x8*)(lds + PG8_SB(b, h) + boff + n * 2048 + k * 1024); } while (0)
#define PG8_MMA(ai, bj, At, Bt) do { __builtin_amdgcn_s_setprio(1); _Pragma("unroll") for (int m = 0; m < 4; ++m) _Pragma("unroll") for (int n = 0; n < 2; ++n) _Pragma("unroll") for (int k = 0; k < 2; ++k) \
        acc[ai][bj][m][n] = __builtin_amdgcn_mfma_f32_16x16x32_bf16(Bt[n][k], At[m][k], acc[ai][bj][m][n], 0, 0, 0); __builtin_amdgcn_s_setprio(0); } while (0)
#define PG8_WAIT_V(n) asm volatile("s_waitcnt vmcnt(" #n ")" ::: "memory")
#define PG8_WAIT_L(n) asm volatile("s_waitcnt lgkmcnt(" #n ")" ::: "memory")
#define PG8_BAR __builtin_amdgcn_s_barrier()
#define PG8_SCHED __builtin_amdgcn_sched_barrier(0)
    Unit cur, nxt; int ui = 0;
    if (!S.next(0, cur)) return;
    f32x4 acc[2][2][4][2];
#pragma unroll
    for (int a = 0; a < 2; ++a)
#pragma unroll
        for (int b = 0; b < 2; ++b)
#pragma unroll
            for (int m = 0; m < 4; ++m)
#pragma unroll
                for (int n = 0; n < 2; ++n) acc[a][b][m][n] = (f32x4){0.f, 0.f, 0.f, 0.f};
    bf16x8 At[4][2], B0[2][2], B1[2][2];
    unsigned cA = (unsigned)cur.pm * tsA, cB = (unsigned)cur.pn * tsB;
    S.a_ready(cur);
    if constexpr (SP2) {
        PG8_STAGE(PG8_SB(0, 0), cB, voffB); PG8_STAGE(PG8_SB(0, 1), cB + hsB, voffB); PG8_STAGE(PG8_SA(0, 0), cA, voffA); PG8_STAGE(PG8_SA(0, 1), cA + hsA, voffA);
        if (wr == 1) PG8_BAR;
        PG8_WAIT_V(2); PG8_BAR;
        PG8_STAGE(PG8_SB(1, 0), cB + kstep, voffB); PG8_STAGE(PG8_SA(1, 0), cA + kstep, voffA); PG8_STAGE(PG8_SB(1, 1), cB + hsB + kstep, voffB);
        PG8_WAIT_V(6); PG8_BAR;
    } else {
        PG8_STAGE(PG8_SB(0, 0), cB, voffB); PG8_STAGE(PG8_SA(0, 0), cA, voffA); PG8_STAGE(PG8_SB(0, 1), cB + hsB, voffB); PG8_STAGE(PG8_SA(0, 1), cA + hsA, voffA);
        if (wr == 1) PG8_BAR;
        PG8_WAIT_V(4); PG8_BAR;
        PG8_STAGE(PG8_SB(1, 0), cB + kstep, voffB); PG8_STAGE(PG8_SA(1, 0), cA + kstep, voffA); PG8_STAGE(PG8_SB(1, 1), cB + hsB + kstep, voffB);
        PG8_WAIT_V(6); PG8_BAR;
    }
    for (;;) {
        const bool has_next = S.next(ui + 1, nxt);
        const unsigned nA = has_next ? (unsigned)nxt.pm * tsA : cA, nB = has_next ? (unsigned)nxt.pn * tsB : cB;
        for (int t = 0; t < nt; t += 2) {
            const bool last = (t == nt - 2);
            const unsigned a1 = cA + (unsigned)(t + 1) * kstep;
            const unsigned a2 = last ? nA : cA + (unsigned)(t + 2) * kstep, b2 = last ? nB : cB + (unsigned)(t + 2) * kstep;
            const unsigned a3 = a2 + kstep, b3 = b2 + kstep;
            if (last && has_next) S.a_ready(nxt);
            if constexpr (SP2) {
            PG8_LDB(B0, 0, 0); PG8_LDB(B1, 0, 1); PG8_SCHED; PG8_LDA(At, 0, 0); PG8_STAGE(PG8_SA(1, 1), a1 + hsA, voffA);
            PG8_WAIT_V(8); PG8_WAIT_L(0); PG8_BAR; PG8_MMA(0, 0, At, B0); PG8_MMA(0, 1, At, B1); PG8_BAR; PG8_SCHED;
            PG8_LDA(At, 0, 1); PG8_STAGE(PG8_SB(0, 0), b2, voffB); PG8_STAGE(PG8_SB(0, 1), b2 + hsB, voffB); PG8_STAGE(PG8_SA(0, 0), a2, voffA);
            PG8_WAIT_V(8); PG8_WAIT_L(0); PG8_BAR; PG8_MMA(1, 0, At, B0); PG8_MMA(1, 1, At, B1); PG8_BAR; PG8_SCHED;
            PG8_LDB(B0, 1, 0); PG8_LDB(B1, 1, 1); PG8_SCHED; PG8_LDA(At, 1, 0); PG8_STAGE(PG8_SA(0, 1), a2 + hsA, voffA);
            PG8_WAIT_V(8); PG8_WAIT_L(0); PG8_BAR; PG8_MMA(0, 0, At, B0); PG8_MMA(0, 1, At, B1); PG8_BAR; PG8_SCHED;
            PG8_LDA(At, 1, 1); PG8_STAGE(PG8_SB(1, 0), b3, voffB); PG8_STAGE(PG8_SB(1, 1), b3 + hsB, voffB); PG8_STAGE(PG8_SA(1, 0), a3, voffA);
            PG8_WAIT_V(8); PG8_WAIT_L(0); PG8_BAR; PG8_MMA(1, 0, At, B0); PG8_MMA(1, 1, At, B1); PG8_BAR; PG8_SCHED;
            } else {
            PG8_LDB(B0, 0, 0); PG8_SCHED; PG8_LDA(At, 0, 0); PG8_STAGE(PG8_SA(1, 1), a1 + hsA, voffA);
            PG8_WAIT_L(8); PG8_BAR; PG8_WAIT_L(0); PG8_MMA(0, 0, At, B0); PG8_BAR; PG8_SCHED;
            PG8_LDB(B1, 0, 1); PG8_STAGE(PG8_SB(0, 0), b2, voffB);
            PG8_BAR; PG8_WAIT_L(0); PG8_MMA(0, 1, At, B1); PG8_BAR;
            PG8_LDA(At, 0, 1); PG8_STAGE(PG8_SA(0, 0), a2, voffA);
            PG8_BAR; PG8_WAIT_L(0); PG8_MMA(1, 0, At, B0); PG8_BAR; PG8_SCHED;
            PG8_STAGE(PG8_SB(0, 1), b2 + hsB, voffB);
            PG8_WAIT_V(6); PG8_BAR; PG8_MMA(1, 1, At, B1); PG8_BAR;
            PG8_LDB(B0, 1, 0); PG8_SCHED; PG8_LDA(At, 1, 0); PG8_STAGE(PG8_SA(0, 1), a2 + hsA, voffA);
            PG8_WAIT_L(8); PG8_BAR; PG8_WAIT_L(0); PG8_MMA(0, 0, At, B0); PG8_BAR; PG8_SCHED;
            PG8_LDB(B1, 1, 1); PG8_STAGE(PG8_SB(1, 0), b3, voffB);
            PG8_BAR; PG8_WAIT_L(0); PG8_MMA(0, 1, At, B1); PG8_BAR;
            PG8_LDA(At, 1, 1); PG8_STAGE(PG8_SA(1, 0), a3, voffA);
            PG8_BAR; PG8_WAIT_L(0); PG8_MMA(1, 0, At, B0); PG8_BAR; PG8_SCHED;
            PG8_STAGE(PG8_SB(1, 1), b3 + hsB, voffB);
            PG8_WAIT_V(6); PG8_BAR; PG8_MMA(1, 1, At, B1); PG8_BAR;
            }
        }
        if constexpr (ALIGN_EPI) { if (wr == 0) PG8_BAR; }
        if constexpr (!Epi::AFTER_DRAIN) { E(acc, cur, wr, wc, fr, fq); S.done(cur); }
        if (!has_next) break;
#pragma unroll
        for (int a = 0; a < 2; ++a)
#pragma unroll
            for (int b = 0; b < 2; ++b)
#pragma unroll
                for (int m = 0; m < 4; ++m)
#pragma unroll
                    for (int n = 0; n < 2; ++n) acc[a][b][m][n] = (f32x4){0.f, 0.f, 0.f, 0.f};
        cur = nxt; cA = nA; cB = nB; ++ui;
        if constexpr (ALIGN_EPI) { if (wr == 1) PG8_BAR; }
    }
    PG8_WAIT_V(0);
    if constexpr (!ALIGN_EPI) { if (wr == 0) PG8_BAR; }
    PG8_BAR;
    if constexpr (Epi::AFTER_DRAIN) { E.fused(acc, cur, wr, wc, fr, fq, lds, wid, lane); S.done(cur); }
#undef PG8_SA
#undef PG8_SB
#undef PG8_STAGE
#undef PG8_SRD_voffA
#undef PG8_SRD_voffB
#undef PG8_LDA
#undef PG8_LDB
#undef PG8_MMA
#undef PG8_WAIT_V
#undef PG8_WAIT_L
#undef PG8_BAR
#undef PG8_SCHED
}
}
#define GAS __attribute__((address_space(1)))
#define LAS __attribute__((address_space(3)))
typedef unsigned short bf16;
typedef unsigned v4u __attribute__((ext_vector_type(4)));
typedef float f32x4 __attribute__((ext_vector_type(4)));
typedef short bf16x8 __attribute__((ext_vector_type(8)));
typedef GAS unsigned gu32;
typedef GAS unsigned long long gu64;
#define RLX_AGENT __ATOMIC_RELAXED, __HIP_MEMORY_SCOPE_AGENT
#define LDS_WAIT() asm volatile("s_waitcnt lgkmcnt(0)" ::: "memory")
#define VM_WAIT() asm volatile("s_waitcnt vmcnt(0)" ::: "memory")
__device__ __forceinline__ unsigned long long rt() { return __builtin_amdgcn_s_memrealtime(); }
__device__ __forceinline__ unsigned f2bf(float f) { unsigned u = __builtin_bit_cast(unsigned, f); return (u + 0x7fffu + ((u >> 16) & 1u)) >> 16; }
__device__ __forceinline__ unsigned pk2(float lo, float hi) { return f2bf(lo) | (f2bf(hi) << 16); }

#define XB_TMO      128
#define XB_XCNT(j)  (256  + 64 * (j))
#define XB_XSUB(j)  (1280 + 64 * (j))
#define XB_XGEN(j)  (2304 + 64 * (j))
#define XB_TOP      3328
#define XB_TOPGEN   3392
#define XCD_BAR_WORDS 3456
#define XB_SPIN_CAP (1u << 18)

__device__ __forceinline__ unsigned xb_ld(unsigned* p)              { return __hip_atomic_load(p, __ATOMIC_RELAXED, __HIP_MEMORY_SCOPE_AGENT); }
__device__ __forceinline__ unsigned xb_add(unsigned* p, unsigned v) { return __hip_atomic_fetch_add(p, v, __ATOMIC_RELAXED, __HIP_MEMORY_SCOPE_AGENT); }
__device__ __forceinline__ unsigned xb_xcc_id() { return (unsigned)__builtin_amdgcn_s_getreg((3 << 11) | 20) & 0xFu; }
#define XB_SPIN(cond, bar) do { unsigned _sp = 0; while (cond) { __builtin_amdgcn_s_sleep(1); \
    if ((++_sp & 255u) == 0u) { if (xb_ld(&(bar)[XB_TMO])) break; if (_sp > XB_SPIN_CAP) { atomicAdd(&(bar)[XB_TMO], 1u); break; } } } } while (0)

struct XcdBarrier {
    unsigned* bar; unsigned x;
    volatile LAS unsigned* st;
};

__device__ __forceinline__ XcdBarrier xcd_barrier_post(unsigned* bar, volatile LAS unsigned* st, int tid) {
    XcdBarrier b; b.bar = bar; b.x = xb_xcc_id(); b.st = st;
    if (tid == 0) (void)xb_add(&bar[XB_XCNT(b.x)], 1u);
    return b;
}
__device__ __forceinline__ void xcd_barrier_complete(unsigned* bar, unsigned x, unsigned& nloc, unsigned& nx) {
    const unsigned G = gridDim.x * gridDim.y * gridDim.z;
    unsigned sum, cnt, mine, sp = 0u;
    for (;;) {
        sum = 0u; cnt = 0u; mine = 0u;
#pragma unroll
        for (unsigned j = 0; j < 16; ++j) { const unsigned c = xb_ld(&bar[XB_XCNT(j)]); sum += c; cnt += (c > 0u) ? 1u : 0u; mine = (j == x) ? c : mine; }
        if (sum == G) break;
        __builtin_amdgcn_s_sleep(1);
        if ((++sp & 255u) == 0u) { if (xb_ld(&bar[XB_TMO])) break; if (sp > XB_SPIN_CAP) { atomicAdd(&bar[XB_TMO], 1u); break; } }
    }
    nloc = mine > 0u ? mine : 1u; nx = cnt > 0u ? cnt : 1u;
}

__device__ __forceinline__ void xcd_barrier(const XcdBarrier& b, int tid) {
    asm volatile("s_waitcnt vmcnt(0)" ::: "memory");
    __syncthreads();
    if (tid == 0) {
        unsigned* bar = b.bar;
        __builtin_amdgcn_s_waitcnt(0);
        unsigned nloc = b.st[0], nx = b.st[1];
        if (nloc == 0u) { xcd_barrier_complete(bar, b.x, nloc, nx); b.st[0] = nloc; b.st[1] = nx; }
        const unsigned old = xb_add(&bar[XB_XSUB(b.x)], 1u);
        const unsigned gen = old / nloc;
        if (old + 1u == (gen + 1u) * nloc) {
            __builtin_amdgcn_fence(__ATOMIC_RELEASE, "agent");
            asm volatile("s_waitcnt vmcnt(0)" ::: "memory");
            const unsigned og = xb_add(&bar[XB_TOP], 1u);
            const unsigned tg = og / nx;
            if (og + 1u == (tg + 1u) * nx) xb_add(&bar[XB_TOPGEN], 1u);
            else XB_SPIN(xb_ld(&bar[XB_TOPGEN]) == tg, bar);
            __builtin_amdgcn_fence(__ATOMIC_ACQUIRE, "agent");
            xb_add(&bar[XB_XGEN(b.x)], 1u);
            asm volatile("s_waitcnt vmcnt(0)" ::: "memory");
        } else {
            XB_SPIN(xb_ld(&bar[XB_XGEN(b.x)]) == gen, bar);
            __builtin_amdgcn_fence(__ATOMIC_ACQUIRE, "agent");
            asm volatile("s_waitcnt vmcnt(0)" ::: "memory");
        }
    }
    __syncthreads();
}

constexpr int NWAVES = 8, NTHREADS = 512;
constexpr int BATCH = 8, SEQ = 2048, DM = 2048, M = BATCH * SEQ;
constexpr int INW = 3904, INWP = 4096;
constexpr int QW = 1536, KVW = 2048, FF = 5632, FF2 = 11264, NMOD = 12288;
constexpr int C_QLAT = 0, C_KVLAT = 512, C_KROPE = 768, C_DQ = 832, C_DK = 1856, C_DV = 2880;
constexpr int MOD_SHA = 0, MOD_SCA = 2048, MOD_GA = 4096, MOD_SHF = 6144, MOD_SCF = 8192, MOD_GF = 10240;
constexpr float EPS = 1e-6f, MLA_SCALE = 0.07216878364870322f, DIFF_SCALE = 0.125f, LAMBDA_INIT = 0.2f;
constexpr int UCH = 4096, NUCH = M / UCH;

constexpr size_t MiB = 1u << 20;
constexpr size_t WS_CTL = 0, CTL_ZERO_BYTES = 1 * MiB, WS_MOD = 512 * 1024, WS_SSQQ = 128 * 1024, WS_SSQKV = 192 * 1024;
constexpr int TKF_OFF = 1024;
constexpr size_t WS_COS = 2 * MiB, WS_SIN = 4 * MiB, WS_TK = 6 * MiB;
constexpr size_t WS_WIN = 8 * MiB, WS_WUQ = 24 * MiB, WS_WUKV = 26 * MiB, WS_WO = 28 * MiB, WS_WUP = 36 * MiB, WS_WDN = 80 * MiB;
constexpr size_t WS_H = 104 * MiB;
constexpr size_t WS_PROJ = 168 * MiB, WS_Q = 296 * MiB, WS_KV = 344 * MiB, WS_AO = 408 * MiB;
constexpr size_t WS_Y = 168 * MiB;
constexpr size_t WS_G = 168 * MiB;
constexpr size_t WS_E = 344 * MiB;
constexpr size_t WS_Y2 = 344 * MiB;
constexpr size_t WS_X1 = 408 * MiB;
constexpr size_t WS_END = 512 * MiB;
constexpr int CW_TMO = 0, CW_CODE = 1, CW_BAR = 4096;

constexpr int LDS_BYTES = 147456;
constexpr int LDSCTL_OFF = LDS_BYTES - 512, MISC_OFF = LDSCTL_OFF;

__device__ __forceinline__ float bf2f(unsigned short u) { return __uint_as_float((unsigned)u << 16); }
__device__ __forceinline__ float bflo(unsigned w) { return __uint_as_float(w << 16); }
__device__ __forceinline__ float bfhi(unsigned w) { return __uint_as_float(w & 0xffff0000u); }
__device__ __forceinline__ float wave_sum(float v) {
#pragma unroll
    for (int o = 1; o < 64; o <<= 1) v += __shfl_xor(v, o);
    return v;
}
__device__ __forceinline__ float wave_max(float v) {
#pragma unroll
    for (int o = 1; o < 64; o <<= 1) v = fmaxf(v, __shfl_xor(v, o));
    return v;
}
__device__ __forceinline__ int t5_bucket(int rel) {
    const int ret = rel > 0 ? 16 : 0; const int n = rel < 0 ? -rel : rel; const float nf = (float)(n > 1 ? n : 1);
    int large = 8 + (int)(logf(nf / 8.0f) / 2.772588722239781f * 8.0f);
    large = large < 15 ? large : 15;
    return ret + (n < 8 ? n : large);
}
__device__ __forceinline__ float gelu_tanh(float x) {
    const float z2 = 1.5957691216057308f * (x + 0.044715f * x * x * x);
    return x / (1.0f + __expf(-z2));
}


constexpr int PTR_OFF = LDSCTL_OFF + 128;
enum { P_X = 0, P_C, P_POS, P_RELB, P_ADAW, P_ADAB, P_APRE, P_APOST, P_WIN, P_QN, P_WUQ, P_KVN, P_WUKV, P_LQ1, P_LK1, P_LQ2, P_LK2, P_SUBLN, P_WO, P_FPRE, P_FPOST, P_WUP, P_CW, P_CB, P_WDN, P_OUT, P_WS };
__device__ __forceinline__ const void* ldptr(LAS unsigned char* lds, int i) {
    const unsigned long long v = *(volatile LAS unsigned long long*)(lds + PTR_OFF + 8 * i);
    const unsigned lo = __builtin_amdgcn_readfirstlane((unsigned)v), hi = __builtin_amdgcn_readfirstlane((unsigned)(v >> 32));
    return (const void*)(GAS const void*)(((unsigned long long)hi << 32) | lo);
}
#define LPF(i) ((const float*)ldptr(lds, (i)))
#define LPWS() ((unsigned char*)ldptr(lds, P_WS))

__device__ __forceinline__ int dst_row(int s, int map) {
    if (map == 1) { if (s >= C_KROPE && s < C_KROPE + 64) { const int d = s - C_KROPE; return C_KROPE + 2 * (d & 31) + (d >> 5); } return s; }
    if (map == 2) { const int h = s / 192, d = s % 192; if (d >= 128) return h * 192 + 128 + 2 * ((d - 128) & 31) + ((d - 128) >> 5); return s; }
    return s;
}
__device__ __forceinline__ void p0_transpose_item(const float* W, const float* sv, int K, int N, bf16* WT, LAS float* scr, int item, int lane, int map) {
    const int nblk = N / 64, kb = item / nblk, nb = item % nblk, k0 = 64 * kb, n0 = 64 * nb;
    const int lr = lane >> 4, lc = (lane & 15) * 4;
    f32x4 v[16];
#pragma unroll
    for (int i = 0; i < 16; ++i) v[i] = __builtin_nontemporal_load((const f32x4*)(W + (size_t)(k0 + 4 * i + lr) * N + n0 + lc));
#pragma unroll
    for (int i = 0; i < 16; ++i) { const int kk = 4 * i + lr; f32x4 w = v[i]; if (sv) w = w * sv[k0 + kk];
        LAS float* d = scr + kk * 65 + lc; d[0] = w[0]; d[1] = w[1]; d[2] = w[2]; d[3] = w[3]; }
    LDS_WAIT(); asm volatile("" ::: "memory");
    const int c = lane & 7;
#pragma unroll
    for (int j = 0; j < 8; ++j) { const int n = (lane >> 3) + 8 * j; const LAS float* s = scr + (8 * c) * 65 + n;
        v4u o; o.x = pk2(s[0 * 65], s[1 * 65]); o.y = pk2(s[2 * 65], s[3 * 65]); o.z = pk2(s[4 * 65], s[5 * 65]); o.w = pk2(s[6 * 65], s[7 * 65]);
        __builtin_nontemporal_store(o, (GAS v4u*)(WT + (size_t)dst_row(n0 + n, map) * K + k0 + 8 * c)); }
    LDS_WAIT(); asm volatile("" ::: "memory");
}
__device__ __forceinline__ void p0_do_item(LAS unsigned char* lds, LAS float* scr, int r, int lane) {
    constexpr int I_IN = (DM / 64) * (INW / 64), I_UQ = (512 / 64) * (QW / 64), I_UKV = (256 / 64) * (KVW / 64), I_O = (DM / 64) * (DM / 64), I_UP = (DM / 64) * (FF2 / 64);
    unsigned char* ws = LPWS();
    if (r < I_IN) { p0_transpose_item(LPF(P_WIN), nullptr, DM, INW, (bf16*)(ws + WS_WIN), scr, r, lane, 1); return; } r -= I_IN;
    if (r < I_UQ) { p0_transpose_item(LPF(P_WUQ), LPF(P_QN), 512, QW, (bf16*)(ws + WS_WUQ), scr, r, lane, 2); return; } r -= I_UQ;
    if (r < I_UKV) { p0_transpose_item(LPF(P_WUKV), LPF(P_KVN), 256, KVW, (bf16*)(ws + WS_WUKV), scr, r, lane, 0); return; } r -= I_UKV;
    if (r < I_O) { p0_transpose_item(LPF(P_WO), nullptr, DM, DM, (bf16*)(ws + WS_WO), scr, r, lane, 0); return; } r -= I_O;
    if (r < I_UP) { p0_transpose_item(LPF(P_WUP), nullptr, DM, FF2, (bf16*)(ws + WS_WUP), scr, r, lane, 0); return; } r -= I_UP;
    p0_transpose_item(LPF(P_WDN), nullptr, FF, DM, (bf16*)(ws + WS_WDN), scr, r, lane, 0);
}
__device__ __forceinline__ void p0_prologue(LAS unsigned char* lds, int tid, int lane, int wave, int G, int bid) {
    constexpr int I_IN = (DM / 64) * (INW / 64), I_UQ = (512 / 64) * (QW / 64), I_UKV = (256 / 64) * (KVW / 64), I_O = (DM / 64) * (DM / 64), I_UP = (DM / 64) * (FF2 / 64), I_DN = (FF / 64) * (DM / 64);
    const int NITEMS = (G == 256) ? I_IN + I_UQ + I_UKV : I_IN + I_UQ + I_UKV + I_O + I_UP + I_DN;
    const int NEXTRA = (G == 256) ? 2 * G : 0;
    LAS float* scr = (LAS float*)(lds + wave * 16640);
    const int gw = bid * NWAVES + wave, NGW = G * NWAVES;
    const int Rg = (bid < 256) ? (256 - bid + G - 1) / G : 0;
#pragma nounroll
    for (int pass = 0; pass <= Rg; ++pass) {
        unsigned char* ws = LPWS(); float* mod = (float*)(ws + WS_MOD); const float* in_c = LPF(P_C); const float* in_adaw = LPF(P_ADAW); const float* in_adab = LPF(P_ADAB);
        const int item = bid + pass * G, kc = item >> 5, cc = item & 31;
        const bool gemv = (pass < Rg);
        LAS float* scl = (LAS float*)lds;
        LAS float* red = (LAS float*)(lds + 8192);
        if (gemv) {
            for (int e = tid; e < 2048; e += NTHREADS) { const int b = e >> 8, i = e & 255; const float cv = in_c[b * DM + 256 * kc + i]; scl[e] = cv / (1.0f + __expf(-cv)); }
            __syncthreads();
            if (tid < 384) {
                const int kg = tid / 96, ct = tid % 96;
                f32x4 acc[8];
#pragma unroll
                for (int b = 0; b < 8; ++b) acc[b] = (f32x4){0.f, 0.f, 0.f, 0.f};
                const float* wp = in_adaw + (size_t)(256 * kc + 64 * kg) * NMOD + 384 * cc + 4 * ct;
#pragma unroll 8
                for (int kk = 0; kk < 64; ++kk) {
                    const f32x4 w = __builtin_nontemporal_load((const f32x4*)(wp + (size_t)kk * NMOD));
#pragma unroll
                    for (int b = 0; b < 8; ++b) acc[b] += w * scl[b * 256 + 64 * kg + kk];
                }
#pragma unroll
                for (int b = 0; b < 8; ++b) *(LAS f32x4*)(red + (kg * 8 + b) * 384 + 4 * ct) = acc[b];
            }
        }
        int it, end, step;
        if (gemv) { it = (pass == 0 && wave >= 6 && NEXTRA) ? NITEMS - NEXTRA + bid * 2 + (wave - 6) : 0x7fffffff; end = (it == 0x7fffffff) ? 0 : it + 1; step = 1; }
        else { it = gw; end = NITEMS - NEXTRA; step = NGW; }
        for (; it < end; it += step) p0_do_item(lds, scr, it, lane);
        if (gemv) {
            __syncthreads();
            for (int o = tid; o < 3072; o += NTHREADS) { const int b = o / 384, col = o % 384;
                float v = (red[(0 * 8 + b) * 384 + col] + red[(1 * 8 + b) * 384 + col]) + (red[(2 * 8 + b) * 384 + col] + red[(3 * 8 + b) * 384 + col]);
                if (kc == 0) v += in_adab[384 * cc + col];
                atomicAdd(mod + b * NMOD + 384 * cc + col, v); }
            __syncthreads();
        }
    }
    unsigned char* ws = LPWS();
    { v4u* z = (v4u*)(ws + WS_WIN + (size_t)INW * DM * 2); const v4u zero = {0u, 0u, 0u, 0u};
      for (int i = bid * NTHREADS + tid; i < (INWP - INW) * DM * 2 / 16; i += G * NTHREADS) z[i] = zero; }
    { float* COS = (float*)(ws + WS_COS); float* SIN = (float*)(ws + WS_SIN); const int* in_pos = (const int*)ldptr(lds, P_POS);
      for (int idx = bid * NTHREADS + tid; idx < M * 32; idx += G * NTHREADS) {
          const int m = idx >> 5, i = idx & 31;
          const float inv = 1.0f / exp2f((float)i * (13.287712379549449f / 32.0f));
          const float ang = (float)in_pos[m] * inv;
          double t = (double)ang * 0.15915494309189535; t -= rint(t);
          const float tf = (float)t;
          COS[idx] = __builtin_amdgcn_cosf(tf); SIN[idx] = __builtin_amdgcn_sinf(tf); } }
    { int* TK = (int*)(ws + WS_TK); const int* in_pos = (const int*)ldptr(lds, P_POS);
      for (int it = gw; it < BATCH * (SEQ / 64); it += NGW) { const int p = in_pos[it * 64 + lane]; int mn = p, mx = p;
#pragma unroll
          for (int of = 1; of < 64; of <<= 1) { mn = min(mn, __shfl_xor(mn, of)); mx = max(mx, __shfl_xor(mx, of)); }
          const bool cont = __all(p - lane == __builtin_amdgcn_readfirstlane(p));
          if (lane == 0) { TK[2 * it] = mn; TK[2 * it + 1] = mx; TK[TKF_OFF + it] = cont ? 1 : 0; } } }
}

__device__ __forceinline__ void prenorm_phase(const float* x, const float* wn, const float* mod, int off_sh, int off_sc, bf16* H, int lane, int wave, int G, int bid) {
    const int gw = bid * NWAVES + wave, NGW = G * NWAVES;
    const int rpw = M / NGW;
    if (rpw * NGW == M && rpw > 0 && (SEQ % rpw) == 0) {
        const int m0 = gw * rpw; const float* mb = mod + (size_t)(m0 >> 11) * NMOD;
        f32x4 cc[8], sh[8];
        const __amdgpu_buffer_rsrc_t wt_h = __builtin_amdgcn_make_buffer_rsrc((void*)H, 0, -1, 0x00020000);
#pragma unroll
        for (int j = 0; j < 8; ++j) { const int col = (lane + 64 * j) * 4; cc[j] = *(const f32x4*)(wn + col) * (*(const f32x4*)(mb + off_sc + col) + 1.0f); sh[j] = *(const f32x4*)(mb + off_sh + col); }
        for (int r = 0; r < rpw; ++r) { const int m = m0 + r;
            const f32x4* xr = (const f32x4*)(x + (size_t)m * DM) + lane;
            f32x4 v[8]; float ss = 0.f;
#pragma unroll
            for (int j = 0; j < 8; ++j) { v[j] = __builtin_nontemporal_load(xr + 64 * j); ss += (v[j].x * v[j].x + v[j].y * v[j].y) + (v[j].z * v[j].z + v[j].w * v[j].w); }
            const float rstd = rsqrtf(wave_sum(ss) * (1.0f / DM) + EPS);
#pragma unroll
            for (int j = 0; j < 8; ++j) { const int col = (lane + 64 * j) * 4;
                const f32x4 o = v[j] * rstd * cc[j] + sh[j];
                pg8::u32x2 pk; pk.x = pk2(o.x, o.y); pk.y = pk2(o.z, o.w);
                __builtin_amdgcn_raw_buffer_store_b64(pk, wt_h, col * 2, (int)((unsigned)m * (DM * 2u)), WT_AUX); } }
        return;
    }
    for (int m = gw; m < M; m += NGW) {
        const f32x4* xr = (const f32x4*)(x + (size_t)m * DM) + lane;
        f32x4 v[8]; float ss = 0.f;
#pragma unroll
        for (int j = 0; j < 8; ++j) { v[j] = __builtin_nontemporal_load(xr + 64 * j); ss += (v[j].x * v[j].x + v[j].y * v[j].y) + (v[j].z * v[j].z + v[j].w * v[j].w); }
        const float rstd = rsqrtf(wave_sum(ss) * (1.0f / DM) + EPS);
        const float* mb = mod + (size_t)(m >> 11) * NMOD;
#pragma unroll
        for (int j = 0; j < 8; ++j) { const int col = (lane + 64 * j) * 4;
            const f32x4 w = *(const f32x4*)(wn + col), sh = *(const f32x4*)(mb + off_sh + col), sc = *(const f32x4*)(mb + off_sc + col);
            const f32x4 o = v[j] * rstd * w * (sc + 1.0f) + sh;
            uint2 pk; pk.x = pk2(o.x, o.y); pk.y = pk2(o.z, o.w);
            *(uint2*)(H + (size_t)m * DM + col) = pk; }
    }
}
template <bool NEXT>
__device__ __forceinline__ void post_phase(const bf16* Y, const void* xin_, void* xout_, const float* wpost, const float* mod, int off_g,
                                           const float* wn2, int off_sh, int off_sc, bf16* Hn, int lane, int wave, int G, int bid) {
    const int gw = bid * NWAVES + wave, NGW = G * NWAVES;
    const int rpw = M / NGW;
    if (rpw * NGW == M && rpw > 0 && (SEQ % rpw) == 0) {
        const int m0 = gw * rpw; const float* mb = mod + (size_t)(m0 >> 11) * NMOD;
        f32x4 gwv[8], c2[8], s2[8];
        const __amdgpu_buffer_rsrc_t wt_x = __builtin_amdgcn_make_buffer_rsrc((void*)xout_, 0, -1, 0x00020000), wt_h = __builtin_amdgcn_make_buffer_rsrc((void*)Hn, 0, -1, 0x00020000);
#pragma unroll
        for (int j = 0; j < 8; ++j) { const int col = (lane + 64 * j) * 4; gwv[j] = *(const f32x4*)(wpost + col) * *(const f32x4*)(mb + off_g + col);
            if constexpr (NEXT) { c2[j] = *(const f32x4*)(wn2 + col) * (*(const f32x4*)(mb + off_sc + col) + 1.0f); s2[j] = *(const f32x4*)(mb + off_sh + col); } }
        for (int r = 0; r < rpw; ++r) { const int m = m0 + r;
            const uint2* yr = (const uint2*)(Y + (size_t)m * DM) + lane;
            const f32x4* xr = (const f32x4*)((const float*)xin_ + (size_t)m * DM) + lane;
            const uint2* xb = (const uint2*)((const bf16*)xin_ + (size_t)m * DM) + lane;
            f32x4 v[8]; float ss = 0.f;
            unsigned long long yq[8]; f32x4 xf[8]; unsigned long long xq[8];
#pragma unroll
            for (int j = 0; j < 8; ++j) yq[j] = __builtin_nontemporal_load((const unsigned long long*)(yr + 64 * j));
#pragma unroll
            for (int j = 0; j < 8; ++j) { if constexpr (NEXT) xf[j] = __builtin_nontemporal_load(xr + 64 * j); else xq[j] = __builtin_nontemporal_load((const unsigned long long*)(xb + 64 * j)); }
#pragma unroll
            for (int j = 0; j < 8; ++j) { const unsigned y0 = (unsigned)yq[j], y1 = (unsigned)(yq[j] >> 32);
                v[j] = (f32x4){bflo(y0), bfhi(y0), bflo(y1), bfhi(y1)}; ss += (v[j].x * v[j].x + v[j].y * v[j].y) + (v[j].z * v[j].z + v[j].w * v[j].w); }
            const float rstd = rsqrtf(wave_sum(ss) * (1.0f / DM) + EPS);
            float ss2 = 0.f;
#pragma unroll
            for (int j = 0; j < 8; ++j) { const int col = (lane + 64 * j) * 4;
                f32x4 xv;
                if constexpr (NEXT) xv = xf[j];
                else { const unsigned x0 = (unsigned)xq[j], x1 = (unsigned)(xq[j] >> 32); xv = (f32x4){bflo(x0), bfhi(x0), bflo(x1), bfhi(x1)}; }
                const f32x4 o = xv + gwv[j] * (v[j] * rstd);
                v[j] = o; ss2 += (o.x * o.x + o.y * o.y) + (o.z * o.z + o.w * o.w);
                if constexpr (NEXT) { pg8::u32x2 pk; pk.x = pk2(o.x, o.y); pk.y = pk2(o.z, o.w); __builtin_amdgcn_raw_buffer_store_b64(pk, wt_x, col * 2, (int)((unsigned)m * (DM * 2u)), WT_AUX); }
                else __builtin_amdgcn_raw_buffer_store_b128(__builtin_bit_cast(pg8::u32x4, o), wt_x, col * 4, (int)((unsigned)m * (DM * 4u)), WT_AUX); }
            if constexpr (NEXT) {
                const float rstd2 = rsqrtf(wave_sum(ss2) * (1.0f / DM) + EPS);
#pragma unroll
                for (int j = 0; j < 8; ++j) { const int col = (lane + 64 * j) * 4;
                    const f32x4 o = v[j] * rstd2 * c2[j] + s2[j];
                    pg8::u32x2 pk; pk.x = pk2(o.x, o.y); pk.y = pk2(o.z, o.w);
                    __builtin_amdgcn_raw_buffer_store_b64(pk, wt_h, col * 2, (int)((unsigned)m * (DM * 2u)), WT_AUX); }
            } }
        return;
    }
    for (int m = gw; m < M; m += NGW) {
        const uint2* yr = (const uint2*)(Y + (size_t)m * DM) + lane;
        const f32x4* xr = (const f32x4*)((const float*)xin_ + (size_t)m * DM) + lane;
        const uint2* xb = (const uint2*)((const bf16*)xin_ + (size_t)m * DM) + lane;
        f32x4 v[8]; float ss = 0.f;
#pragma unroll
        for (int j = 0; j < 8; ++j) { const unsigned long long yq_ = __builtin_nontemporal_load((const unsigned long long*)(yr + 64 * j)); uint2 yw; yw.x = (unsigned)yq_; yw.y = (unsigned)(yq_ >> 32); v[j] = (f32x4){bflo(yw.x), bfhi(yw.x), bflo(yw.y), bfhi(yw.y)}; ss += (v[j].x * v[j].x + v[j].y * v[j].y) + (v[j].z * v[j].z + v[j].w * v[j].w); }
        const float rstd = rsqrtf(wave_sum(ss) * (1.0f / DM) + EPS);
        const float* mb = mod + (size_t)(m >> 11) * NMOD;
        float ss2 = 0.f;
#pragma unroll
        for (int j = 0; j < 8; ++j) { const int col = (lane + 64 * j) * 4;
            const f32x4 w = *(const f32x4*)(wpost + col), g = *(const f32x4*)(mb + off_g + col);
            f32x4 xv;
            if constexpr (NEXT) xv = __builtin_nontemporal_load(xr + 64 * j);
            else { const unsigned long long xq_ = __builtin_nontemporal_load((const unsigned long long*)(xb + 64 * j)); const unsigned x0 = (unsigned)xq_, x1 = (unsigned)(xq_ >> 32); xv = (f32x4){bflo(x0), bfhi(x0), bflo(x1), bfhi(x1)}; }
            const f32x4 o = xv + g * (v[j] * rstd * w);
            v[j] = o; ss2 += (o.x * o.x + o.y * o.y) + (o.z * o.z + o.w * o.w);
            if constexpr (NEXT) { uint2 pk; pk.x = pk2(o.x, o.y); pk.y = pk2(o.z, o.w); *(uint2*)((bf16*)xout_ + (size_t)m * DM + col) = pk; }
            else *(f32x4*)((float*)xout_ + (size_t)m * DM + col) = o; }
        if (NEXT) {
            const float rstd2 = rsqrtf(wave_sum(ss2) * (1.0f / DM) + EPS);
#pragma unroll
            for (int j = 0; j < 8; ++j) { const int col = (lane + 64 * j) * 4;
                const f32x4 w = *(const f32x4*)(wn2 + col), sh = *(const f32x4*)(mb + off_sh + col), sc = *(const f32x4*)(mb + off_sc + col);
                const f32x4 o = v[j] * rstd2 * w * (sc + 1.0f) + sh;
                uint2 pk; pk.x = pk2(o.x, o.y); pk.y = pk2(o.z, o.w);
                *(uint2*)(Hn + (size_t)m * DM + col) = pk; }
        }
    }
}
__device__ __forceinline__ void fixup_phase(const bf16* E, bf16* Gb, const float* cw, const float* cb, int tid, int G, int bid) {
    constexpr int NPN = FF / 128;
    const int nit = 256 * NPN * 16, per = (nit + G - 1) / G, lo = bid * per, hi_ = (lo + per < nit) ? lo + per : nit;
    for (int idx = lo + tid; idx < hi_; idx += NTHREADS) {
        const int g = idx / (NPN * 16), rem = idx % (NPN * 16), pn = rem >> 4, fl = (rem & 15) * 8;
        if ((g & 31) == 0) continue;
        const bf16* ea = E + ((size_t)(pn * 256 + g - 1) * 4 + 2) * 256 + fl; const bf16* ec = E + ((size_t)(pn * 256 + g) * 4) * 256 + fl;
        const v4u ga = *(const v4u*)ea, gbv = *(const v4u*)(ea + 256), gc = *(const v4u*)ec, gd = *(const v4u*)(ec + 256);
        const v4u va = *(const v4u*)(ea + 128), vbv = *(const v4u*)(ea + 256 + 128), vc = *(const v4u*)(ec + 128), vd = *(const v4u*)(ec + 256 + 128);
        const int f8 = pn * 128 + fl;
        f32x4 pw[8][2];
#pragma unroll
        for (int hq = 0; hq < 2; ++hq) { const int fo = f8 + 4 * hq;
            pw[0][hq] = *(const f32x4*)(cw + fo); pw[1][hq] = *(const f32x4*)(cw + FF2 + fo); pw[2][hq] = *(const f32x4*)(cw + 2 * FF2 + fo); pw[3][hq] = *(const f32x4*)(cb + fo);
            pw[4][hq] = *(const f32x4*)(cw + FF + fo); pw[5][hq] = *(const f32x4*)(cw + FF2 + FF + fo); pw[6][hq] = *(const f32x4*)(cw + 2 * FF2 + FF + fo); pw[7][hq] = *(const f32x4*)(cb + FF + fo); }
        unsigned o0[4], o1[4];
#pragma unroll
        for (int q = 0; q < 4; ++q) {
            float r0[2], r1[2];
#pragma unroll
            for (int hh = 0; hh < 2; ++hh) { const int e = 2 * q + hh, eh = e >> 2, ec4 = e & 3;
                const float a = hh ? bfhi(ga[q]) : bflo(ga[q]), b = hh ? bfhi(gbv[q]) : bflo(gbv[q]), c = hh ? bfhi(gc[q]) : bflo(gc[q]), d = hh ? bfhi(gd[q]) : bflo(gd[q]);
                const float xa = hh ? bfhi(va[q]) : bflo(va[q]), xb = hh ? bfhi(vbv[q]) : bflo(vbv[q]), xc = hh ? bfhi(vc[q]) : bflo(vc[q]), xd = hh ? bfhi(vd[q]) : bflo(vd[q]);
                const float w0 = pw[0][eh][ec4], w1 = pw[1][eh][ec4], w2 = pw[2][eh][ec4], wb = pw[3][eh][ec4], y0 = pw[4][eh][ec4], y1 = pw[5][eh][ec4], y2 = pw[6][eh][ec4], yb = pw[7][eh][ec4];
                r0[hh] = pg8::EpiConv::gelu(wb + w0 * a + w1 * b + w2 * c) * (yb + y0 * xa + y1 * xb + y2 * xc);
                r1[hh] = pg8::EpiConv::gelu(wb + w0 * b + w1 * c + w2 * d) * (yb + y0 * xb + y1 * xc + y2 * xd); }
            o0[q] = pk2(r0[0], r0[1]); o1[q] = pk2(r1[0], r1[1]); }
        const v4u w0 = {o0[0], o0[1], o0[2], o0[3]}, w1 = {o1[0], o1[1], o1[2], o1[3]};
        *(v4u*)(Gb + (size_t)(64 * g - 1) * FF + pn * 128 + fl) = w0; *(v4u*)(Gb + (size_t)(64 * g) * FF + pn * 128 + fl) = w1;
    }
}


namespace att {
typedef short bf16x8 __attribute__((ext_vector_type(8)));
typedef short s16x4 __attribute__((ext_vector_type(4)));
typedef float f32x16 __attribute__((ext_vector_type(16)));
typedef unsigned u32x4 __attribute__((ext_vector_type(4)));
typedef LAS char* lptr;
#define KSWZ(row, colB) ((row) * 256 + ((colB) ^ (((row) & 7) << 4)))
#define KRSWZ(row, colB) ((row) * 128 + ((colB) ^ ((((row) >> 1) & 7) << 4)))
#define SBAR() __builtin_amdgcn_sched_barrier(0)
constexpr int QBLK = 32, KVBLK = 64, SHM_V = KVBLK * 128 * 2, SHM_K = KVBLK * 128 * 2, SHM_KR = KVBLK * 64 * 2;
constexpr float LOG2E = 1.4426950408889634f;
constexpr float THRL = 8.0f * LOG2E;
__device__ __forceinline__ int crow(int r, int hi) { return (r & 3) + 8 * (r >> 2) + 4 * hi; }
__device__ __forceinline__ unsigned cvtpk(float lo, float hi) { unsigned r; asm volatile("v_cvt_pk_bf16_f32 %0, %1, %2" : "=v"(r) : "v"(lo), "v"(hi)); return r; }
__device__ __forceinline__ bf16x8 ld8(const bf16* p) { return *reinterpret_cast<const bf16x8*>(p); }

template <bool EXPALL = false>
__device__ __forceinline__ void partialSM(f32x16& p0, f32x16& p1, float C, float bl, float& m_reg, float& alpha) {
    float pmax = p0[0];
#pragma unroll
    for (int r = 1; r < 16; ++r) pmax = fmaxf(pmax, p0[r]);
#pragma unroll
    for (int r = 0; r < 16; ++r) pmax = fmaxf(pmax, p1[r]);
    { auto rr = __builtin_amdgcn_permlane32_swap(__float_as_uint(pmax), __float_as_uint(pmax), false, false);
      pmax = fmaxf(__uint_as_float(rr[0]), __uint_as_float(rr[1])); }
    const float tmax = fmaf(pmax, C, bl);
    float mn;
    if (__builtin_expect(__all(tmax - m_reg <= THRL), 1)) { mn = m_reg; alpha = 1.f; }
    else { mn = fmaxf(m_reg, tmax); alpha = __builtin_amdgcn_exp2f(m_reg - mn); m_reg = mn; }
    const float off = bl - mn;
#pragma unroll
    for (int r = 0; r < 16; ++r) p0[r] = fmaf(p0[r], C, off);
#pragma unroll
    for (int r = 0; r < 16; ++r) p1[r] = fmaf(p1[r], C, off);
#pragma unroll
    for (int r = 0; r < 16; ++r) p0[r] = __builtin_amdgcn_exp2f(p0[r]);
    if (EXPALL) {
#pragma unroll
        for (int r = 0; r < 16; ++r) p1[r] = __builtin_amdgcn_exp2f(p1[r]); }
}
__device__ __forceinline__ void lut_adjust(f32x16& p0, f32x16& p1, const LAS float* lutx, const LAS int* kp, int qp, int hi) {
#pragma unroll
    for (int r = 0; r < 16; ++r) { const int key = crow(r, hi);
        int d0 = kp[key] - qp, d1 = kp[key + 32] - qp;
        d0 = d0 < -128 ? -128 : (d0 > 128 ? 128 : d0); d1 = d1 < -128 ? -128 : (d1 > 128 ? 128 : d1);
        p0[r] += lutx[d0 + 256]; p1[r] += lutx[d1 + 256]; }
}
__device__ __forceinline__ void lut_adjust_fast(f32x16& p0, f32x16& p1, const LAS float* lutx, int kp0, int qp, int hi) {
    const LAS float* bp = lutx + (kp0 - qp + 256 + 4 * hi);
#pragma unroll
    for (int r = 0; r < 16; ++r) { const int off = (r & 3) + 8 * (r >> 2); p0[r] += bp[off]; p1[r] += bp[off + 32]; }
}
template <bool EXPDONE = false>
__device__ __forceinline__ void finishSM(f32x16& p0, f32x16& p1, float alpha, float& l_reg, bf16x8& pa0, bf16x8& pa1, bf16x8& pa2, bf16x8& pa3) {
    if (!EXPDONE) {
#pragma unroll
        for (int r = 0; r < 16; ++r) p1[r] = __builtin_amdgcn_exp2f(p1[r]); }
    float ps = 0;
#pragma unroll
    for (int r = 0; r < 16; ++r) ps += p0[r];
#pragma unroll
    for (int r = 0; r < 16; ++r) ps += p1[r];
    { auto rr = __builtin_amdgcn_permlane32_swap(__float_as_uint(ps), __float_as_uint(ps), false, false);
      ps = __uint_as_float(rr[0]) + __uint_as_float(rr[1]); }
    l_reg = l_reg * alpha + ps;
#define PK4(P, BASE, OUT) do { u32x4 w = {cvtpk(P[BASE + 0], P[BASE + 1]), cvtpk(P[BASE + 2], P[BASE + 3]), cvtpk(P[BASE + 4], P[BASE + 5]), cvtpk(P[BASE + 6], P[BASE + 7])}; \
    OUT = *reinterpret_cast<bf16x8*>(&w); } while (0)
    PK4(p0, 0, pa0); PK4(p0, 8, pa1); PK4(p1, 0, pa2); PK4(p1, 8, pa3);
#undef PK4
}
__device__ __forceinline__ int v_st(int k, int c) { const int kk = (k & ~0xC) | ((k & 4) << 1) | ((k & 8) >> 1); return ((kk >> 3) * 4 + (c >> 5)) * 512 + ((kk & 7) * 32 + (c & 31)) * 2; }
__device__ __forceinline__ int v_rd_base(int lane) { return ((lane & 3) << 3) | (((lane >> 2) & 3) << 6) | (((lane >> 4) & 1) << 5) | (((lane >> 5) & 1) << 8); }
constexpr int v_rd_off(int d0, int ks, int half) { return d0 * 512 + ks * 4096 + half * 2048; }
template <int OFF> __device__ __forceinline__ s16x4 tr_read(int vb) {
    s16x4 r; asm volatile("ds_read_b64_tr_b16 %0, %1 offset:%2" : "=&v"(r) : "v"(vb), "i"(OFF) : "memory"); return r;
}
template <int D0, bool PRIO = true> __device__ __forceinline__ void pv_one(f32x16& od, int vb, bf16x8 pa0, bf16x8 pa1, bf16x8 pa2, bf16x8 pa3) {
    const s16x4 l0 = tr_read<v_rd_off(D0, 0, 0)>(vb), h0 = tr_read<v_rd_off(D0, 0, 1)>(vb), l1 = tr_read<v_rd_off(D0, 1, 0)>(vb), h1 = tr_read<v_rd_off(D0, 1, 1)>(vb);
    const s16x4 l2 = tr_read<v_rd_off(D0, 2, 0)>(vb), h2 = tr_read<v_rd_off(D0, 2, 1)>(vb), l3 = tr_read<v_rd_off(D0, 3, 0)>(vb), h3 = tr_read<v_rd_off(D0, 3, 1)>(vb);
    asm volatile("s_waitcnt lgkmcnt(0)" ::: "memory"); SBAR();
    if (PRIO) __builtin_amdgcn_s_setprio(1);
#define PK(L, H) (bf16x8){L[0], L[1], L[2], L[3], H[0], H[1], H[2], H[3]}
    od = __builtin_amdgcn_mfma_f32_32x32x16_bf16(pa0, PK(l0, h0), od, 0, 0, 0);
    od = __builtin_amdgcn_mfma_f32_32x32x16_bf16(pa1, PK(l1, h1), od, 0, 0, 0);
    od = __builtin_amdgcn_mfma_f32_32x32x16_bf16(pa2, PK(l2, h2), od, 0, 0, 0);
    od = __builtin_amdgcn_mfma_f32_32x32x16_bf16(pa3, PK(l3, h3), od, 0, 0, 0);
    if (PRIO) __builtin_amdgcn_s_setprio(0);
#undef PK
}
template <bool PRIO = true> __device__ __forceinline__ void pv_d0(f32x16* o, int vb, bf16x8 pa0, bf16x8 pa1, bf16x8 pa2, bf16x8 pa3) {
    pv_one<0, PRIO>(o[0], vb, pa0, pa1, pa2, pa3); pv_one<1, PRIO>(o[1], vb, pa0, pa1, pa2, pa3); pv_one<2, PRIO>(o[2], vb, pa0, pa1, pa2, pa3); pv_one<3, PRIO>(o[3], vb, pa0, pa1, pa2, pa3);
}
#ifndef DF_PRIO
#define DF_PRIO false
#endif
#ifndef ML_PRIO
#define ML_PRIO true
#endif
#ifndef MLA_PF
#define MLA_PF 4
#endif
struct KAddr { int kb[4]; int krb[4]; };
__device__ __forceinline__ KAddr make_kaddr(int r32, int hi) {
    KAddr a; const int y = (hi * 16) ^ ((r32 & 7) << 4), y2 = (hi * 16) ^ (((r32 >> 1) & 7) << 4);
#pragma unroll
    for (int j = 0; j < 4; ++j) { a.kb[j] = r32 * 256 + ((j * 32) ^ y); a.krb[j] = r32 * 128 + ((j * 32) ^ y2); }
    return a;
}
template <int ND0, int NR, bool PRIO = true>
__device__ __forceinline__ void qkt(f32x16& p0, f32x16& p1, lptr Ks, lptr KRs, lptr QRs, const bf16x8* qr, int d0b, const KAddr& ka, const f32x16& cinit) {
    if (PRIO) __builtin_amdgcn_s_setprio(1);
#pragma unroll
    for (int d0 = 0; d0 < ND0; ++d0) {
        const bf16x8 b0 = *reinterpret_cast<const LAS bf16x8*>(Ks + ka.kb[d0 & 3] + ((d0b + d0) >> 2) * 128);
        const bf16x8 b1 = *reinterpret_cast<const LAS bf16x8*>(Ks + ka.kb[d0 & 3] + ((d0b + d0) >> 2) * 128 + 32 * 256);
        if (d0 == 0) { p0 = __builtin_amdgcn_mfma_f32_32x32x16_bf16(b0, qr[d0], cinit, 0, 0, 0); p1 = __builtin_amdgcn_mfma_f32_32x32x16_bf16(b1, qr[d0], cinit, 0, 0, 0); }
        else { p0 = __builtin_amdgcn_mfma_f32_32x32x16_bf16(b0, qr[d0], p0, 0, 0, 0); p1 = __builtin_amdgcn_mfma_f32_32x32x16_bf16(b1, qr[d0], p1, 0, 0, 0); } }
#pragma unroll
    for (int d0 = 0; d0 < NR; ++d0) {
        const bf16x8 b0 = *reinterpret_cast<const LAS bf16x8*>(KRs + ka.krb[d0]);
        const bf16x8 b1 = *reinterpret_cast<const LAS bf16x8*>(KRs + ka.krb[d0] + 32 * 128);
        p0 = __builtin_amdgcn_mfma_f32_32x32x16_bf16(b0, qr[ND0 + d0], p0, 0, 0, 0);
        p1 = __builtin_amdgcn_mfma_f32_32x32x16_bf16(b1, qr[ND0 + d0], p1, 0, 0, 0); }
    if (PRIO) __builtin_amdgcn_s_setprio(0);
}
template <int ND0, bool PRIO, int PF>
__device__ __forceinline__ void qktp(f32x16& p0, f32x16& p1, lptr Ks, const bf16x8* qr, int d0b, const KAddr& ka, const f32x16& cinit) {
    constexpr int NS = 2 * ND0;
    bf16x8 kf[PF];
#define QKT_LD(S_) (*reinterpret_cast<const LAS bf16x8*>(Ks + ka.kb[((S_) >> 1) & 3] + ((d0b + ((S_) >> 1)) >> 2) * 128 + ((S_) & 1) * 32 * 256))
#pragma unroll
    for (int s_ = 0; s_ < PF; ++s_) kf[s_] = QKT_LD(s_);
    SBAR();
    if (PRIO) __builtin_amdgcn_s_setprio(1);
#pragma unroll
    for (int s_ = 0; s_ < NS; ++s_) { const int d = s_ >> 1;
        if (s_ & 1) p1 = __builtin_amdgcn_mfma_f32_32x32x16_bf16(kf[s_ % PF], qr[d], d == 0 ? cinit : p1, 0, 0, 0);
        else        p0 = __builtin_amdgcn_mfma_f32_32x32x16_bf16(kf[s_ % PF], qr[d], d == 0 ? cinit : p0, 0, 0, 0);
        if (s_ + PF < NS) kf[s_ % PF] = QKT_LD(s_ + PF);
        SBAR(); }
    if (PRIO) __builtin_amdgcn_s_setprio(0);
#undef QKT_LD
}
template <bool PRIO, int PF>
__device__ __forceinline__ void qktp_mla(f32x16& p0, f32x16& p1, lptr Ks, lptr KRs, const bf16x8* qr, const KAddr& ka, const f32x16& cinit) {
    constexpr int ND0 = 8, NR = 4, NS = 2 * (ND0 + NR);
    bf16x8 kf[PF];
#define QKT_LD(S_) ((((S_) >> 1) < ND0) ? *reinterpret_cast<const LAS bf16x8*>(Ks + ka.kb[((S_) >> 1) & 3] + (((S_) >> 1) >> 2) * 128 + ((S_) & 1) * 32 * 256) \
                                       : *reinterpret_cast<const LAS bf16x8*>(KRs + ka.krb[(((S_) >> 1) - ND0) & 3] + ((S_) & 1) * 32 * 128))
#pragma unroll
    for (int s_ = 0; s_ < PF; ++s_) kf[s_] = QKT_LD(s_);
    SBAR();
    if (PRIO) __builtin_amdgcn_s_setprio(1);
#pragma unroll
    for (int s_ = 0; s_ < NS; ++s_) { const int d = s_ >> 1;
        if (s_ & 1) p1 = __builtin_amdgcn_mfma_f32_32x32x16_bf16(kf[s_ % PF], qr[d], d == 0 ? cinit : p1, 0, 0, 0);
        else        p0 = __builtin_amdgcn_mfma_f32_32x32x16_bf16(kf[s_ % PF], qr[d], d == 0 ? cinit : p0, 0, 0, 0);
        if (s_ + PF < NS) kf[s_ % PF] = QKT_LD(s_ + PF);
        SBAR(); }
    if (PRIO) __builtin_amdgcn_s_setprio(0);
#undef QKT_LD
}
template <bool EXPALL, bool FIRST>
__device__ __forceinline__ void partialSMn(f32x16& p0, f32x16& p1, float& m_reg, float& alpha) {
    float pmax = p0[0];
#pragma unroll
    for (int r = 1; r < 16; ++r) pmax = fmaxf(pmax, p0[r]);
#pragma unroll
    for (int r = 0; r < 16; ++r) pmax = fmaxf(pmax, p1[r]);
    { auto rr = __builtin_amdgcn_permlane32_swap(__float_as_uint(pmax), __float_as_uint(pmax), false, false);
      pmax = fmaxf(__uint_as_float(rr[0]), __uint_as_float(rr[1])); }
    alpha = 1.f;
    if (FIRST) { m_reg = pmax; alpha = 0.f;
#pragma unroll
        for (int r = 0; r < 16; ++r) { p0[r] -= pmax; p1[r] -= pmax; } }
    else if (__builtin_expect(!__all(pmax <= THRL), 0)) { const float delta = fmaxf(pmax, 0.f); m_reg += delta; alpha = __builtin_amdgcn_exp2f(-delta);
#pragma unroll
        for (int r = 0; r < 16; ++r) { p0[r] -= delta; p1[r] -= delta; } }
#pragma unroll
    for (int r = 0; r < 16; ++r) p0[r] = __builtin_amdgcn_exp2f(p0[r]);
    if (EXPALL) {
#pragma unroll
        for (int r = 0; r < 16; ++r) p1[r] = __builtin_amdgcn_exp2f(p1[r]); }
}
__device__ __forceinline__ bf16x8 scale_frag(bf16x8 q, float c) {
    const u32x4 w = __builtin_bit_cast(u32x4, q); u32x4 o;
#pragma unroll
    for (int i = 0; i < 4; ++i) o[i] = cvtpk(__uint_as_float(w[i] << 16) * c, __uint_as_float(w[i] & 0xffff0000u) * c);
    return __builtin_bit_cast(bf16x8, o);
}
#define SETNEG(BL) do { const float nv_ = (BL) - m_reg; if (__any(nv_ != negv)) { negv = nv_; _Pragma("unroll") for (int r = 0; r < 16; ++r) negm[r] = nv_; asm volatile("" : "+v"(negm)); } } while (0)

__device__ __forceinline__ void glds16(const bf16* g, lptr l) { __builtin_amdgcn_global_load_lds((const unsigned*)g, (LAS unsigned*)l, 16, 0, 0); }
__device__ __forceinline__ void blds16(__amdgpu_buffer_rsrc_t r, int voff, int soff, lptr l) { __builtin_amdgcn_raw_ptr_buffer_load_lds(r, (LAS void*)l, 16, voff, soff, 0, 0); }
#define WAITV(n) asm volatile("s_waitcnt vmcnt(" #n ")" ::: "memory")
#define ABAR() do { asm volatile("s_waitcnt lgkmcnt(0)" ::: "memory"); __builtin_amdgcn_s_barrier(); asm volatile("" ::: "memory"); } while (0)
__device__ __forceinline__ long ksrc_off(int p, int lane, int stride) { const int row = 4 * p + (lane >> 4), c = (lane & 15) ^ (row & 7); return (long)row * stride + c * 8; }
__device__ __forceinline__ long krsrc_off(int p, int lane, int stride) { const int row = 8 * p + (lane >> 3), c = (lane & 7) ^ ((row >> 1) & 7); return (long)row * stride + c * 8; }
__device__ __forceinline__ long vsrc_off(int p, int lane, int stride) { const int st = 2 * p + (lane >> 5), kk = (st >> 2) * 8 + ((lane & 31) >> 2);
    const int k = kk, col = (st & 3) * 32 + (lane & 3) * 8; return (long)k * stride + col; }
#define RESC(a) do { if (__any((a) < 1.f)) { if (hi == 0) al_l[r32] = (a); asm volatile("s_waitcnt lgkmcnt(0)" ::: "memory"); \
    _Pragma("unroll") for (int d = 0; d < 4; ++d) _Pragma("unroll") for (int r = 0; r < 16; ++r) o[d][r] *= al_l[crow(r, hi)]; } } while (0)

constexpr int ML_SLOT = SHM_K + SHM_V + SHM_KR, ML_NS = 3, ML_WS = ML_NS * ML_SLOT, MLA_LDS = ML_WS + 8 * 64 * 4;
__device__ __forceinline__ void mla_unit(const bf16* __restrict__ Qb, const bf16* __restrict__ KNh, const bf16* __restrict__ KRb, bf16* __restrict__ Ob, lptr lds, int tid) {
    constexpr float C = MLA_SCALE * LOG2E;
    const int wid = __builtin_amdgcn_readfirstlane(tid >> 6), lane = tid & 63, r32 = lane & 31, hi = lane >> 5;
    LAS float* ws = (LAS float*)(lds + ML_WS) + wid * 64; LAS float* li_l = ws; LAS float* al_l = ws + 32;
    float m_reg = 0.f, l_reg = 0; f32x16 o[4] = {}; bf16x8 qr[12]; f32x16 negm = {}; float negv = 0.f;
    const bf16* Qw = Qb + (long)(wid * QBLK + r32) * QW + hi * 8;
#pragma unroll
    for (int d0 = 0; d0 < 12; ++d0) qr[d0] = ld8(Qw + d0 * 16);
    const KAddr ka = make_kaddr(r32, hi);
    const bf16* Vh = KNh + 128;
    const int vb0 = (int)(unsigned)(uintptr_t)lds + SHM_K + v_rd_base(lane);
    const long ko0 = ksrc_off(2 * wid, lane, KVW), ko1 = ksrc_off(2 * wid + 1, lane, KVW), vo0 = vsrc_off(2 * wid, lane, KVW), vo1 = vsrc_off(2 * wid + 1, lane, KVW), ro0 = krsrc_off(wid, lane, INWP);
    lptr dK = lds + wid * 2048, dV = lds + SHM_K + wid * 2048, dR = lds + SHM_K + SHM_V + wid * 1024;
    const __amdgpu_buffer_rsrc_t rs_kv = __builtin_amdgcn_make_buffer_rsrc((void*)KNh, 0, -1, 0x00020000), rs_kr = __builtin_amdgcn_make_buffer_rsrc((void*)KRb, 0, -1, 0x00020000);
    const int bko0 = (int)ko0 * 2, bko1 = (int)ko1 * 2, bvo0 = ((int)vo0 + 128) * 2, bvo1 = ((int)vo1 + 128) * 2, bro0 = (int)ro0 * 2;
#define DMA(t, so) do { const int ks_ = (t) * (KVBLK * KVW * 2), rs_ = (t) * (KVBLK * INWP * 2); \
    blds16(rs_kv, bko0, ks_, dK + (so)); blds16(rs_kv, bko1, ks_, dK + (so) + 1024); blds16(rs_kv, bvo0, ks_, dV + (so)); blds16(rs_kv, bvo1, ks_, dV + (so) + 1024); blds16(rs_kr, bro0, rs_, dR + (so)); } while (0)
#define ROT3() do { const int t_ = sp; sp = sc; sc = sn; sn = t_; } while (0)
    f32x16 pA0, pA1, pB0, pB1; float alA, alB; bf16x8 pa0, pa1, pa2, pa3; constexpr int NT = SEQ / KVBLK;
    int sp = 0, sc = 0, sn = ML_SLOT;
    DMA(0, 0); DMA(1, ML_SLOT); WAITV(5); ABAR();
    qktp_mla<ML_PRIO, MLA_PF>(pA0, pA1, lds, lds + SHM_K + SHM_V, qr, ka, negm); partialSMn<false, true>(pA0, pA1, m_reg, alA);
    WAITV(0); ABAR();
    sp = 0; sc = ML_SLOT; sn = 2 * ML_SLOT;
    for (int j = 1; j + 1 < NT; j += 2) {
        DMA(j + 1, sn);
        SETNEG(0.f); SBAR(); qktp_mla<ML_PRIO, MLA_PF>(pB0, pB1, lds + sc, lds + sc + SHM_K + SHM_V, qr, ka, negm);
        finishSM(pA0, pA1, alA, l_reg, pa0, pa1, pa2, pa3); SBAR();
        pv_d0<ML_PRIO>(o, vb0 + sp, pa0, pa1, pa2, pa3); partialSMn<false, false>(pB0, pB1, m_reg, alB);
        WAITV(0); ABAR(); RESC(alB); ROT3();
        if (j + 2 < NT) DMA(j + 2, sn);
        SETNEG(0.f); SBAR(); qktp_mla<ML_PRIO, MLA_PF>(pA0, pA1, lds + sc, lds + sc + SHM_K + SHM_V, qr, ka, negm);
        finishSM(pB0, pB1, alB, l_reg, pa0, pa1, pa2, pa3); SBAR();
        pv_d0<ML_PRIO>(o, vb0 + sp, pa0, pa1, pa2, pa3); partialSMn<false, false>(pA0, pA1, m_reg, alA);
        WAITV(0); ABAR(); RESC(alA); ROT3();
    }
    SETNEG(0.f); SBAR(); qktp_mla<ML_PRIO, MLA_PF>(pB0, pB1, lds + sc, lds + sc + SHM_K + SHM_V, qr, ka, negm);
    finishSM(pA0, pA1, alA, l_reg, pa0, pa1, pa2, pa3); SBAR();
    pv_d0<ML_PRIO>(o, vb0 + sp, pa0, pa1, pa2, pa3); partialSMn<false, false>(pB0, pB1, m_reg, alB);
    RESC(alB);
    finishSM(pB0, pB1, alB, l_reg, pa0, pa1, pa2, pa3); SBAR();
    pv_d0<ML_PRIO>(o, vb0 + sc, pa0, pa1, pa2, pa3);
    if (hi == 0) li_l[r32] = l_reg; asm volatile("s_waitcnt lgkmcnt(0)" ::: "memory");
    float rli[16];
#pragma unroll
    for (int r = 0; r < 16; ++r) rli[r] = __builtin_amdgcn_rcpf(li_l[crow(r, hi)]);
    bf16* Ow = Ob + (long)(wid * QBLK) * DM;
#pragma unroll
    for (int r = 0; r < 16; ++r) { const int orow = crow(r, hi);
#pragma unroll
        for (int d0 = 0; d0 < 4; d0 += 2) { const unsigned pk_ = cvtpk(o[d0][r] * rli[r], o[d0 + 1][r] * rli[r]);
            Ow[(long)orow * DM + d0 * 32 + r32] = (bf16)(pk_ & 0xffffu); Ow[(long)orow * DM + (d0 + 1) * 32 + r32] = (bf16)(pk_ >> 16); } }
    ABAR();
#undef DMA
#undef ROT3
}

typedef float cv_f32x2 __attribute__((ext_vector_type(2)));
typedef __bf16 cv_bf16x2 __attribute__((ext_vector_type(2)));
__device__ __forceinline__ unsigned cv_pk(float lo, float hi) { const cv_f32x2 v = {lo, hi}; const cv_bf16x2 r = __builtin_convertvector(v, cv_bf16x2); return __builtin_bit_cast(unsigned, r); }
struct CvStream { bool on; const float* src; unsigned char* dst; unsigned sN4  , K2  , so_src, so_dst; int nsteps  ; };
constexpr int DF_SLOT = SHM_K + SHM_V, DF_NS = 4, DF_WS = DF_NS * DF_SLOT, DF_LUT = DF_WS + 8 * 64 * 4, DF_TK = DF_LUT + 512 * 4, DF_KPOS = DF_TK + 96 * 4, DF_LDS = DF_KPOS + SEQ * 4;
__device__ __forceinline__ void diff_unit(const bf16* __restrict__ Qb  , const bf16* __restrict__ Kh  ,
                                          const bf16* __restrict__ Vh  , const int* __restrict__ qposp  ,
                                          const int* __restrict__ kposp  , const int* __restrict__ tk  , const int* __restrict__ tkf  ,
                                          const float* __restrict__ relb_h  , const float* __restrict__ subln, float lam, bf16* __restrict__ Ob  , lptr lds, int tid, const CvStream cv) {
    constexpr float C = DIFF_SCALE * LOG2E;
    const int wid = __builtin_amdgcn_readfirstlane(tid >> 6), lane = tid & 63, r32 = lane & 31, hi = lane >> 5;
    const int comp = wid >> 2, wq = wid & 3;
    LAS float* ws = (LAS float*)(lds + DF_WS) + wid * 64; LAS float* li_l = ws; LAS float* al_l = ws + 32;
    LAS int* kpos_l = (LAS int*)(lds + DF_KPOS); LAS float* lut = (LAS float*)(lds + DF_LUT); LAS int* tkl = (LAS int*)(lds + DF_TK);
    const long ko0 = ksrc_off(2 * wid, lane, INWP), ko1 = ksrc_off(2 * wid + 1, lane, INWP), vo0 = vsrc_off(2 * wid, lane, INWP), vo1 = vsrc_off(2 * wid + 1, lane, INWP);
    lptr dK = lds + wid * 2048, dV = lds + SHM_K + wid * 2048;
    const __amdgpu_buffer_rsrc_t rs_k = __builtin_amdgcn_make_buffer_rsrc((void*)Kh, 0, -1, 0x00020000);
    const int dvk = (int)(Vh - Kh);
    const int bko0 = (int)ko0 * 2, bko1 = (int)ko1 * 2, bvo0 = ((int)vo0 + dvk) * 2, bvo1 = ((int)vo1 + dvk) * 2;
#define DMA(t, so) do { const int ks_ = (t) * (KVBLK * INWP * 2); \
    blds16(rs_k, bko0, ks_, dK + (so)); blds16(rs_k, bko1, ks_, dK + (so) + 1024); blds16(rs_k, bvo0, ks_, dV + (so)); blds16(rs_k, bvo1, ks_, dV + (so) + 1024); } while (0)
    DMA(0, 0); DMA(1, DF_SLOT);
    const bool cv_on = cv.on;
    const __amdgpu_buffer_rsrc_t cv_rs = __builtin_amdgcn_make_buffer_rsrc((void*)cv.src, 0, -1, 0x00020000), cv_rd = __builtin_amdgcn_make_buffer_rsrc((void*)cv.dst, 0, -1, 0x00020000);
    unsigned cv_ss = cv.so_src, cv_sd = cv.so_dst; const unsigned cv_n4 = cv.sN4;
    const int cv_vs = (lane >> 4) * 4 * (int)cv.sN4 + (lane & 15) * 16, cv_vd = (lane & 15) * 4 * (int)cv.K2 + (lane >> 4) * 8; int cv_left = cv.nsteps;
    u32x4 cv0 = {}, cv1 = {}, cv2 = {}, cv3 = {};
#define CV_LOAD() do { if (cv_on && cv_left > 0) { cv0 = __builtin_amdgcn_raw_buffer_load_b128(cv_rs, cv_vs, cv_ss, 2); cv1 = __builtin_amdgcn_raw_buffer_load_b128(cv_rs, cv_vs, cv_ss + cv_n4, 2); \
      cv2 = __builtin_amdgcn_raw_buffer_load_b128(cv_rs, cv_vs, cv_ss + 2 * cv_n4, 2); cv3 = __builtin_amdgcn_raw_buffer_load_b128(cv_rs, cv_vs, cv_ss + 3 * cv_n4, 2); cv_ss += 16 * cv_n4; } } while (0)
#define CV_ST1(J_, C_) do { pg8::u32x2 o_; o_.x = cv_pk(cvf0_.C_, cvf1_.C_); o_.y = cv_pk(cvf2_.C_, cvf3_.C_); \
      __builtin_amdgcn_raw_buffer_store_b64(o_, cv_rd, cv_vd, cv_sd + (J_) * cv.K2, 0); } while (0)
#define CV_STORE() do { if (cv_on && cv_left > 0) {   \
      const f32x4 cvf0_ = __builtin_bit_cast(f32x4, cv0), cvf1_ = __builtin_bit_cast(f32x4, cv1), cvf2_ = __builtin_bit_cast(f32x4, cv2), cvf3_ = __builtin_bit_cast(f32x4, cv3); \
      CV_ST1(0, x); CV_ST1(1, y); CV_ST1(2, z); CV_ST1(3, w); cv_sd += 32; --cv_left; } } while (0)
    const int ld_ = tid - 256;
    const float lutv = relb_h[t5_bucket(ld_ < -128 ? -128 : (ld_ > 128 ? 128 : ld_)) * 8] * LOG2E;
    const int tkv = (tid >= 448) ? tk[tid - 448] : ((tid >= 416) ? tkf[tid - 416] : 0);
    const u32x4 kp4 = *(const u32x4*)(kposp + tid * 4);
    const int qp = qposp[wq * QBLK + r32];
    float m_reg = 0.f, l_reg = 0; f32x16 o[4] = {}; bf16x8 qr[4]; f32x16 negm = {}; float negv = 0.f;
    const bf16* Qw = Qb + (long)(wq * QBLK + r32) * INWP + comp * 64 + hi * 8;
#pragma unroll
    for (int d0 = 0; d0 < 4; ++d0) qr[d0] = ld8(Qw + d0 * 16);
    lut[tid] = lutv;
    if (tid >= 448) tkl[tid - 448] = tkv; else if (tid >= 416) tkl[64 + tid - 416] = tkv;
    *(LAS u32x4*)(kpos_l + tid * 4) = kp4;
    int qmn = qp, qmx = qp;
#pragma unroll
    for (int of = 1; of < 32; of <<= 1) { qmn = min(qmn, __shfl_xor(qmn, of)); qmx = max(qmx, __shfl_xor(qmx, of)); }
    qmn = __builtin_amdgcn_readfirstlane(qmn); qmx = __builtin_amdgcn_readfirstlane(qmx);
    const bool qnarrow = (qmx - qmn < 32);
#pragma unroll
    for (int d0 = 0; d0 < 4; ++d0) qr[d0] = scale_frag(qr[d0], C);
    const KAddr ka = make_kaddr(r32, hi);
    const int vb0 = (int)(unsigned)(uintptr_t)lds + SHM_K + v_rd_base(lane);
#define TILEBIAS(t, BL, NEAR) const bool fr_##BL = (m_fr >> (t)) & 1u, fl_##BL = (m_fl >> (t)) & 1u; \
    const bool NEAR = !(fr_##BL || fl_##BL); const float BL = fr_##BL ? blR : (fl_##BL ? blL : 0.f)
#define ADJ(P0, P1, t, NEAR) do { if (NEAR) { if (qnarrow && tkl[64 + (t)] != 0) lut_adjust_fast(P0, P1, lut, tkl[2 * (t)], qp, hi); else lut_adjust(P0, P1, lut, kpos_l + (t) * 64, qp, hi); } } while (0)
#define SLOT(t) (((t) & 3) * DF_SLOT)
#define ENDWAIT(t) do { if ((t) + 2 < NT) WAITV(4); else WAITV(0); } while (0)
#define ENDSTEP(t) ABAR()
    f32x16 pA0, pA1, pB0, pB1; float alA, alB; bf16x8 pa0, pa1, pa2, pa3; constexpr int NT = SEQ / KVBLK;
    WAITV(0); ABAR();
    const float blR = lut[256 + 128], blL = lut[256 - 128];
    const unsigned m_fr = (unsigned)__ballot(tkl[2 * (lane & 31)] - qmx >= 91), m_fl = (unsigned)__ballot(tkl[2 * (lane & 31) + 1] - qmn <= -91);
    DMA(2, SLOT(2));
    { TILEBIAS(0, bl0, near0); SETNEG(bl0);
      qktp<4, DF_PRIO, 4>(pA0, pA1, lds + SLOT(0), qr, 4 * comp, ka, negm); ADJ(pA0, pA1, 0, near0); partialSMn<true, true>(pA0, pA1, m_reg, alA); }
    ENDWAIT(0); CV_LOAD(); ENDSTEP(0);
    for (int j = 1; j + 1 < NT; j += 2) {
        if (j + 2 < NT) DMA(j + 2, SLOT(j + 2));
        { TILEBIAS(j, blb, nearb); SETNEG(blb);
          SBAR(); qktp<4, DF_PRIO, 4>(pB0, pB1, lds + SLOT(j), qr, 4 * comp, ka, negm);
          finishSM<true>(pA0, pA1, alA, l_reg, pa0, pa1, pa2, pa3); SBAR();
          ADJ(pB0, pB1, j, nearb); SBAR();
          pv_d0<DF_PRIO>(o, vb0 + SLOT(j - 1), pa0, pa1, pa2, pa3); partialSMn<true, false>(pB0, pB1, m_reg, alB); }
        ENDWAIT(j); CV_STORE(); CV_LOAD(); ENDSTEP(j); RESC(alB);
        if (j + 3 < NT) DMA(j + 3, SLOT(j + 3));
        { TILEBIAS(j + 1, bla, neara); SETNEG(bla);
          SBAR(); qktp<4, DF_PRIO, 4>(pA0, pA1, lds + SLOT(j + 1), qr, 4 * comp, ka, negm);
          finishSM<true>(pB0, pB1, alB, l_reg, pa0, pa1, pa2, pa3); SBAR();
          ADJ(pA0, pA1, j + 1, neara); SBAR();
          pv_d0<DF_PRIO>(o, vb0 + SLOT(j), pa0, pa1, pa2, pa3); partialSMn<true, false>(pA0, pA1, m_reg, alA); }
        ENDWAIT(j + 1); CV_STORE(); CV_LOAD(); ENDSTEP(j + 1); RESC(alA);
    }
    CV_STORE(); CV_LOAD();
    { TILEBIAS(NT - 1, blz, nearz); SETNEG(blz);
      SBAR(); qktp<4, DF_PRIO, 4>(pB0, pB1, lds + SLOT(NT - 1), qr, 4 * comp, ka, negm);
      finishSM<true>(pA0, pA1, alA, l_reg, pa0, pa1, pa2, pa3); SBAR();
      ADJ(pB0, pB1, NT - 1, nearz); SBAR();
      pv_d0<DF_PRIO>(o, vb0 + SLOT(NT - 2), pa0, pa1, pa2, pa3); partialSMn<true, false>(pB0, pB1, m_reg, alB); }
    RESC(alB);
    finishSM<true>(pB0, pB1, alB, l_reg, pa0, pa1, pa2, pa3); SBAR();
    pv_d0<DF_PRIO>(o, vb0 + SLOT(NT - 1), pa0, pa1, pa2, pa3);
    CV_STORE();
    if (hi == 0) li_l[r32] = l_reg; asm volatile("s_waitcnt lgkmcnt(0)" ::: "memory");
    float rli[16];
#pragma unroll
    for (int r = 0; r < 16; ++r) rli[r] = __builtin_amdgcn_rcpf(li_l[crow(r, hi)]);
    ABAR();
    LAS float* X = (LAS float*)lds + (wq * 32) * 128;
    if (comp == 1) {
#pragma unroll
        for (int r = 0; r < 16; ++r) { const int orow = crow(r, hi);
#pragma unroll
            for (int d0 = 0; d0 < 4; ++d0) X[orow * 128 + d0 * 32 + r32] = o[d0][r] * rli[r] * lam; }
    }
    ABAR();
    if (comp == 0) {
        bf16* Ow = Ob + (long)(wq * QBLK) * DM;
        float sl[4];
#pragma unroll
        for (int d0 = 0; d0 < 4; ++d0) sl[d0] = subln[d0 * 32 + r32] * (1.0f - LAMBDA_INIT);
#pragma unroll
        for (int r = 0; r < 16; ++r) { const int orow = crow(r, hi);
            float v[4]; float ss = 0.f;
#pragma unroll
            for (int d0 = 0; d0 < 4; ++d0) { v[d0] = o[d0][r] * rli[r] - X[orow * 128 + d0 * 32 + r32]; ss += v[d0] * v[d0]; }
#pragma unroll
            for (int of = 1; of < 32; of <<= 1) ss += __shfl_xor(ss, of);
            const float rstd = rsqrtf(ss * (1.0f / 128.0f) + EPS);
#pragma unroll
            for (int d0 = 0; d0 < 4; d0 += 2) { const unsigned pk_ = cvtpk(v[d0] * rstd * sl[d0], v[d0 + 1] * rstd * sl[d0 + 1]);
                Ow[(long)orow * DM + d0 * 32 + r32] = (bf16)(pk_ & 0xffffu); Ow[(long)orow * DM + (d0 + 1) * 32 + r32] = (bf16)(pk_ >> 16); } }
    }
    ABAR();
#undef DMA
#undef TILEBIAS
#undef ADJ
#undef SETNEG
#undef SLOT
#undef ENDSTEP
#undef ENDWAIT
#undef CV_LOAD
#undef CV_STORE
#undef CV_ST1
#undef RESC
#undef WAITV
#undef ABAR
}
#undef KSWZ
#undef KRSWZ
#undef SBAR
}

__device__ __forceinline__ void attn_phase(unsigned char* ws, const int* pos, const float* rel_bias, const float* subln, float lam, LAS unsigned char* lds, int tid, int G, int bid,
                                           const float* wsrc_o, const float* wsrc_up, const float* wsrc_dn) {
    const bf16* PROJ = (const bf16*)(ws + WS_PROJ); const bf16* Qb = (const bf16*)(ws + WS_Q); const bf16* KVb = (const bf16*)(ws + WS_KV); bf16* AO = (bf16*)(ws + WS_AO);
    const int* TK = (const int*)(ws + WS_TK);
    const int vcu = (G % 8 == 0) ? (bid % 8) * (G / 8) + bid / 8 : bid;
    { constexpr int NU = BATCH * 8 * (SEQ / 256); const int per = (NU + G - 1) / G;
      for (int i = 0; i < per; ++i) { const int un = vcu * per + i; if (un >= NU) break;
        int tidu = tid; asm volatile("" : "+v"(tidu));
        const int qb = un & 7, h = (un >> 3) & 7, b = un >> 6;
        const size_t m0 = (size_t)b * SEQ + qb * 256;
        att::mla_unit(Qb + m0 * QW + h * 192, KVb + (size_t)b * SEQ * KVW + h * 256, PROJ + (size_t)b * SEQ * INWP + C_KROPE, AO + m0 * DM + h * 128, (att::lptr)lds, tidu); } }
    { constexpr int NU = BATCH * 8 * (SEQ / 128); const int per = (NU + G - 1) / G;
      att::CvStream cvb; cvb.on = false; cvb.src = nullptr; cvb.dst = nullptr; cvb.sN4 = 0; cvb.K2 = 0; cvb.so_src = 0; cvb.so_dst = 0; cvb.nsteps = 0; int cv_kunit = 0;
      if (G == 256) { const int gw_ = __builtin_amdgcn_readfirstlane(tid >> 6) * G + vcu; int strip = 0, kb_ = 0, N_ = 0, K_ = 0;
        if (gw_ < 32) { strip = gw_; N_ = DM; K_ = DM; cvb.src = wsrc_o; cvb.dst = ws + WS_WO; cvb.on = true; cvb.nsteps = 32; cv_kunit = 512; }
        else if (gw_ < 208) { strip = gw_ - 32; N_ = FF2; K_ = DM; cvb.src = wsrc_up; cvb.dst = ws + WS_WUP; cvb.on = true; cvb.nsteps = 32; cv_kunit = 512; }
        else if (gw_ < 336) { const int g_ = gw_ - 208; strip = g_ >> 2; kb_ = 1408 * (g_ & 3); N_ = DM; K_ = FF; cvb.src = wsrc_dn; cvb.dst = ws + WS_WDN; cvb.on = true; cvb.nsteps = 22; cv_kunit = 352; }
        cvb.sN4 = (unsigned)N_ * 4u; cvb.K2 = (unsigned)K_ * 2u;
        cvb.so_src = ((unsigned)kb_ * (unsigned)N_ + 64u * strip) * 4u; cvb.so_dst = ((unsigned)(64 * strip) * (unsigned)K_ + (unsigned)kb_) * 2u; }
      for (int i = 0; i < per; ++i) { const int un = vcu * per + i; if (un >= NU) break;
        int tidu = tid; asm volatile("" : "+v"(tidu));
        const int qb = un & 15, h = (un >> 4) & 7, b = un >> 7;
        const size_t m0 = (size_t)b * SEQ + qb * 128;
        att::CvStream cv = cvb; cv.so_src += (unsigned)(cv_kunit * i) * cvb.sN4; cv.so_dst += (unsigned)(cv_kunit * i) * 2u;
        att::diff_unit(PROJ + m0 * INWP + C_DQ + h * 128, PROJ + (size_t)b * SEQ * INWP + C_DK + h * 128, PROJ + (size_t)b * SEQ * INWP + C_DV + h * 128,
                       pos + m0, pos + (size_t)b * SEQ, TK + b * 64, TK + TKF_OFF + b * 32, rel_bias + h, subln, lam, AO + m0 * DM + 1024 + h * 128, (att::lptr)lds, tidu, cv); } }
}

constexpr int NPH = 11;
struct Args { const void* in[25]; float* out; unsigned char* ws; int ph_lo, ph_hi; };
__global__ void __launch_bounds__(NTHREADS, 2) fwd(Args args) {
    extern __shared__ __attribute__((aligned(16))) unsigned char lds_raw[];
    LAS unsigned char* lds = (LAS unsigned char*)lds_raw;
    const int tid0 = threadIdx.x, G0 = gridDim.x;
    const int wave0 = __builtin_amdgcn_readfirstlane(tid0 >> 6);
    for (int u = tid0; u < (LDS_BYTES - LDSCTL_OFF) / 4; u += NTHREADS) ((LAS unsigned*)(lds + LDSCTL_OFF))[u] = 0u;
    __syncthreads();
    if (tid0 == 0) {
        LAS unsigned long long* pt = (LAS unsigned long long*)(lds + PTR_OFF);
#pragma unroll
        for (int i = 0; i < 25; ++i) pt[i] = (unsigned long long)args.in[i];
        pt[P_OUT] = (unsigned long long)args.out; pt[P_WS] = (unsigned long long)args.ws;
    }
    __syncthreads();
    volatile LAS unsigned* MISC = (volatile LAS unsigned*)(lds + MISC_OFF);
    const int ph_lo = args.ph_lo, ph_hi = args.ph_hi;
    XcdBarrier bar; bar.bar = nullptr; bar.x = 0; bar.st = nullptr;
    if (ph_hi - ph_lo > 1) bar = xcd_barrier_post((unsigned*)(LPWS() + WS_CTL) + CW_BAR, MISC + 8, tid0);

#define PH_BEGIN(k) if (ph_lo <= (k) && (k) < ph_hi) { int G = G0, bid = (int)blockIdx.x, wave = wave0; \
        int lane = (int)__builtin_amdgcn_mbcnt_hi(~0u, __builtin_amdgcn_mbcnt_lo(~0u, 0u)); \
        asm volatile("" : "+v"(lane)); asm volatile("" : "+s"(G)); asm volatile("" : "+s"(bid)); asm volatile("" : "+s"(wave)); \
        const int tid = wave * 64 + lane; (void)tid; (void)lane; (void)G; (void)bid; unsigned char* ws = LPWS(); (void)ws;
#define PH_END(k) if ((k) + 1 < ph_hi) xcd_barrier(bar, tid); }

    PH_BEGIN(0) p0_prologue(lds, tid, lane, wave, G, bid);
        { const float s1 = wave_sum(LPF(P_LQ1)[lane] * LPF(P_LK1)[lane]), s2 = wave_sum(LPF(P_LQ2)[lane] * LPF(P_LK2)[lane]);
          if (tid == 0) *(volatile LAS float*)(lds + LDSCTL_OFF + 384) = expf(s1) - expf(s2) + LAMBDA_INIT; }
    PH_END(0)
    PH_BEGIN(1) prenorm_phase(LPF(P_X), LPF(P_APRE), (const float*)(ws + WS_MOD), MOD_SHA, MOD_SCA, (bf16*)(ws + WS_H), lane, wave, G, bid); PH_END(1)
    for (int q = 0; q < 3; ++q) {
        const int k = (q == 0) ? 2 : 3;
        PH_BEGIN(k)
            bf16* PROJ = (bf16*)(ws + WS_PROJ);
            pg8::Gemm g; pg8::EpiX E;
            E.qscale = MLA_SCALE * att::LOG2E; E.ssq_q = (float*)(ws + WS_SSQQ); E.ssq_kv = (float*)(ws + WS_SSQKV); E.COS = (const float*)(ws + WS_COS); E.SIN = (const float*)(ws + WS_SIN);
            if (q == 0) { g = pg8::Gemm{(const bf16*)(ws + WS_H), (const bf16*)(ws + WS_WIN), M, INWP, DM, DM, DM, 128, 256, 0}; E.O = PROJ; E.ldc = INWP; E.mode = 0; }
            else if (q == 1) { g = pg8::Gemm{PROJ + C_QLAT, (const bf16*)(ws + WS_WUQ), M, QW, 512, INWP, 512, 128, 256, 0}; E.O = (bf16*)(ws + WS_Q); E.ldc = QW; E.mode = 1; }
            else { g = pg8::Gemm{PROJ + C_KVLAT, (const bf16*)(ws + WS_WUKV), M, KVW, 256, INWP, 256, 128, 256, 0}; E.O = (bf16*)(ws + WS_KV); E.ldc = KVW; E.mode = 2; }
            const int vcu = (G % 8 == 0) ? (bid % 8) * (G / 8) + bid / 8 : bid;
            pg8::ListOrder S;
            if (G == 256) {
                if (q == 0) S = pg8::ListOrder{4 * vcu, 4, INWP / 256};
                else if (q == 1) S = (vcu < 128) ? pg8::ListOrder{2 * vcu, 2, QW / 256} : pg8::ListOrder{256 + (vcu - 128), 1, QW / 256};
                else S = (vcu < 128) ? pg8::ListOrder{vcu, 1, KVW / 256} : pg8::ListOrder{128 + 3 * (vcu - 128), 3, KVW / 256};
            } else { const int nu = (g.M / 256) * (g.N / 256), per = (nu + G - 1) / G, b0 = vcu * per; S = pg8::ListOrder{b0, (b0 >= nu) ? 0 : ((nu - b0 < per) ? nu - b0 : per), g.N / 256}; }
            pg8::gemm_phase<pg8::EpiX, pg8::ListOrder, true, true>(lds, g, S, E, tid);
            if (q == 1) { }
            else
        PH_END(k)
        else { }
    }
    PH_BEGIN(4)
        float lam;
        if (ph_lo == 0) lam = *(volatile LAS float*)(lds + LDSCTL_OFF + 384);
        else { const float s1 = wave_sum(LPF(P_LQ1)[lane] * LPF(P_LK1)[lane]), s2 = wave_sum(LPF(P_LQ2)[lane] * LPF(P_LK2)[lane]); lam = expf(s1) - expf(s2) + LAMBDA_INIT; }
        attn_phase(ws, (const int*)ldptr(lds, P_POS), LPF(P_RELB), LPF(P_SUBLN), lam, lds, tid, G, bid, LPF(P_WO), LPF(P_WUP), LPF(P_WDN));
    PH_END(4)
    for (int q = 0; q < 2; ++q) {
        const int k = (q == 0) ? 5 : 9;
        PH_BEGIN(k)
            pg8::Gemm g; pg8::EpiBf16 E;
            if (q == 0) { g = pg8::Gemm{(const bf16*)(ws + WS_AO), (const bf16*)(ws + WS_WO), M, DM, DM, DM, DM, 128, 256, 0}; E = pg8::EpiBf16{(bf16*)(ws + WS_Y), DM}; }
            else { g = pg8::Gemm{(const bf16*)(ws + WS_G), (const bf16*)(ws + WS_WDN), M, DM, FF, FF, FF, 128, 256, 0}; E = pg8::EpiBf16{(bf16*)(ws + WS_Y2), DM}; }
            pg8::StaticOrder S; S.init(g.M, g.N, G, bid);
            pg8::gemm_phase<pg8::EpiBf16, pg8::StaticOrder, true, true>(lds, g, S, E, tid);
        PH_END(k)
        if (q == 0) {
            PH_BEGIN(6) post_phase<true>((const bf16*)(ws + WS_Y), LPF(P_X), (void*)(ws + WS_X1), LPF(P_APOST), (const float*)(ws + WS_MOD), MOD_GA, LPF(P_FPRE), MOD_SHF, MOD_SCF, (bf16*)(ws + WS_H), lane, wave, G, bid); PH_END(6)
            PH_BEGIN(7)
                pg8::Gemm g = pg8::Gemm{(const bf16*)(ws + WS_H), (const bf16*)(ws + WS_WUP), M, FF2, DM, DM, DM, FF, 128, 1};
                pg8::EpiConv E{(bf16*)(ws + WS_G), (bf16*)(ws + WS_E), LPF(P_CW), LPF(P_CB), FF, FF2};
                pg8::StaticOrder S; S.init(g.M, g.N, G, bid);
                pg8::gemm_phase<pg8::EpiConv, pg8::StaticOrder, true, true>(lds, g, S, E, tid);
            PH_END(7)
            PH_BEGIN(8) fixup_phase((const bf16*)(ws + WS_E), (bf16*)(ws + WS_G), LPF(P_CW), LPF(P_CB), tid, G, bid); PH_END(8)
        }
    }
    PH_BEGIN(10) float* outp = (float*)ldptr(lds, P_OUT);
        post_phase<false>((const bf16*)(ws + WS_Y2), (const void*)(ws + WS_X1), outp, LPF(P_FPOST), (const float*)(ws + WS_MOD), MOD_GF, nullptr, 0, 0, nullptr, lane, wave, G, bid); PH_END(10)
#undef PH_BEGIN
#undef PH_END
}

#ifndef MK_ONE_LAUNCH
#define MK_ONE_LAUNCH 1
#endif
extern "C" void kernel_launch(void* const* d_in, const int* in_sizes, int n_in, void* d_out, int out_size, void* d_ws, size_t ws_size, hipStream_t stream) {
    static int grid = 0;
    if (grid == 0) {
        if (n_in != 25 || in_sizes[0] != M * DM || out_size != M * DM || ws_size < WS_END) {
            fprintf(stderr, "kernel_launch: shape mismatch: n_in %d in0 %d out %d ws %zu (need >= %zu)\n", n_in, n_in > 0 ? in_sizes[0] : -1, out_size, ws_size, (size_t)WS_END); grid = -1; return; }
        int dev = 0, cus = 0;
        if (hipGetDevice(&dev) != hipSuccess || hipDeviceGetAttribute(&cus, hipDeviceAttributeMultiprocessorCount, dev) != hipSuccess) { grid = -1; return; }
        if (hipFuncSetAttribute((const void*)fwd, hipFuncAttributeMaxDynamicSharedMemorySize, LDS_BYTES) != hipSuccess) { fprintf(stderr, "kernel_launch: hipFuncSetAttribute failed\n"); grid = -1; return; }
        (void)hipGetLastError();
        grid = cus;
    }
    if (grid < 0) return;
    if (hipMemsetAsync((char*)d_ws + WS_CTL, 0, CTL_ZERO_BYTES, stream) != hipSuccess) { fprintf(stderr, "kernel_launch: memset failed\n"); return; }
    Args a{};
    for (int i = 0; i < 25; ++i) a.in[i] = d_in[i];
    a.out = (float*)d_out; a.ws = (unsigned char*)d_ws;
#if MK_ONE_LAUNCH
    a.ph_lo = 0; a.ph_hi = NPH;
    hipLaunchKernelGGL(fwd, dim3(grid), dim3(NTHREADS), LDS_BYTES, stream, a);
#else
    for (int p = 0; p < NPH; ++p) { a.ph_lo = p; a.ph_hi = p + 1; hipLaunchKernelGGL(fwd, dim3(grid), dim3(NTHREADS), LDS_BYTES, stream, a); }
#endif
    const hipError_t le = hipPeekAtLastError();
    if (le != hipSuccess) fprintf(stderr, "kernel_launch: launch failed: %s\n", hipGetErrorName(le));
}
```
